# Optimizing an MI355X kernel written in HIP

```python
import jax, jax.numpy as jnp
from jax import lax
import numpy as np

D_MODEL = 1024
BATCH = 16
SEQ = 2048
DEPTH = 2

CHUNK = 64
Q_BLOCK = 128
HEAD_DIM = 64
N_HEADS_FOX = 6
N_HEADS_SB = 5
N_HEADS_DSA = 5
W_FOX = N_HEADS_FOX * HEAD_DIM
W_SB = N_HEADS_SB * HEAD_DIM
W_DSA = N_HEADS_DSA * HEAD_DIM
KV_LATENT = 128
N_IDX_HEADS = 4
IDX_DIM = 64
TOPK_MAX = 256
ROPE_THETA = 500000.0
ROPE_DIM = HEAD_DIM // 4
D_FF = 2816
N_BRANCH = 3
EPS = 1e-6
D_IN = 3 * W_FOX + N_HEADS_FOX + 3 * W_SB + W_DSA + KV_LATENT + N_IDX_HEADS * IDX_DIM + IDX_DIM + N_IDX_HEADS + N_BRANCH * D_MODEL

kernel_name = "hybrid_fox_stickbreak_dsa_macaron"


def _in_sizes():
    return [W_FOX, W_FOX, W_FOX, N_HEADS_FOX,
            W_SB, W_SB, W_SB,
            W_DSA, KV_LATENT, N_IDX_HEADS * IDX_DIM, IDX_DIM, N_IDX_HEADS,
            N_BRANCH * D_MODEL]


def _split_points():
    pts, acc = [], 0
    for s in _in_sizes()[:-1]:
        acc += s
        pts.append(acc)
    return pts


def rmsnorm(x, g):
    xf = x.astype(jnp.float32)
    y = xf * lax.rsqrt(jnp.mean(xf * xf, axis=-1, keepdims=True) + EPS)
    return (y * g.astype(jnp.float32)).astype(x.dtype)


def swiglu(h, w_gu, w_down):
    g, u = jnp.split(h @ w_gu, 2, axis=-1)
    return (jax.nn.silu(g) * u) @ w_down


def rope_tables(seq):
    pos = jnp.arange(seq, dtype=jnp.float32)
    inv = ROPE_THETA ** (-jnp.arange(0, ROPE_DIM, 2, dtype=jnp.float32) / ROPE_DIM)
    ang = pos[:, None] * inv[None, :]
    return jnp.cos(ang), jnp.sin(ang)


def partial_rope(x, cos, sin):
    half = ROPE_DIM // 2
    x1 = x[..., :half].astype(jnp.float32)
    x2 = x[..., half:ROPE_DIM].astype(jnp.float32)
    c = cos[None, :, None, :]
    s = sin[None, :, None, :]
    r1 = (x1 * c - x2 * s).astype(x.dtype)
    r2 = (x2 * c + x1 * s).astype(x.dtype)
    return jnp.concatenate([r1, r2, x[..., ROPE_DIM:]], axis=-1)


def forgetting_attention(q, k, v, f_logit):
    B, S, H, Dh = q.shape
    scale = Dh ** -0.5
    c = jnp.cumsum(jax.nn.log_sigmoid(f_logit.astype(jnp.float32)), axis=1)
    c = c.transpose(0, 2, 1)
    outs = []
    for start in range(0, S, Q_BLOCK):
        end = start + Q_BLOCK
        s = jnp.einsum('bqhd,bkhd->bhqk', q[:, start:end], k[:, :end]).astype(jnp.float32) * scale
        bias = c[:, :, start:end, None] - c[:, :, None, :end]
        t_pos = jnp.arange(start, end)
        s_pos = jnp.arange(end)
        mask = s_pos[None, :] <= t_pos[:, None]
        p = jax.nn.softmax(jnp.where(mask, s + bias, -jnp.inf), axis=-1)
        outs.append(jnp.einsum('bhqk,bkhd->bqhd', p.astype(v.dtype), v[:, :end]))
    return jnp.concatenate(outs, axis=1)


def stick_breaking_attention(q, k, v):
    B, S, H, Dh = q.shape
    scale = Dh ** -0.5
    outs = []
    for start in range(0, S, Q_BLOCK):
        end = start + Q_BLOCK
        z = jnp.einsum('bqhd,bkhd->bhqk', q[:, start:end], k[:, :end]).astype(jnp.float32) * scale
        t_pos = jnp.arange(start, end)
        s_pos = jnp.arange(end)
        mask = s_pos[None, :] < t_pos[:, None]
        log_1m = jnp.where(mask, jax.nn.log_sigmoid(-z), 0.0)
        acc = lax.cumsum(log_1m, axis=3, reverse=True) - log_1m
        a = jnp.where(mask, jnp.exp(jax.nn.log_sigmoid(z) + acc), 0.0)
        outs.append(jnp.einsum('bhqk,bkhd->bqhd', a.astype(v.dtype), v[:, :end]))
    return jnp.concatenate(outs, axis=1)


def dsa_attention(q, k, v, iq, ik, iw):
    B, S, H, Dh = q.shape
    scale = Dh ** -0.5
    chunk_id = jnp.arange(S) // CHUNK
    topk = min(TOPK_MAX, S // 4)
    outs = []
    for start in range(0, S, Q_BLOCK):
        end = start + Q_BLOCK
        kk = min(topk, end)
        q_chunk = chunk_id[start:end]
        rel = jax.nn.relu(jnp.einsum('bqhd,bkd->bqhk', iq[:, start:end], ik[:, :end]).astype(jnp.float32))
        score = jnp.einsum('bqhk,bqh->bqk', rel, iw[:, start:end].astype(jnp.float32))
        admissible = chunk_id[None, :end] <= q_chunk[:, None]
        score = jnp.where(admissible[None], score, -jnp.inf)
        _, sel = lax.top_k(score, kk)
        valid = chunk_id[sel] <= q_chunk[None, :, None]
        k_sel = jax.vmap(lambda kb, ib: kb[ib])(k[:, :end], sel)
        v_sel = jax.vmap(lambda vb, ib: vb[ib])(v[:, :end], sel)
        s = jnp.einsum('bqhd,bqkd->bqhk', q[:, start:end], k_sel).astype(jnp.float32) * scale
        p = jax.nn.softmax(jnp.where(valid[:, :, None, :], s, -jnp.inf), axis=-1)
        outs.append(jnp.einsum('bqhk,bqkd->bqhd', p.astype(v.dtype), v_sel))
    return jnp.concatenate(outs, axis=1)


def hybrid_mixer(h, w_in, b_forget, g_kv, w_kv_up, g_idx_k, w_up_fox, w_up_sb, w_up_dsa, w_out, cos, sin):
    B, S, _ = h.shape
    (q_a, k_a, v_a, f_a, q_b, k_b, v_b, q_c, c_kv, q_i, k_i, w_i, gates) = jnp.split(h @ w_in, _split_points(), axis=-1)
    heads = lambda t, n: t.reshape(B, S, n, HEAD_DIM)
    y_a = forgetting_attention(heads(q_a, N_HEADS_FOX), heads(k_a, N_HEADS_FOX), heads(v_a, N_HEADS_FOX), f_a + b_forget)
    y_b = stick_breaking_attention(heads(q_b, N_HEADS_SB), heads(k_b, N_HEADS_SB), heads(v_b, N_HEADS_SB))
    k_c, v_c = jnp.split(rmsnorm(c_kv, g_kv) @ w_kv_up, 2, axis=-1)
    q_c = partial_rope(heads(q_c, N_HEADS_DSA), cos, sin)
    k_c = partial_rope(k_c[:, :, None, :], cos, sin)[:, :, 0]
    q_i = partial_rope(q_i.reshape(B, S, N_IDX_HEADS, IDX_DIM), cos, sin)
    k_i = partial_rope(rmsnorm(k_i, g_idx_k)[:, :, None, :], cos, sin)[:, :, 0]
    y_c = dsa_attention(q_c, k_c, v_c, q_i, k_i, w_i)
    g_a, g_b, g_c = jnp.split(jax.nn.sigmoid(gates), N_BRANCH, axis=-1)
    merged = (g_a * (y_a.reshape(B, S, W_FOX) @ w_up_fox)
              + g_b * (y_b.reshape(B, S, W_SB) @ w_up_sb)
              + g_c * (y_c.reshape(B, S, W_DSA) @ w_up_dsa))
    return merged @ w_out


def setup_inputs(seed: int = 0) -> dict:
    key = jax.random.key(seed)
    ks = jax.random.split(key, 20)
    f32 = jnp.float32
    nrm = lambda k, shape, fan_in: jax.random.normal(k, shape, f32) * (fan_in ** -0.5)
    gain = lambda k, shape: 1.0 + 0.02 * jax.random.normal(k, shape, f32)
    return {
        "x": jax.random.normal(ks[0], (BATCH, SEQ, D_MODEL), f32),
        "g_ffn1": gain(ks[1], (DEPTH, D_MODEL)),
        "w_ffn1_gu": nrm(ks[2], (DEPTH, D_MODEL, 2 * D_FF), D_MODEL),
        "w_ffn1_down": nrm(ks[3], (DEPTH, D_FF, D_MODEL), D_FF),
        "g_mix": gain(ks[4], (DEPTH, D_MODEL)),
        "w_in": nrm(ks[5], (DEPTH, D_MODEL, D_IN), D_MODEL),
        "b_forget": 2.0 + 0.5 * jax.random.normal(ks[6], (DEPTH, N_HEADS_FOX), f32),
        "g_kv_latent": gain(ks[7], (DEPTH, KV_LATENT)),
        "w_kv_up": nrm(ks[8], (DEPTH, KV_LATENT, 2 * HEAD_DIM), KV_LATENT),
        "g_idx_k": gain(ks[9], (DEPTH, IDX_DIM)),
        "w_up_fox": nrm(ks[10], (DEPTH, W_FOX, D_MODEL), W_FOX),
        "w_up_sb": nrm(ks[11], (DEPTH, W_SB, D_MODEL), W_SB),
        "w_up_dsa": nrm(ks[12], (DEPTH, W_DSA, D_MODEL), W_DSA),
        "w_out": nrm(ks[13], (DEPTH, D_MODEL, D_MODEL), D_MODEL),
        "g_ffn2": gain(ks[14], (DEPTH, D_MODEL)),
        "w_ffn2_gu": nrm(ks[15], (DEPTH, D_MODEL, 2 * D_FF), D_MODEL),
        "w_ffn2_down": nrm(ks[16], (DEPTH, D_FF, D_MODEL), D_FF),
        "g_final": gain(ks[17], (D_MODEL,)),
    }


def reference(x, g_ffn1, w_ffn1_gu, w_ffn1_down, g_mix, w_in, b_forget, g_kv_latent, w_kv_up, g_idx_k,
              w_up_fox, w_up_sb, w_up_dsa, w_out, g_ffn2, w_ffn2_gu, w_ffn2_down, g_final):
    cos, sin = rope_tables(x.shape[1])
    for l in range(DEPTH):
        x = x + 0.5 * swiglu(rmsnorm(x, g_ffn1[l]), w_ffn1_gu[l], w_ffn1_down[l])
        x = x + hybrid_mixer(rmsnorm(x, g_mix[l]), w_in[l], b_forget[l], g_kv_latent[l], w_kv_up[l], g_idx_k[l],
                             w_up_fox[l], w_up_sb[l], w_up_dsa[l], w_out[l], cos, sin)
        x = x + 0.5 * swiglu(rmsnorm(x, g_ffn2[l]), w_ffn2_gu[l], w_ffn2_down[l])
    return rmsnorm(x, g_final)
```

```cpp
#include <hip/hip_runtime.h>
#include <cstdio>
#include <cstdint>
#include <cmath>
namespace pg8 {
#define PG8_LAS __attribute__((address_space(3)))
typedef unsigned short bf16_t;
typedef short bf16x8 __attribute__((ext_vector_type(8)));
typedef float f32x4 __attribute__((ext_vector_type(4)));
typedef unsigned u32x4 __attribute__((ext_vector_type(4)));
constexpr int BM = 256, BK = 64, HALF = 128, HTB = HALF * BK * 2  , STAGE_BYTES = 8 * HTB, NXCD = 8, WGM = 8;

__host__ __device__ __forceinline__ int lds_byte(int r, int c) { const int st = (r >> 4) * 2 + (c >> 5), rr = r & 15, cc = c & 31, ob = rr * 64 + cc * 2; return st * 1024 + (ob ^ (((ob >> 9) & 1) << 5)); }
__host__ __device__ __forceinline__ void stage_rc(int b, int& R, int& C) { const int st = b / 1024, sb = b % 1024, swz = sb ^ (((sb >> 9) & 1) << 5); R = (st >> 1) * 16 + swz / 64; C = (st & 1) * 32 + (swz % 64) / 2; }
__host__ __device__ __forceinline__ int perm32(int rho) { const int n = rho >> 4, i = rho & 15; return 8 * (i >> 2) + 4 * n + (i & 3); }

struct Unit { int pm, pn; };
struct Gemm { const bf16_t* A; const bf16_t* Bt; int M, N, K; };

struct StaticOrder {
    int nM, nN, nwg, G, c;
    __host__ __device__ void init(int M, int N, int G_, int c_) { nM = M / BM; nN = N / BM; nwg = nM * nN; G = G_; c = c_; }
    __host__ __device__ bool next(int i, Unit& u) const {
        const long L = (long)i * G + c; if (L >= nwg) return false;
        int wgid = (int)L; { const int q = nwg / NXCD, r = nwg % NXCD, xcd = wgid % NXCD, off = wgid / NXCD; wgid = (xcd < r ? xcd * (q + 1) : r * (q + 1) + (xcd - r) * q) + off; }
        const int nig = WGM * nN, gid = wgid / nig, fm = gid * WGM, gsz = (nM - fm) < WGM ? (nM - fm) : WGM;
        u.pm = fm + ((wgid % nig) % gsz); u.pn = (wgid % nig) / gsz; return true;
    }
    __device__ __forceinline__ void a_ready(const Unit&) const {}
    __device__ __forceinline__ void done(const Unit&) const {}
};

__device__ __forceinline__ unsigned cvt_pk_bf16(float lo, float hi) { unsigned r; asm volatile("v_cvt_pk_bf16_f32 %0, %1, %2" : "=v"(r) : "v"(lo), "v"(hi)); return r; }
typedef float f32x2 __attribute__((ext_vector_type(2)));

__device__ __forceinline__ float row_rs(const float* ssq, int row) {
    const f32x4* p = (const f32x4*)(ssq + (size_t)row * 16);
    const f32x4 a = p[0], b = p[1], c = p[2], d = p[3];
    const float s = (((a[0] + a[1]) + (a[2] + a[3])) + ((b[0] + b[1]) + (b[2] + b[3]))) + (((c[0] + c[1]) + (c[2] + c[3])) + ((d[0] + d[1]) + (d[2] + d[3])));
    return 1.0f / sqrtf(s * (1.0f / 1024.0f) + 1e-6f);
}
__device__ __forceinline__ float sigmoid_f(float v) { return __builtin_amdgcn_rcpf(1.0f + __expf(-v)); }
__device__ __forceinline__ float bf_lo(unsigned w) { return __uint_as_float(w << 16); }
__device__ __forceinline__ float bf_hi(unsigned w) { return __uint_as_float(w & 0xffff0000u); }

struct EpiSwiglu {
    static constexpr bool PERM = true, AFTER_DRAIN = false;
    const float* ssq; bf16_t* H; int ldh;
    __device__ __forceinline__ void operator()(const f32x4 (&acc)[2][2][4][2], const Unit& u, int wr, int wc, int fr, int fq) const {
        const int row0 = u.pm * BM + wr * 64 + fr, col0 = u.pn * HALF + wc * 32 + 8 * fq;
#pragma unroll
        for (int ai = 0; ai < 2; ++ai)
#pragma unroll
            for (int m = 0; m < 4; ++m) {
                const int row = row0 + ai * HALF + m * 16; const float r = row_rs(ssq, row);
                float h[8];
#pragma unroll
                for (int n = 0; n < 2; ++n)
#pragma unroll
                    for (int e = 0; e < 4; ++e) { const float g = acc[ai][0][m][n][e] * r, uu = acc[ai][1][m][n][e] * r; h[4 * n + e] = g * sigmoid_f(g) * uu; }
                u32x4 w; w.x = cvt_pk_bf16(h[0], h[1]); w.y = cvt_pk_bf16(h[2], h[3]); w.z = cvt_pk_bf16(h[4], h[5]); w.w = cvt_pk_bf16(h[6], h[7]);
                *(u32x4*)(H + (size_t)row * ldh + col0) = w;
            }
    }
};
struct EpiResid {
    static constexpr bool PERM = false, AFTER_DRAIN = false;
    const float* xin; float* xout; bf16_t* xb; float* ssq; float alpha;
    __device__ __forceinline__ void operator()(const f32x4 (&acc)[2][2][4][2], const Unit& u, int wr, int wc, int fr, int fq) const {
        const int row0 = u.pm * BM + wr * 64 + fr, col0 = u.pn * BM + wc * 32 + 4 * fq;
#pragma unroll
        for (int ai = 0; ai < 2; ++ai)
#pragma unroll
            for (int m = 0; m < 4; ++m) {
                const int row = row0 + ai * HALF + m * 16; float sq = 0.f;
#pragma unroll
                for (int bj = 0; bj < 2; ++bj)
#pragma unroll
                    for (int n = 0; n < 2; ++n) {
                        const size_t off = (size_t)row * 1024 + col0 + bj * HALF + n * 16;
                        const f32x4 xo = *(const f32x4*)(xin + off); const f32x4 xn = xo + acc[ai][bj][m][n] * alpha;
                        *(f32x4*)(xout + off) = xn;
                        typedef unsigned u32x2v __attribute__((ext_vector_type(2)));
                        u32x2v w; w.x = cvt_pk_bf16(xn[0], xn[1]); w.y = cvt_pk_bf16(xn[2], xn[3]); *(u32x2v*)(xb + off) = w;
                        sq += (xn[0] * xn[0] + xn[1] * xn[1]) + (xn[2] * xn[2] + xn[3] * xn[3]);
                    }
                sq += __shfl_xor(sq, 16); sq += __shfl_xor(sq, 32);
                if (fq == 0) ssq[(size_t)row * 16 + u.pn * 4 + wc] = sq;
            }
    }
};
struct EpiWin {
    static constexpr bool PERM = true, AFTER_DRAIN = false;
    const float* ssq; bf16_t* P; float* Pf; int ldp;
    __device__ __forceinline__ void operator()(const f32x4 (&acc)[2][2][4][2], const Unit& u, int wr, int wc, int fr, int fq) const {
        const int row0 = u.pm * BM + wr * 64 + fr, cin = wc * 32 + 8 * fq;
#pragma unroll
        for (int ai = 0; ai < 2; ++ai)
#pragma unroll
            for (int m = 0; m < 4; ++m) {
                const int row = row0 + ai * HALF + m * 16; const float r = row_rs(ssq, row);
#pragma unroll
                for (int bj = 0; bj < 2; ++bj) {
                    f32x4 v0 = acc[ai][bj][m][0] * r, v1 = acc[ai][bj][m][1] * r;
                    if (u.pn == 11) {
                        float* o = Pf + (size_t)row * 256 + cin + bj * HALF; *(f32x4*)o = v0; *(f32x4*)(o + 4) = v1;
                    } else {
                        if (u.pn >= 12) {
#pragma unroll
                            for (int e = 0; e < 4; ++e) { v0[e] = sigmoid_f(v0[e]); v1[e] = sigmoid_f(v1[e]); }
                        }
                        u32x4 w; w.x = cvt_pk_bf16(v0[0], v0[1]); w.y = cvt_pk_bf16(v0[2], v0[3]); w.z = cvt_pk_bf16(v1[0], v1[1]); w.w = cvt_pk_bf16(v1[2], v1[3]);
                        *(u32x4*)(P + (size_t)row * ldp + u.pn * BM + cin + bj * HALF) = w;
                    }
                }
            }
    }
};
template <int MODE> struct EpiGate {
    static constexpr bool PERM = true, AFTER_DRAIN = false;
    const bf16_t* G; int ldg; float* mgf; bf16_t* mgb;
    __device__ __forceinline__ void operator()(const f32x4 (&acc)[2][2][4][2], const Unit& u, int wr, int wc, int fr, int fq) const {
        const int row0 = u.pm * BM + wr * 64 + fr, col0 = u.pn * BM + wc * 32 + 8 * fq;
#pragma unroll
        for (int ai = 0; ai < 2; ++ai)
#pragma unroll
            for (int m = 0; m < 4; ++m) {
                const int row = row0 + ai * HALF + m * 16;
#pragma unroll
                for (int bj = 0; bj < 2; ++bj) {
                    const int col = col0 + bj * HALF;
                    const u32x4 gw = *(const u32x4*)(G + (size_t)row * ldg + col);
                    f32x4 v0 = acc[ai][bj][m][0], v1 = acc[ai][bj][m][1];
                    v0[0] *= bf_lo(gw.x); v0[1] *= bf_hi(gw.x); v0[2] *= bf_lo(gw.y); v0[3] *= bf_hi(gw.y);
                    v1[0] *= bf_lo(gw.z); v1[1] *= bf_hi(gw.z); v1[2] *= bf_lo(gw.w); v1[3] *= bf_hi(gw.w);
                    float* o = mgf + (size_t)row * 1024 + col;
                    if (MODE >= 1) { v0 += *(const f32x4*)o; v1 += *(const f32x4*)(o + 4); }
                    if (MODE <= 1) { *(f32x4*)o = v0; *(f32x4*)(o + 4) = v1; }
                    else { u32x4 w; w.x = cvt_pk_bf16(v0[0], v0[1]); w.y = cvt_pk_bf16(v0[2], v0[3]); w.z = cvt_pk_bf16(v1[0], v1[1]); w.w = cvt_pk_bf16(v1[2], v1[3]);
                           *(u32x4*)(mgb + (size_t)row * 1024 + col) = w; }
                }
            }
    }
};

template <class Epi, class Sched, bool ALIGN_EPI = false, bool SP2 = false>
__device__ __forceinline__ void gemm_phase(PG8_LAS unsigned char* lds, const Gemm g, const Sched& S, const Epi& E) {
    int tid_ = threadIdx.x; asm volatile("" : "+v"(tid_));
    const int tid = tid_, wid = __builtin_amdgcn_readfirstlane(tid >> 6), lane = tid & 63, wr = wid >> 2, wc = wid & 3, fr = lane & 15, fq = lane >> 4;
    const int K = g.K, nt = K / BK;
    unsigned voffA[2], voffB[2];
#pragma unroll
    for (int i = 0; i < 2; ++i) { int R, C; stage_rc(tid * 16 + i * 8192, R, C); const int Rb = Epi::PERM ? ((R & ~31) + perm32(R & 31)) : R;
        voffA[i] = (unsigned)(R * K + C) * 2u; voffB[i] = (unsigned)(Rb * K + C) * 2u; }
    const size_t kstep = (size_t)(BK * 2);
    const size_t hstep = (size_t)HALF * K * 2;
    const size_t tstep = 2 * hstep;
    const unsigned ldsw = (unsigned)wid * 1024u;
    const int aoff = lds_byte(wr * 64 + fr, fq * 8), boff = lds_byte(wc * 32 + fr, fq * 8);
#define PG8_SA(b, h) (((b) * 2 + (h)) * HTB)
#define PG8_SB(b, h) ((4 + (b) * 2 + (h)) * HTB)
#define PG8_STAGE(bufoff, gbase, voff) do { _Pragma("unroll") for (int _i = 0; _i < 2; ++_i) \
        __builtin_amdgcn_global_load_lds((const unsigned*)((const char*)(gbase) + (voff)[_i]), (PG8_LAS unsigned*)(lds + (bufoff) + ldsw + _i * 8192), 16, 0, 0); } while (0)
#define PG8_LDA(dst, b, h) do { _Pragma("unroll") for (int m = 0; m < 4; ++m) _Pragma("unroll") for (int k = 0; k < 2; ++k) dst[m][k] = *(const PG8_LAS bf16x8*)(lds + PG8_SA(b, h) + aoff + m * 2048 + k * 1024); } while (0)
#define PG8_LDB(dst, b, h) do { _Pragma("unroll") for (int n = 0; n < 2; ++n) _Pragma("unroll") for (int k = 0; k < 2; ++k) dst[n][k] = *(const PG8_LAS bf16x8*)(lds + PG8_SB(b, h) + boff + n * 2048 + k * 1024); } while (0)
#define PG8_MMA(ai, bj, At, Bt) do { __builtin_amdgcn_s_setprio(1); _Pragma("unroll") for (int m = 0; m < 4; ++m) _Pragma("unroll") for (int n = 0; n < 2; ++n) _Pragma("unroll") for (int k = 0; k < 2; ++k) \
        acc[ai][bj][m][n] = __builtin_amdgcn_mfma_f32_16x16x32_bf16(Bt[n][k], At[m][k], acc[ai][bj][m][n], 0, 0, 0); __builtin_amdgcn_s_setprio(0); } while (0)
#define PG8_WAIT_V(n) asm volatile("s_waitcnt vmcnt(" #n ")" ::: "memory")
#define PG8_WAIT_L(n) asm volatile("s_waitcnt lgkmcnt(" #n ")" ::: "memory")
#define PG8_BAR __builtin_amdgcn_s_barrier()
#define PG8_SCHED __builtin_amdgcn_sched_barrier(0)
    Unit cur, nxt; int ui = 0;
    if (!S.next(0, cur)) return;
    f32x4 acc[2][2][4][2];
#pragma unroll
    for (int a = 0; a < 2; ++a)
#pragma unroll
        for (int b = 0; b < 2; ++b)
#pragma unroll
            for (int m = 0; m < 4; ++m)
#pragma unroll
                for (int n = 0; n < 2; ++n) acc[a][b][m][n] = (f32x4){0.f, 0.f, 0.f, 0.f};
    bf16x8 At[4][2], B0[2][2], B1[2][2];
    const char* cA = (const char*)g.A + (size_t)cur.pm * tstep; const char* cB = (const char*)g.Bt + (size_t)cur.pn * tstep;
    S.a_ready(cur);
    if constexpr (SP2) {
        PG8_STAGE(PG8_SB(0, 0), cB, voffB); PG8_STAGE(PG8_SB(0, 1), cB + hstep, voffB); PG8_STAGE(PG8_SA(0, 0), cA, voffA); PG8_STAGE(PG8_SA(0, 1), cA + hstep, voffA);
        if (wr == 1) PG8_BAR;
        PG8_WAIT_V(2); PG8_BAR;
        PG8_STAGE(PG8_SB(1, 0), cB + kstep, voffB); PG8_STAGE(PG8_SA(1, 0), cA + kstep, voffA); PG8_STAGE(PG8_SB(1, 1), cB + hstep + kstep, voffB);
        PG8_WAIT_V(6); PG8_BAR;
    } else {
        PG8_STAGE(PG8_SB(0, 0), cB, voffB); PG8_STAGE(PG8_SA(0, 0), cA, voffA); PG8_STAGE(PG8_SB(0, 1), cB + hstep, voffB); PG8_STAGE(PG8_SA(0, 1), cA + hstep, voffA);
        if (wr == 1) PG8_BAR;
        PG8_WAIT_V(4); PG8_BAR;
        PG8_STAGE(PG8_SB(1, 0), cB + kstep, voffB); PG8_STAGE(PG8_SA(1, 0), cA + kstep, voffA); PG8_STAGE(PG8_SB(1, 1), cB + hstep + kstep, voffB);
        PG8_WAIT_V(6); PG8_BAR;
    }
    for (;;) {
        const bool has_next = S.next(ui + 1, nxt);
        const char* nA = has_next ? (const char*)g.A + (size_t)nxt.pm * tstep : cA; const char* nB = has_next ? (const char*)g.Bt + (size_t)nxt.pn * tstep : cB;
        for (int t = 0; t < nt; t += 2) {
            const bool last = (t == nt - 2);
            const char* a1 = cA + (size_t)(t + 1) * kstep;
            const char* a2 = last ? nA : cA + (size_t)(t + 2) * kstep; const char* b2 = last ? nB : cB + (size_t)(t + 2) * kstep;
            const char* a3 = a2 + kstep; const char* b3 = b2 + kstep;
            if (last && has_next) S.a_ready(nxt);
            if constexpr (SP2) {
            PG8_LDB(B0, 0, 0); PG8_LDB(B1, 0, 1); PG8_SCHED; PG8_LDA(At, 0, 0); PG8_STAGE(PG8_SA(1, 1), a1 + hstep, voffA);
            PG8_WAIT_V(8); PG8_WAIT_L(0); PG8_BAR; PG8_MMA(0, 0, At, B0); PG8_MMA(0, 1, At, B1); PG8_BAR; PG8_SCHED;
            PG8_LDA(At, 0, 1); PG8_STAGE(PG8_SB(0, 0), b2, voffB); PG8_STAGE(PG8_SB(0, 1), b2 + hstep, voffB); PG8_STAGE(PG8_SA(0, 0), a2, voffA);
            PG8_WAIT_V(8); PG8_WAIT_L(0); PG8_BAR; PG8_MMA(1, 0, At, B0); PG8_MMA(1, 1, At, B1); PG8_BAR; PG8_SCHED;
            PG8_LDB(B0, 1, 0); PG8_LDB(B1, 1, 1); PG8_SCHED; PG8_LDA(At, 1, 0); PG8_STAGE(PG8_SA(0, 1), a2 + hstep, voffA);
            PG8_WAIT_V(8); PG8_WAIT_L(0); PG8_BAR; PG8_MMA(0, 0, At, B0); PG8_MMA(0, 1, At, B1); PG8_BAR; PG8_SCHED;
            PG8_LDA(At, 1, 1); PG8_STAGE(PG8_SB(1, 0), b3, voffB); PG8_STAGE(PG8_SB(1, 1), b3 + hstep, voffB); PG8_STAGE(PG8_SA(1, 0), a3, voffA);
            PG8_WAIT_V(8); PG8_WAIT_L(0); PG8_BAR; PG8_MMA(1, 0, At, B0); PG8_MMA(1, 1, At, B1); PG8_BAR; PG8_SCHED;
            } else {
            PG8_LDB(B0, 0, 0); PG8_SCHED; PG8_LDA(At, 0, 0); PG8_STAGE(PG8_SA(1, 1), a1 + hstep, voffA);
            PG8_WAIT_L(8); PG8_BAR; PG8_WAIT_L(0); PG8_MMA(0, 0, At, B0); PG8_BAR; PG8_SCHED;
            PG8_LDB(B1, 0, 1); PG8_STAGE(PG8_SB(0, 0), b2, voffB);
            PG8_BAR; PG8_WAIT_L(0); PG8_MMA(0, 1, At, B1); PG8_BAR;
            PG8_LDA(At, 0, 1); PG8_STAGE(PG8_SA(0, 0), a2, voffA);
            PG8_BAR; PG8_WAIT_L(0); PG8_MMA(1, 0, At, B0); PG8_BAR; PG8_SCHED;
            PG8_STAGE(PG8_SB(0, 1), b2 + hstep, voffB);
            PG8_WAIT_V(6); PG8_BAR; PG8_MMA(1, 1, At, B1); PG8_BAR;
            PG8_LDB(B0, 1, 0); PG8_SCHED; PG8_LDA(At, 1, 0); PG8_STAGE(PG8_SA(0, 1), a2 + hstep, voffA);
            PG8_WAIT_L(8); PG8_BAR; PG8_WAIT_L(0); PG8_MMA(0, 0, At, B0); PG8_BAR; PG8_SCHED;
            PG8_LDB(B1, 1, 1); PG8_STAGE(PG8_SB(1, 0), b3, voffB);
            PG8_BAR; PG8_WAIT_L(0); PG8_MMA(0, 1, At, B1); PG8_BAR;
            PG8_LDA(At, 1, 1); PG8_STAGE(PG8_SA(1, 0), a3, voffA);
            PG8_BAR; PG8_WAIT_L(0); PG8_MMA(1, 0, At, B0); PG8_BAR; PG8_SCHED;
            PG8_STAGE(PG8_SB(1, 1), b3 + hstep, voffB);
            PG8_WAIT_V(6); PG8_BAR; PG8_MMA(1, 1, At, B1); PG8_BAR;
            }
        }
        if constexpr (ALIGN_EPI) { if (wr == 0) PG8_BAR; }
        if constexpr (!Epi::AFTER_DRAIN) { E(acc, cur, wr, wc, fr, fq); S.done(cur); }
        if (!has_next) break;
#pragma unroll
        for (int a = 0; a < 2; ++a)
#pragma unroll
            for (int b = 0; b < 2; ++b)
#pragma unroll
                for (int m = 0; m < 4; ++m)
#pragma unroll
                    for (int n = 0; n < 2; ++n) acc[a][b][m][n] = (f32x4){0.f, 0.f, 0.f, 0.f};
        cur = nxt; cA = nA; cB = nB; ++ui;
        if constexpr (ALIGN_EPI) { if (wr == 1) PG8_BAR; }
    }
    PG8_WAIT_V(0);
    if constexpr (!ALIGN_EPI) { if (wr == 0) PG8_BAR; }
    PG8_BAR;
    if constexpr (Epi::AFTER_DRAIN) { E.fused(acc, cur, wr, wc, fr, fq, lds, wid, lane); S.done(cur); }
#undef PG8_SA
#undef PG8_SB
#undef PG8_STAGE
#undef PG8_LDA
#undef PG8_LDB
#undef PG8_MMA
#undef PG8_WAIT_V
#undef PG8_WAIT_L
#undef PG8_BAR
#undef PG8_SCHED
}
}


constexpr int NWAVES = 8;
constexpr int DM = 1024, BATCH = 16, SEQ = 2048, MTOK = BATCH * SEQ, HB = 8, MH = HB * SEQ, DFF = 2816, NGU = 2 * DFF, NIN = 6144, DEPTH = 2, KUP = 384;
constexpr int NFOX = 6, NSB = 5, NDSA = 5;
constexpr int C_QA = 0, C_KA = 384, C_VA = 768, C_QB = 1152, C_KB = 1472, C_VB = 1792, C_QC = 2112, C_CKV = 2432, C_QI = 2560, C_GATE = 3072;
constexpr int F_KI = 0, F_FA = 64, F_WI = 70;
constexpr float EPS = 1e-6f;

constexpr size_t MiB = 1u << 20;
constexpr size_t WS_CTL = 0, CTL_ZERO_BYTES = 1 * MiB;
constexpr size_t WS_WGU1 = 2 * MiB, WS_WD1 = 13 * MiB, WS_WIN = 19 * MiB, WS_WUP = 31 * MiB, WS_WOUT = 34 * MiB, WS_WGU2 = 36 * MiB, WS_WD2 = 47 * MiB;
constexpr size_t WS_XB = 54 * MiB;
constexpr size_t WS_SSQ = 118 * MiB;
constexpr size_t WS_P = 120 * MiB;
constexpr size_t WS_HFF = 120 * MiB;
constexpr size_t WS_PF = 312 * MiB;
constexpr size_t WS_YA = 328 * MiB, WS_YB = 340 * MiB, WS_YC = 352 * MiB;
constexpr size_t WS_MGF = 364 * MiB;
constexpr size_t WS_MGB = 428 * MiB;
constexpr size_t WS_KC = 460 * MiB, WS_VC = 462 * MiB, WS_KI = 464 * MiB;
constexpr size_t WS_CF = 466 * MiB;
constexpr size_t WS_END = 468 * MiB;
constexpr int CW_BAR = 4096;
constexpr int MAX_LAUNCHES = 60;

constexpr int RING_OFF = 0, RING_BYTES = 131072;
constexpr int LDSCTL_OFF = RING_BYTES, MISC_OFF = LDSCTL_OFF + 320;
constexpr int LDS_BYTES = 147456;

#define GAS __attribute__((address_space(1)))
#define LAS __attribute__((address_space(3)))
typedef unsigned short bf16;
typedef unsigned v4u __attribute__((ext_vector_type(4)));
typedef float f32x4 __attribute__((ext_vector_type(4)));
typedef short bf16x8 __attribute__((ext_vector_type(8)));
typedef GAS unsigned gu32;
typedef GAS unsigned long long gu64;
#define RLX_AGENT __ATOMIC_RELAXED, __HIP_MEMORY_SCOPE_AGENT
#define LDS_WAIT() asm volatile("s_waitcnt lgkmcnt(0)" ::: "memory")
#define VM_WAIT() asm volatile("s_waitcnt vmcnt(0)" ::: "memory")
__device__ __forceinline__ unsigned long long rt() { return __builtin_amdgcn_s_memrealtime(); }
__device__ __forceinline__ unsigned f2bf(float f) { unsigned u = __builtin_bit_cast(unsigned, f); return (u + 0x7fffu + ((u >> 16) & 1u)) >> 16; }
__device__ __forceinline__ unsigned pk2(float lo, float hi) { return f2bf(lo) | (f2bf(hi) << 16); }

#define XB_TMO      128
#define XB_XCNT(j)  (256  + 64 * (j))
#define XB_XSUB(j)  (1280 + 64 * (j))
#define XB_XGEN(j)  (2304 + 64 * (j))
#define XB_TOP      3328
#define XB_TOPGEN   3392
#define XCD_BAR_WORDS 3456
#define XB_SPIN_CAP (1u << 18)

__device__ __forceinline__ unsigned xb_ld(unsigned* p)              { return __hip_atomic_load(p, __ATOMIC_RELAXED, __HIP_MEMORY_SCOPE_AGENT); }
__device__ __forceinline__ unsigned xb_add(unsigned* p, unsigned v) { return __hip_atomic_fetch_add(p, v, __ATOMIC_RELAXED, __HIP_MEMORY_SCOPE_AGENT); }
__device__ __forceinline__ unsigned xb_xcc_id() { return (unsigned)__builtin_amdgcn_s_getreg((3 << 11) | 20) & 0xFu; }
#define XB_SPIN(cond, bar) do { unsigned _sp = 0; while (cond) { __builtin_amdgcn_s_sleep(1); \
    if ((++_sp & 255u) == 0u) { if (xb_ld(&(bar)[XB_TMO])) break; if (_sp > XB_SPIN_CAP) { atomicAdd(&(bar)[XB_TMO], 1u); break; } } } } while (0)

struct XcdBarrier {
    unsigned* bar; unsigned x;
    volatile LAS unsigned* st;
};

__device__ __forceinline__ XcdBarrier xcd_barrier_post(unsigned* bar, volatile LAS unsigned* st) {
    XcdBarrier b; b.bar = bar; b.x = xb_xcc_id(); b.st = st;
    if (threadIdx.x == 0) (void)xb_add(&bar[XB_XCNT(b.x)], 1u);
    return b;
}
__device__ __forceinline__ void xcd_barrier_complete(unsigned* bar, unsigned x, unsigned& nloc, unsigned& nx) {
    const unsigned G = gridDim.x * gridDim.y * gridDim.z;
    unsigned sum, cnt, mine, sp = 0u;
    for (;;) {
        sum = 0u; cnt = 0u; mine = 0u;
#pragma unroll
        for (unsigned j = 0; j < 16; ++j) { const unsigned c = xb_ld(&bar[XB_XCNT(j)]); sum += c; cnt += (c > 0u) ? 1u : 0u; mine = (j == x) ? c : mine; }
        if (sum == G) break;
        __builtin_amdgcn_s_sleep(1);
        if ((++sp & 255u) == 0u) { if (xb_ld(&bar[XB_TMO])) break; if (sp > XB_SPIN_CAP) { atomicAdd(&bar[XB_TMO], 1u); break; } }
    }
    nloc = mine > 0u ? mine : 1u; nx = cnt > 0u ? cnt : 1u;
}

__device__ __forceinline__ void xcd_barrier(const XcdBarrier& b) {
    asm volatile("s_waitcnt vmcnt(0)" ::: "memory");
    __syncthreads();
    if (threadIdx.x == 0) {
        unsigned* bar = b.bar; unsigned bx_ = b.x; asm volatile("" : "+s"(bar), "+s"(bx_));
        __builtin_amdgcn_s_waitcnt(0);
        unsigned nloc = b.st[0], nx = b.st[1];
        if (nloc == 0u) { xcd_barrier_complete(bar, bx_, nloc, nx); b.st[0] = nloc; b.st[1] = nx; }
        const unsigned old = xb_add(&bar[XB_XSUB(bx_)], 1u);
        const unsigned gen = old / nloc;
        if (old + 1u == (gen + 1u) * nloc) {
            __builtin_amdgcn_fence(__ATOMIC_RELEASE, "agent");
            asm volatile("s_waitcnt vmcnt(0)" ::: "memory");
            const unsigned og = xb_add(&bar[XB_TOP], 1u);
            const unsigned tg = og / nx;
            if (og + 1u == (tg + 1u) * nx) xb_add(&bar[XB_TOPGEN], 1u);
            else XB_SPIN(xb_ld(&bar[XB_TOPGEN]) == tg, bar);
            __builtin_amdgcn_fence(__ATOMIC_ACQUIRE, "agent");
            xb_add(&bar[XB_XGEN(bx_)], 1u);
            asm volatile("s_waitcnt vmcnt(0)" ::: "memory");
        } else {
            XB_SPIN(xb_ld(&bar[XB_XGEN(bx_)]) == gen, bar);
            __builtin_amdgcn_fence(__ATOMIC_ACQUIRE, "agent");
            asm volatile("s_waitcnt vmcnt(0)" ::: "memory");
        }
    }
    __syncthreads();
}


typedef unsigned u32x2 __attribute__((ext_vector_type(2)));
__device__ __forceinline__ float bflo(unsigned w) { return __uint_as_float(w << 16); }
__device__ __forceinline__ float bfhi(unsigned w) { return __uint_as_float(w & 0xffff0000u); }
__device__ __forceinline__ float bf2f(bf16 v) { return __uint_as_float((unsigned)v << 16); }
__device__ __forceinline__ float wave_sum(float v) {
#pragma unroll
    for (int o = 1; o < 64; o <<= 1) v += __shfl_xor(v, o);
    return v;
}
__device__ __forceinline__ float wave_max(float v) {
#pragma unroll
    for (int o = 1; o < 64; o <<= 1) v = fmaxf(v, __shfl_xor(v, o));
    return v;
}
__device__ __forceinline__ void rope_cs(int pos, int i, float& c, float& s) {
    const float cf = i == 0 ? 0.15915494309189535f : i == 1 ? 0.03086376340470123f : i == 2 ? 0.005985185712713705f : i == 3 ? 0.001160663641240061f
                   : i == 4 ? 0.00022507907903927653f : i == 5 ? 4.364795279280289e-05f : i == 6 ? 8.464330808241401e-06f : 1.6414262627950345e-06f;
    const float hi = __uint_as_float(__float_as_uint(cf) & 0xfffff000u), lo = cf - hi;
    const float p = (float)pos; const float a = p * hi; float r = a - floorf(a); r += p * lo;
    s = __builtin_amdgcn_sinf(r); c = __builtin_amdgcn_cosf(r);
}

template <int MODE> __device__ __forceinline__ int colmap(int n) {
    if (MODE == 0) return n;
    if (MODE == 1) { const int t = n >> 8, r = n & 255; return r < 128 ? t * 128 + r : DFF + t * 128 + (r - 128); }
    if (n < 1152) return n;
    if (n < 2880) return n + 6;
    if (n < 2886) return n - 2880 + 1152;
    if (n < 2890) return n;
    if (n < 3072) return -1;
    return n - 182;
}
template <int MODE> __device__ __forceinline__ void conv_job(const float* W, int Nsrc, int Ksrc, const float* gain, bf16* WT, int Ndst, int Kdst, LAS float* scr, int gw, int ngw, int lane) {
    const int nblk = Ndst / 32, nitems = (Kdst / 64) * nblk;
    for (int it = gw; it < nitems; it += ngw) {
        const int kb = it / nblk, nb = it % nblk, k0 = 64 * kb, n0 = 32 * nb;
        const int sc = colmap<MODE>(n0 + (lane & 31));
#pragma unroll 8
        for (int i = 0; i < 32; ++i) { const int kk = 2 * i + (lane >> 5), k = k0 + kk; float v = 0.f;
            if (sc >= 0 && k < Ksrc) { v = W[(size_t)k * Nsrc + sc]; if (gain) v *= gain[k]; }
            scr[kk * 33 + (lane & 31)] = v; }
        LDS_WAIT(); asm volatile("" ::: "memory");
        const int c = lane & 7;
#pragma unroll
        for (int j = 0; j < 4; ++j) { const int n = (lane >> 3) + 8 * j; const LAS float* s = scr + (8 * c) * 33 + n;
            v4u o; o.x = pk2(s[0 * 33], s[1 * 33]); o.y = pk2(s[2 * 33], s[3 * 33]); o.z = pk2(s[4 * 33], s[5 * 33]); o.w = pk2(s[6 * 33], s[7 * 33]);
            *(GAS v4u*)(WT + (size_t)(n0 + n) * Kdst + k0 + 8 * c) = o; }
        LDS_WAIT(); asm volatile("" ::: "memory");
    }
}

__device__ __forceinline__ void fox_naive(const bf16* P, const float* CF, bf16* YA, int b, int h, int tg, int lane) {
    const int t = tg * 64 + lane; const size_t rowq = (size_t)b * SEQ + t;
    float q[64], o[64];
    { const v4u* qp = (const v4u*)(P + rowq * NIN + C_QA + h * 64);
#pragma unroll
      for (int j = 0; j < 8; ++j) { const v4u w = qp[j]; q[8 * j + 0] = bflo(w.x) * 0.125f; q[8 * j + 1] = bfhi(w.x) * 0.125f; q[8 * j + 2] = bflo(w.y) * 0.125f; q[8 * j + 3] = bfhi(w.y) * 0.125f;
          q[8 * j + 4] = bflo(w.z) * 0.125f; q[8 * j + 5] = bfhi(w.z) * 0.125f; q[8 * j + 6] = bflo(w.w) * 0.125f; q[8 * j + 7] = bfhi(w.w) * 0.125f; } }
#pragma unroll
    for (int d = 0; d < 64; ++d) o[d] = 0.f;
    float m = -INFINITY, l = 0.f;
    const float* cf = CF + (size_t)(b * NFOX + h) * SEQ;
    const bf16* kbase = P + (size_t)b * SEQ * NIN + C_KA + h * 64; const bf16* vbase = P + (size_t)b * SEQ * NIN + C_VA + h * 64;
    const int smax = tg * 64 + 63;
    for (int s = 0; s <= smax; ++s) {
        const v4u* kp = (const v4u*)(kbase + (size_t)s * NIN);
        float d0 = 0.f, d1 = 0.f;
#pragma unroll
        for (int j = 0; j < 8; ++j) { const v4u w = kp[j];
            d0 += q[8 * j + 0] * bflo(w.x); d1 += q[8 * j + 1] * bfhi(w.x); d0 += q[8 * j + 2] * bflo(w.y); d1 += q[8 * j + 3] * bfhi(w.y);
            d0 += q[8 * j + 4] * bflo(w.z); d1 += q[8 * j + 5] * bfhi(w.z); d0 += q[8 * j + 6] * bflo(w.w); d1 += q[8 * j + 7] * bfhi(w.w); }
        const float logit = (d0 + d1) - cf[s];
        if (s <= t) {
            const float mn = fmaxf(m, logit), a = __expf(m - mn), p = __expf(logit - mn); l = l * a + p; m = mn;
            const v4u* vp = (const v4u*)(vbase + (size_t)s * NIN);
#pragma unroll
            for (int j = 0; j < 8; ++j) { const v4u w = vp[j];
                o[8 * j + 0] = o[8 * j + 0] * a + p * bflo(w.x); o[8 * j + 1] = o[8 * j + 1] * a + p * bfhi(w.x); o[8 * j + 2] = o[8 * j + 2] * a + p * bflo(w.y); o[8 * j + 3] = o[8 * j + 3] * a + p * bfhi(w.y);
                o[8 * j + 4] = o[8 * j + 4] * a + p * bflo(w.z); o[8 * j + 5] = o[8 * j + 5] * a + p * bfhi(w.z); o[8 * j + 6] = o[8 * j + 6] * a + p * bflo(w.w); o[8 * j + 7] = o[8 * j + 7] * a + p * bfhi(w.w); }
        }
    }
    const float il = 1.0f / l;
    v4u* op = (v4u*)(YA + rowq * KUP + h * 64);
#pragma unroll
    for (int j = 0; j < 8; ++j) { v4u w; w.x = pk2(o[8 * j + 0] * il, o[8 * j + 1] * il); w.y = pk2(o[8 * j + 2] * il, o[8 * j + 3] * il); w.z = pk2(o[8 * j + 4] * il, o[8 * j + 5] * il); w.w = pk2(o[8 * j + 6] * il, o[8 * j + 7] * il); op[j] = w; }
}
__device__ __forceinline__ void sb_naive(const bf16* P, bf16* YB, int b, int h, int tg, int lane) {
    const int t = tg * 64 + lane; const size_t rowq = (size_t)b * SEQ + t;
    float q[64], o[64];
    { const v4u* qp = (const v4u*)(P + rowq * NIN + C_QB + h * 64);
#pragma unroll
      for (int j = 0; j < 8; ++j) { const v4u w = qp[j]; q[8 * j + 0] = bflo(w.x) * 0.125f; q[8 * j + 1] = bfhi(w.x) * 0.125f; q[8 * j + 2] = bflo(w.y) * 0.125f; q[8 * j + 3] = bfhi(w.y) * 0.125f;
          q[8 * j + 4] = bflo(w.z) * 0.125f; q[8 * j + 5] = bfhi(w.z) * 0.125f; q[8 * j + 6] = bflo(w.w) * 0.125f; q[8 * j + 7] = bfhi(w.w) * 0.125f; } }
#pragma unroll
    for (int d = 0; d < 64; ++d) o[d] = 0.f;
    float R = 0.f;
    const bf16* kbase = P + (size_t)b * SEQ * NIN + C_KB + h * 64; const bf16* vbase = P + (size_t)b * SEQ * NIN + C_VB + h * 64;
    for (int s = tg * 64 + 62; s >= 0; --s) {
        const v4u* kp = (const v4u*)(kbase + (size_t)s * NIN);
        float d0 = 0.f, d1 = 0.f;
#pragma unroll
        for (int j = 0; j < 8; ++j) { const v4u w = kp[j];
            d0 += q[8 * j + 0] * bflo(w.x); d1 += q[8 * j + 1] * bfhi(w.x); d0 += q[8 * j + 2] * bflo(w.y); d1 += q[8 * j + 3] * bfhi(w.y);
            d0 += q[8 * j + 4] * bflo(w.z); d1 += q[8 * j + 5] * bfhi(w.z); d0 += q[8 * j + 6] * bflo(w.w); d1 += q[8 * j + 7] * bfhi(w.w); }
        if (s < t) {
            const float z = d0 + d1, sp = fmaxf(z, 0.f) + __logf(1.0f + __expf(-fabsf(z)));
            const float a = __expf((z - sp) + R); R -= sp;
            const v4u* vp = (const v4u*)(vbase + (size_t)s * NIN);
#pragma unroll
            for (int j = 0; j < 8; ++j) { const v4u w = vp[j];
                o[8 * j + 0] += a * bflo(w.x); o[8 * j + 1] += a * bfhi(w.x); o[8 * j + 2] += a * bflo(w.y); o[8 * j + 3] += a * bfhi(w.y);
                o[8 * j + 4] += a * bflo(w.z); o[8 * j + 5] += a * bfhi(w.z); o[8 * j + 6] += a * bflo(w.w); o[8 * j + 7] += a * bfhi(w.w); }
        }
    }
    v4u* op = (v4u*)(YB + rowq * KUP + h * 64);
#pragma unroll
    for (int j = 0; j < 8; ++j) { v4u w; w.x = pk2(o[8 * j + 0], o[8 * j + 1]); w.y = pk2(o[8 * j + 2], o[8 * j + 3]); w.z = pk2(o[8 * j + 4], o[8 * j + 5]); w.w = pk2(o[8 * j + 6], o[8 * j + 7]); op[j] = w; }
}
__device__ __forceinline__ unsigned wave_sum_u(unsigned v) {
#pragma unroll
    for (int o = 1; o < 64; o <<= 1) v += (unsigned)__shfl_xor((int)v, o);
    return v;
}
__device__ __forceinline__ unsigned count_ge(const unsigned (&key)[32], unsigned cand) {
    unsigned c = 0;
#pragma unroll
    for (int i = 0; i < 32; ++i) c += (key[i] >= cand) ? 1u : 0u;
    return wave_sum_u(c);
}
__device__ __forceinline__ void dsa_naive(const bf16* P, const float* Pf, const bf16* KI, const bf16* KC, const bf16* VC, bf16* YC, int b, int t, int lane, LAS float* scr) {
    asm volatile("" : "+v"(lane));
    LAS float* qi = scr; LAS float* wv = scr + 256; LAS float* qc = scr + 264; LAS unsigned* sk = (LAS unsigned*)(scr + 584); LAS float* pr = scr + 584; LAS unsigned* list = (LAS unsigned*)(scr + 584 + 2048);
    const size_t row = (size_t)b * SEQ + t; const int N = 64 * (t / 64 + 1);
#pragma unroll
    for (int j = 0; j < 4; ++j) qi[j * 64 + lane] = bf2f(P[row * NIN + C_QI + j * 64 + lane]);
#pragma unroll
    for (int j = 0; j < 5; ++j) qc[j * 64 + lane] = bf2f(P[row * NIN + C_QC + j * 64 + lane]) * 0.125f;
    if (lane < 4) wv[lane] = Pf[row * 256 + F_WI + lane];
    LDS_WAIT(); asm volatile("" ::: "memory");
    const float w0 = wv[0], w1 = wv[1], w2 = wv[2], w3 = wv[3];
    for (int i = 0; i * 64 < N; ++i) {
        const int s = i * 64 + lane;
        const v4u* kp = (const v4u*)(KI + ((size_t)b * SEQ + s) * 64);
        float a0 = 0.f, a1 = 0.f, a2 = 0.f, a3 = 0.f;
#pragma unroll 1
        for (int j = 0; j < 8; ++j) { const v4u w = kp[j]; float kv[8] = {bflo(w.x), bfhi(w.x), bflo(w.y), bfhi(w.y), bflo(w.z), bfhi(w.z), bflo(w.w), bfhi(w.w)};
#pragma unroll
            for (int e = 0; e < 8; e += 4) {
                const f32x4 q0 = *(const LAS f32x4*)(qi + 0 * 64 + 8 * j + e), q1 = *(const LAS f32x4*)(qi + 1 * 64 + 8 * j + e), q2 = *(const LAS f32x4*)(qi + 2 * 64 + 8 * j + e), q3 = *(const LAS f32x4*)(qi + 3 * 64 + 8 * j + e);
#pragma unroll
                for (int x = 0; x < 4; ++x) { a0 = fmaf(q0[x], kv[e + x], a0); a1 = fmaf(q1[x], kv[e + x], a1); a2 = fmaf(q2[x], kv[e + x], a2); a3 = fmaf(q3[x], kv[e + x], a3); } } }
        float sc = fmaf(w3, fmaxf(a3, 0.f), fmaf(w2, fmaxf(a2, 0.f), fmaf(w1, fmaxf(a1, 0.f), w0 * fmaxf(a0, 0.f)))) + 0.0f;
        const unsigned ub = __float_as_uint(sc); sk[s] = (ub & 0x80000000u) ? ~ub : (ub | 0x80000000u);
    }
    LDS_WAIT(); asm volatile("" ::: "memory");
    unsigned key[32];
#pragma unroll
    for (int i = 0; i < 32; ++i) key[i] = (i * 64 < N) ? sk[i * 64 + lane] : 0u;
    LDS_WAIT(); asm volatile("" ::: "memory");
    unsigned T = 0u; int J = 4096;
    if (N > 256) {
        for (int bit = 31; bit >= 0; --bit) { const unsigned cand = T | (1u << bit); if (count_ge(key, cand) >= 256u) T = cand; }
        unsigned cgt = 0, ceq = 0;
#pragma unroll
        for (int i = 0; i < 32; ++i) { cgt += (key[i] > T) ? 1u : 0u; ceq += (key[i] == T) ? 1u : 0u; }
        cgt = wave_sum_u(cgt); ceq = wave_sum_u(ceq);
        const unsigned need = 256u - cgt;
        if (ceq > need) {
            int Jf = 0;
            for (int bit = 10; bit >= 0; --bit) { const int cand = Jf | (1 << bit); unsigned c = 0;
#pragma unroll
                for (int i = 0; i < 32; ++i) c += (key[i] == T && (i * 64 + lane) < cand) ? 1u : 0u;
                if (wave_sum_u(c) < need) Jf = cand; }
            J = Jf;
        }
    }
    asm volatile("" : "+v"(lane));
    int L = 0;
#pragma unroll
    for (int i = 0; i < 32; ++i) { const int s = i * 64 + lane; const bool pred = (i * 64 < N) && (key[i] > T || (key[i] == T && s <= J));
        const unsigned long long mk = __ballot(pred); const int pos = L + (int)__builtin_amdgcn_mbcnt_hi((unsigned)(mk >> 32), __builtin_amdgcn_mbcnt_lo((unsigned)mk, 0u));
        if (pred && pos < 256) list[pos] = (unsigned)s; L += (int)__popcll(mk); }
    if (L > 256) L = 256;
    LDS_WAIT(); asm volatile("" ::: "memory");
    float lg[5][4];
#pragma unroll
    for (int j = 0; j < 4; ++j) {
        const int e = j * 64 + lane; const bool valid = e < L; const unsigned s = valid ? list[e] : 0u;
        const v4u* kp = (const v4u*)(KC + ((size_t)b * SEQ + s) * 64);
        float a[5] = {0.f, 0.f, 0.f, 0.f, 0.f};
#pragma unroll 1
        for (int jj = 0; jj < 8; ++jj) { const v4u w = kp[jj]; float kv[8] = {bflo(w.x), bfhi(w.x), bflo(w.y), bfhi(w.y), bflo(w.z), bfhi(w.z), bflo(w.w), bfhi(w.w)};
#pragma unroll
            for (int e4 = 0; e4 < 8; e4 += 4)
#pragma unroll
                for (int hh = 0; hh < 5; ++hh) { const f32x4 qv = *(const LAS f32x4*)(qc + hh * 64 + 8 * jj + e4);
#pragma unroll
                    for (int x = 0; x < 4; ++x) a[hh] = fmaf(qv[x], kv[e4 + x], a[hh]); } }
#pragma unroll
        for (int hh = 0; hh < 5; ++hh) lg[hh][j] = valid ? a[hh] : -INFINITY;
    }
#pragma unroll
    for (int hh = 0; hh < 5; ++hh) {
        const float mx = wave_max(fmaxf(fmaxf(lg[hh][0], lg[hh][1]), fmaxf(lg[hh][2], lg[hh][3])));
        float p[4], sm = 0.f;
#pragma unroll
        for (int j = 0; j < 4; ++j) { p[j] = __expf(lg[hh][j] - mx); sm += p[j]; }
        const float inv = 1.0f / wave_sum(sm);
#pragma unroll
        for (int j = 0; j < 4; ++j) pr[hh * 256 + j * 64 + lane] = p[j] * inv;
    }
    LDS_WAIT(); asm volatile("" ::: "memory");
    float o[5] = {0.f, 0.f, 0.f, 0.f, 0.f};
    for (int e = 0; e < L; e += 4) {
        const v4u ids = *(const LAS v4u*)(list + e);
        const float v0 = bf2f(VC[((size_t)b * SEQ + ids.x) * 64 + lane]), v1 = bf2f(VC[((size_t)b * SEQ + ids.y) * 64 + lane]), v2 = bf2f(VC[((size_t)b * SEQ + ids.z) * 64 + lane]), v3 = bf2f(VC[((size_t)b * SEQ + ids.w) * 64 + lane]);
#pragma unroll
        for (int hh = 0; hh < 5; ++hh) { const f32x4 pv = *(const LAS f32x4*)(pr + hh * 256 + e); o[hh] += pv[0] * v0 + pv[1] * v1 + pv[2] * v2 + pv[3] * v3; }
    }
#pragma unroll
    for (int hh = 0; hh < 5; ++hh) YC[row * KUP + hh * 64 + lane] = (bf16)f2bf(o[hh]);
    LDS_WAIT(); asm volatile("" ::: "memory");
}


struct Args { const float* in[18]; float* out; unsigned char* ws; int ph_lo, ph_hi, li, pad; };

__global__ void __launch_bounds__(NWAVES * 64, 2) mk_fwd(Args args) {
    extern __shared__ __attribute__((aligned(16))) unsigned char lds_raw[];
    LAS unsigned char* lds = (LAS unsigned char*)lds_raw;
    volatile LAS unsigned* MISC = (volatile LAS unsigned*)(lds + MISC_OFF);
    const int tid = threadIdx.x, lane0 = tid & 63, wave0 = __builtin_amdgcn_readfirstlane(tid >> 6);
    const int G0 = gridDim.x; const int bx0 = blockIdx.x; const int vcu = (G0 % 8 == 0) ? (bx0 % 8) * (G0 / 8) + bx0 / 8 : bx0;
    const int gw0 = vcu * NWAVES + wave0;
    unsigned char* ws0 = args.ws;
    gu32* ctl = (gu32*)(ws0 + WS_CTL);
    for (int u = tid; u < (LDS_BYTES - LDSCTL_OFF) / 4; u += NWAVES * 64) ((LAS unsigned*)(lds + LDSCTL_OFF))[u] = 0u;
    __syncthreads();
    XcdBarrier bar = xcd_barrier_post((unsigned*)(ctl + CW_BAR) + args.li * XCD_BAR_WORDS, MISC + 8);
    const int lo = args.ph_lo, hi = args.ph_hi;
    int ph = 0;
#define PH_BEGIN if (ph >= lo && ph < hi) { unsigned char* ws = ws0; float* xf = args.out; int lane = lane0, wave = wave0, gw = gw0, G = G0, bx = bx0; asm volatile("" : "+s"(ws), "+s"(xf), "+v"(lane), "+s"(wave), "+s"(gw), "+s"(G), "+s"(bx)); const int NGW = G * NWAVES;
#define PH_END   if (ph + 1 < hi) xcd_barrier(bar); } ++ph;

#define WGU1 ((bf16*)(ws + WS_WGU1))
#define WD1 ((bf16*)(ws + WS_WD1))
#define WIN ((bf16*)(ws + WS_WIN))
#define WUP ((bf16*)(ws + WS_WUP))
#define WOUT ((bf16*)(ws + WS_WOUT))
#define WGU2 ((bf16*)(ws + WS_WGU2))
#define WD2 ((bf16*)(ws + WS_WD2))
#define XB ((bf16*)(ws + WS_XB))
#define SSQ ((float*)(ws + WS_SSQ))
#define P ((bf16*)(ws + WS_P))
#define HFF ((bf16*)(ws + WS_HFF))
#define PF ((float*)(ws + WS_PF))
#define YA ((bf16*)(ws + WS_YA))
#define YB ((bf16*)(ws + WS_YB))
#define YC ((bf16*)(ws + WS_YC))
#define MGF ((float*)(ws + WS_MGF))
#define MGB ((bf16*)(ws + WS_MGB))
#define KC ((bf16*)(ws + WS_KC))
#define VC ((bf16*)(ws + WS_VC))
#define KI ((bf16*)(ws + WS_KI))
#define CF ((float*)(ws + WS_CF))
#define XF (xf)
#define scr ((LAS float*)(lds + RING_OFF + wave * 16384))
#define CONV_FFN(l, which) do { const float* gg = args.in[(which) ? 14 : 1] + (size_t)(l) * DM; const float* wgu = args.in[(which) ? 15 : 2] + (size_t)(l) * DM * NGU; const float* wd = args.in[(which) ? 16 : 3] + (size_t)(l) * DFF * DM; \
        conv_job<1>(wgu, NGU, DM, gg, (which) ? WGU2 : WGU1, NGU, DM, scr, gw, NGW, lane); conv_job<0>(wd, DM, DFF, nullptr, (which) ? WD2 : WD1, DM, DFF, scr, gw, NGW, lane); } while (0)
#define CONV_MIX(l) do { conv_job<2>(args.in[5] + (size_t)(l) * DM * 5962, 5962, DM, args.in[4] + (size_t)(l) * DM, WIN, NIN, DM, scr, gw, NGW, lane); \
        conv_job<0>(args.in[10] + (size_t)(l) * 384 * DM, DM, 384, nullptr, WUP, DM, KUP, scr, gw, NGW, lane); \
        conv_job<0>(args.in[11] + (size_t)(l) * 320 * DM, DM, 320, nullptr, WUP + (size_t)DM * KUP, DM, KUP, scr, gw, NGW, lane); \
        conv_job<0>(args.in[12] + (size_t)(l) * 320 * DM, DM, 320, nullptr, WUP + (size_t)2 * DM * KUP, DM, KUP, scr, gw, NGW, lane); \
        conv_job<0>(args.in[13] + (size_t)(l) * DM * DM, DM, DM, nullptr, WOUT, DM, DM, scr, gw, NGW, lane); } while (0)

    PH_BEGIN
        CONV_FFN(0, 0); CONV_MIX(0); CONV_FFN(0, 1);
        const float* x = args.in[0];
        for (int m = gw; m < MTOK; m += NGW) {
            const GAS f32x4* xr = (const GAS f32x4*)(x + (size_t)m * DM) + lane; GAS u32x2* o8 = (GAS u32x2*)(XB + (size_t)m * DM) + lane; float s = 0.f;
#pragma unroll
            for (int j = 0; j < 4; ++j) { const f32x4 v = xr[64 * j]; s += (v[0] * v[0] + v[1] * v[1]) + (v[2] * v[2] + v[3] * v[3]); u32x2 w; w.x = pk2(v[0], v[1]); w.y = pk2(v[2], v[3]); o8[64 * j] = w; }
            s = wave_sum(s);
            if (lane < 16) SSQ[(size_t)m * 16 + lane] = lane == 0 ? s : 0.f;
        }
    PH_END

    for (int layer = 0; layer < DEPTH; ++layer) {
        for (int f = 0; f < 2; ++f) {
            PH_BEGIN
                pg8::Gemm g{XB, f ? WGU2 : WGU1, MTOK, NGU, DM}; pg8::StaticOrder S; S.init(MTOK, NGU, G, bx);
                pg8::EpiSwiglu E{SSQ, HFF, DFF};
                pg8::gemm_phase<pg8::EpiSwiglu, pg8::StaticOrder, true, true>(lds + RING_OFF, g, S, E);
                if (f == 0 && layer + 1 < DEPTH) {   }
                if (f == 0) {   }
                if (f == 1 && layer + 1 < DEPTH) CONV_MIX(layer + 1);
            PH_END
            PH_BEGIN
                pg8::Gemm g{HFF, f ? WD2 : WD1, MTOK, DM, DFF}; pg8::StaticOrder S; S.init(MTOK, DM, G, bx);
                pg8::EpiResid E{(layer == 0 && f == 0) ? args.in[0] : XF, XF, XB, SSQ, 0.5f};
                pg8::gemm_phase<pg8::EpiResid, pg8::StaticOrder, true, true>(lds + RING_OFF, g, S, E);
            PH_END
            if (f == 1) break;
            for (int hf = 0; hf < 2; ++hf) {
                const size_t rb = (size_t)hf * MH;
                PH_BEGIN
                    pg8::Gemm g{XB + rb * DM, WIN, MH, NIN, DM}; pg8::StaticOrder S; S.init(MH, NIN, G, bx);
                    pg8::EpiWin E{SSQ + rb * 16, P, PF, NIN};
                    pg8::gemm_phase<pg8::EpiWin, pg8::StaticOrder, true, true>(lds + RING_OFF, g, S, E);
                PH_END
                PH_BEGIN
                    if (gw < HB * NFOX) {
                        const int bl = gw / NFOX, h = gw % NFOX; const float bfg = args.in[6][layer * NFOX + h]; float carry = 0.f;
                        for (int c = 0; c < SEQ / 64; ++c) {
                            const int t = c * 64 + lane; const float fv = PF[((size_t)bl * SEQ + t) * 256 + F_FA + h] + bfg;
                            float v = fminf(fv, 0.f) - __logf(1.0f + __expf(-fabsf(fv)));
#pragma unroll
                            for (int o = 1; o < 64; o <<= 1) { const float n = __shfl_up(v, o); if (lane >= o) v += n; }
                            v += carry; CF[((size_t)bl * NFOX + h) * SEQ + t] = v; carry = __shfl(v, 63);
                        }
                    }
                    const float* gkv = args.in[7] + layer * 128; const float* wkv = args.in[8] + (size_t)layer * 128 * 128; const float* gik = args.in[9] + layer * 64;
                    for (int r = gw; r < MH; r += NGW) {
                        const int pos = r % SEQ; const int i8 = lane & 7;
                        float rc, rsn; rope_cs(pos, i8, rc, rsn);
                        const float c0 = bf2f(P[(size_t)r * NIN + C_CKV + lane]), c1 = bf2f(P[(size_t)r * NIN + C_CKV + 64 + lane]);
                        const float rn = 1.0f / sqrtf(wave_sum(c0 * c0 + c1 * c1) * (1.0f / 128.0f) + EPS);
                        scr[lane] = c0 * rn * gkv[lane]; scr[64 + lane] = c1 * rn * gkv[64 + lane];
                        LDS_WAIT(); asm volatile("" ::: "memory");
                        float kc = 0.f, vc = 0.f;
#pragma unroll 8
                        for (int k = 0; k < 128; ++k) { const float cn = scr[k]; kc = fmaf(cn, wkv[k * 128 + lane], kc); vc = fmaf(cn, wkv[k * 128 + 64 + lane], vc); }
                        { const float other = __shfl_xor(kc, 8); if (lane < 8) kc = kc * rc - other * rsn; else if (lane < 16) kc = kc * rc + other * rsn; }
                        KC[(size_t)r * 64 + lane] = (bf16)f2bf(kc); VC[(size_t)r * 64 + lane] = (bf16)f2bf(vc);

                        { const int hh = lane >> 3;
                          if (hh < 5) { bf16* p = P + (size_t)r * NIN + C_QC + hh * 64; const float x1 = bf2f(p[i8]), x2 = bf2f(p[i8 + 8]); p[i8] = (bf16)f2bf(x1 * rc - x2 * rsn); p[i8 + 8] = (bf16)f2bf(x2 * rc + x1 * rsn); }
                          if (hh < 4) { bf16* p = P + (size_t)r * NIN + C_QI + hh * 64; const float x1 = bf2f(p[i8]), x2 = bf2f(p[i8 + 8]); p[i8] = (bf16)f2bf(x1 * rc - x2 * rsn); p[i8 + 8] = (bf16)f2bf(x2 * rc + x1 * rsn); } }
                        { const float v = PF[(size_t)r * 256 + F_KI + lane]; const float rn2 = 1.0f / sqrtf(wave_sum(v * v) * (1.0f / 64.0f) + EPS); float y = v * rn2 * gik[lane];
                          const float other = __shfl_xor(y, 8); if (lane < 8) y = y * rc - other * rsn; else if (lane < 16) y = y * rc + other * rsn;
                          KI[(size_t)r * 64 + lane] = (bf16)f2bf(y); }
                        YB[(size_t)r * KUP + 320 + lane] = 0; YC[(size_t)r * KUP + 320 + lane] = 0;
                        LDS_WAIT(); asm volatile("" ::: "memory");
                    }
                    if (hf == 0 && layer + 1 < DEPTH) CONV_FFN(layer + 1, 0);
                    if (hf == 0 && layer >= 1) CONV_FFN(layer, 1);
                PH_END
                PH_BEGIN
                    { const int wu = gw; if (wu < HB * NFOX * 32) { const int tg = 31 - wu / (HB * NFOX), bh = wu % (HB * NFOX); fox_naive(P, CF, YA, bh / NFOX, bh % NFOX, tg, lane); } }
                    { const int su = NGW - 1 - gw; if (su >= 0 && su < HB * NSB * 32) { const int tg = 31 - su / (HB * NSB), bh = su % (HB * NSB); sb_naive(P, YB, bh / NSB, bh % NSB, tg, lane); } }
                    for (int qx = gw; qx < MH; qx += NGW) { const int t = SEQ - 1 - qx / HB, b = qx % HB; dsa_naive(P, PF, KI, KC, VC, YC, b, t, lane, scr); }
                PH_END
                PH_BEGIN
                    pg8::StaticOrder S; S.init(MH, DM, G, bx);
                    { pg8::Gemm g{YA, WUP, MH, DM, KUP}; pg8::EpiGate<0> E{P + C_GATE, NIN, MGF, MGB}; pg8::gemm_phase<pg8::EpiGate<0>, pg8::StaticOrder, true, true>(lds + RING_OFF, g, S, E); }
                    { pg8::Gemm g{YB, WUP + (size_t)DM * KUP, MH, DM, KUP}; pg8::EpiGate<1> E{P + C_GATE + DM, NIN, MGF, MGB}; pg8::gemm_phase<pg8::EpiGate<1>, pg8::StaticOrder, true, true>(lds + RING_OFF, g, S, E); }
                    { pg8::Gemm g{YC, WUP + (size_t)2 * DM * KUP, MH, DM, KUP}; pg8::EpiGate<2> E{P + C_GATE + 2 * DM, NIN, MGF, MGB}; pg8::gemm_phase<pg8::EpiGate<2>, pg8::StaticOrder, true, true>(lds + RING_OFF, g, S, E); }
                PH_END
                PH_BEGIN
                    pg8::Gemm g{MGB, WOUT, MH, DM, DM}; pg8::StaticOrder S; S.init(MH, DM, G, bx);
                    pg8::EpiResid E{XF + rb * DM, XF + rb * DM, XB + rb * DM, SSQ + rb * 16, 1.0f};
                    pg8::gemm_phase<pg8::EpiResid, pg8::StaticOrder, true, true>(lds + RING_OFF, g, S, E);
                PH_END
            }
        }
    }
    PH_BEGIN
        const float* gf = args.in[17];
        for (int m = gw; m < MTOK; m += NGW) {
            GAS f32x4* xr = (GAS f32x4*)(XF + (size_t)m * DM) + lane; const GAS f32x4* gr = (const GAS f32x4*)gf + lane; f32x4 v[4]; float s = 0.f;
#pragma unroll
            for (int j = 0; j < 4; ++j) { v[j] = xr[64 * j]; s += (v[j][0] * v[j][0] + v[j][1] * v[j][1]) + (v[j][2] * v[j][2] + v[j][3] * v[j][3]); }
            const float rs = 1.0f / sqrtf(wave_sum(s) * (1.0f / DM) + EPS);
#pragma unroll
            for (int j = 0; j < 4; ++j) xr[64 * j] = v[j] * rs * gr[64 * j];
        }
    PH_END
#undef PH_BEGIN
#undef PH_END
}

#ifndef MK_N_LAUNCHES
#define MK_N_LAUNCHES 1
#endif
constexpr int N_PHASES = 1 + DEPTH * (2 + 2 * 5 + 2) + 1;
extern "C" void kernel_launch(void* const* d_in, const int* in_sizes, int n_in, void* d_out, int out_size, void* d_ws, size_t ws_size, hipStream_t stream) {
    static int grid = 0;
    if (grid == 0) {
        if (n_in != 18 || in_sizes[0] != MTOK * DM || out_size != MTOK * DM || ws_size < WS_END) { fprintf(stderr, "kernel_launch: unexpected shapes (n_in %d, in0 %d, out %d, ws %zu); nothing launched\n", n_in, n_in > 0 ? in_sizes[0] : -1, out_size, ws_size); grid = -1; return; }
        int dev = 0, cus = 0, per_cu = 0;
        if (hipGetDevice(&dev) != hipSuccess || hipDeviceGetAttribute(&cus, hipDeviceAttributeMultiprocessorCount, dev) != hipSuccess) { grid = -1; return; }
        if (hipFuncSetAttribute((const void*)mk_fwd, hipFuncAttributeMaxDynamicSharedMemorySize, LDS_BYTES) != hipSuccess) { fprintf(stderr, "kernel_launch: hipFuncSetAttribute failed\n"); grid = -1; return; }
        if (hipOccupancyMaxActiveBlocksPerMultiprocessor(&per_cu, (const void*)mk_fwd, NWAVES * 64, LDS_BYTES) != hipSuccess || per_cu < 1) fprintf(stderr, "kernel_launch: occupancy query reports %d workgroups per CU\n", per_cu);
        (void)hipGetLastError();
        grid = cus;
        if (grid > 256) grid = 256;
    }
    if (grid < 0) return;
    if (hipMemsetAsync((char*)d_ws + WS_CTL, 0, CTL_ZERO_BYTES, stream) != hipSuccess) return;
    Args a{};
    for (int i = 0; i < 18; ++i) a.in[i] = (const float*)d_in[i];
    a.out = (float*)d_out; a.ws = (unsigned char*)d_ws; a.pad = 0;
    const int nl = MK_N_LAUNCHES;
    for (int li = 0; li < nl; ++li) {
        a.ph_lo = (int)((long)N_PHASES * li / nl); a.ph_hi = (int)((long)N_PHASES * (li + 1) / nl); a.li = li;
        hipLaunchKernelGGL(mk_fwd, dim3(grid), dim3(NWAVES * 64), LDS_BYTES, stream, a);
        const hipError_t le = hipPeekAtLastError();
        if (le != hipSuccess) { fprintf(stderr, "kernel_launch: launch %d failed: %s\n", li, hipGetErrorName(le)); break; }
    }
}
```

```cpp
#include <hip/hip_runtime.h>
#include <cstdio>
#include <cstdint>
#include <cmath>
namespace pg8 {
#define PG8_LAS __attribute__((address_space(3)))
typedef unsigned short bf16_t;
typedef short bf16x8 __attribute__((ext_vector_type(8)));
typedef float f32x4 __attribute__((ext_vector_type(4)));
typedef unsigned u32x4 __attribute__((ext_vector_type(4)));
constexpr int BM = 256, BK = 64, HALF = 128, HTB = HALF * BK * 2  , STAGE_BYTES = 8 * HTB, NXCD = 8, WGM = 8;

__host__ __device__ __forceinline__ int lds_byte(int r, int c) { const int st = (r >> 4) * 2 + (c >> 5), rr = r & 15, cc = c & 31, ob = rr * 64 + cc * 2; return st * 1024 + (ob ^ (((ob >> 9) & 1) << 5)); }
__host__ __device__ __forceinline__ void stage_rc(int b, int& R, int& C) { const int st = b / 1024, sb = b % 1024, swz = sb ^ (((sb >> 9) & 1) << 5); R = (st >> 1) * 16 + swz / 64; C = (st & 1) * 32 + (swz % 64) / 2; }
__host__ __device__ __forceinline__ int perm32(int rho) { const int n = rho >> 4, i = rho & 15; return 8 * (i >> 2) + 4 * n + (i & 3); }

struct Unit { int pm, pn, ks, ui; };
struct Gemm { const bf16_t* A; const bf16_t* Bt; int M, N, K, ld; };

struct StaticOrder {
    int nM, nN, nwg, G, c;
    __host__ __device__ void init(int M, int N, int G_, int c_) { nM = M / BM; nN = N / BM; nwg = nM * nN; G = G_; c = c_; }
    __host__ __device__ bool next(int i, Unit& u) const {
        const long L = (long)i * G + c; if (L >= nwg) return false;
        int wgid = (int)L; { const int q = nwg / NXCD, r = nwg % NXCD, xcd = wgid % NXCD, off = wgid / NXCD; wgid = (xcd < r ? xcd * (q + 1) : r * (q + 1) + (xcd - r) * q) + off; }
        const int nig = WGM * nN, gid = wgid / nig, fm = gid * WGM, gsz = (nM - fm) < WGM ? (nM - fm) : WGM;
        u.pm = fm + ((wgid % nig) % gsz); u.pn = (wgid % nig) / gsz; u.ks = 0; u.ui = i; return true;
    }
    __device__ __forceinline__ void a_ready(const Unit&) const {}
    __device__ __forceinline__ void done(const Unit&) const {}
};

__device__ __forceinline__ unsigned cvt_pk_bf16(float lo, float hi) { unsigned r; asm volatile("v_cvt_pk_bf16_f32 %0, %1, %2" : "=v"(r) : "v"(lo), "v"(hi)); return r; }
typedef float f32x2 __attribute__((ext_vector_type(2)));

#define PG8_GAS __attribute__((address_space(1)))
__device__ __forceinline__ float row_rs(const float* ssq, int row) {
    const f32x4* p = (const f32x4*)(ssq + (size_t)row * 16);
    const f32x4 a = p[0], b = p[1], c = p[2], d = p[3];
    const float s = (((a[0] + a[1]) + (a[2] + a[3])) + ((b[0] + b[1]) + (b[2] + b[3]))) + (((c[0] + c[1]) + (c[2] + c[3])) + ((d[0] + d[1]) + (d[2] + d[3])));
    return 1.0f / sqrtf(s * (1.0f / 1024.0f) + 1e-6f);
}
__device__ __forceinline__ float sigmoid_f(float v) { return __builtin_amdgcn_rcpf(1.0f + __expf(-v)); }
__device__ __forceinline__ float bf_lo(unsigned w) { return __uint_as_float(w << 16); }
__device__ __forceinline__ float bf_hi(unsigned w) { return __uint_as_float(w & 0xffff0000u); }

template <class Sched> __device__ __forceinline__ void rs_table_fill(PG8_LAS float* rsT, const float* ssq, const Sched& S, int tid) {
    Unit u; const int row = tid >> 1, hf = tid & 1;
    f32x4 a[12], b[12]; int n = 0;
#pragma unroll
    for (int i = 0; i < 12; ++i) { if (S.next(i, u)) { const PG8_GAS f32x4* p = (const PG8_GAS f32x4*)(ssq + (size_t)(u.pm * BM + row) * 16 + 8 * hf); a[i] = p[0]; b[i] = p[1]; n = i + 1; } else { a[i] = f32x4{}; b[i] = f32x4{}; } }
#pragma unroll
    for (int i = 0; i < 12; ++i) {
        float s = ((a[i][0] + a[i][1]) + (a[i][2] + a[i][3])) + ((b[i][0] + b[i][1]) + (b[i][2] + b[i][3]));
        s += __int_as_float(__builtin_amdgcn_ds_bpermute(((tid & 63) ^ 1) << 2, __float_as_int(s)));
        if (hf == 0 && i < n) rsT[i * BM + row] = 1.0f / sqrtf(s * (1.0f / 1024.0f) + 1e-6f);
    }
    __syncthreads();
}
#define PIN8(a) asm volatile("" : "+v"((a)[0]), "+v"((a)[1]), "+v"((a)[2]), "+v"((a)[3]), "+v"((a)[4]), "+v"((a)[5]), "+v"((a)[6]), "+v"((a)[7]))
#define PIN4X2(a) asm volatile("" : "+v"((a)[0]), "+v"((a)[1]), "+v"((a)[2]), "+v"((a)[3]))
struct EpiSwiglu {
    static constexpr bool PERM = true, AFTER_DRAIN = false, CARRY = false;
    const PG8_LAS float* rsT; bf16_t* H; int ldh;
    __device__ __forceinline__ void operator()(const f32x4 (&acc)[2][2][4][2], const Unit& u, int wr, int wc, int fr, int fq) const {
        const int row0 = u.pm * BM + wr * 64 + fr, col0 = u.pn * HALF + wc * 32 + 8 * fq;
#pragma unroll
        for (int ai = 0; ai < 2; ++ai)
#pragma unroll
            for (int m = 0; m < 4; ++m) {
                const int row = row0 + ai * HALF + m * 16; const float r = rsT[u.ui * BM + wr * 64 + fr + ai * HALF + m * 16];
                const float rn = r * -1.4426950408889634f, rq = r * r;
                f32x2 g[4], p[4], t[4];
#pragma unroll
                for (int n = 0; n < 2; ++n) { const f32x4 G4 = acc[ai][0][m][n], U4 = acc[ai][1][m][n];
                    g[2 * n] = f32x2{G4[0], G4[1]}; g[2 * n + 1] = f32x2{G4[2], G4[3]}; p[2 * n] = f32x2{U4[0], U4[1]}; p[2 * n + 1] = f32x2{U4[2], U4[3]}; }
#pragma unroll
                for (int i = 0; i < 4; ++i) { t[i] = g[i] * rn; p[i] = g[i] * p[i]; }
                PIN4X2(t);
#pragma unroll
                for (int i = 0; i < 4; ++i) { t[i][0] = __builtin_amdgcn_exp2f(t[i][0]); t[i][1] = __builtin_amdgcn_exp2f(t[i][1]); }
                PIN4X2(t);
#pragma unroll
                for (int i = 0; i < 4; ++i) { t[i] = t[i] + 1.0f; p[i] = p[i] * rq; }
                PIN4X2(t);
#pragma unroll
                for (int i = 0; i < 4; ++i) { t[i][0] = __builtin_amdgcn_rcpf(t[i][0]); t[i][1] = __builtin_amdgcn_rcpf(t[i][1]); }
                PIN4X2(t);
#pragma unroll
                for (int i = 0; i < 4; ++i) t[i] = t[i] * p[i];
                u32x4 w; w.x = cvt_pk_bf16(t[0][0], t[0][1]); w.y = cvt_pk_bf16(t[1][0], t[1][1]); w.z = cvt_pk_bf16(t[2][0], t[2][1]); w.w = cvt_pk_bf16(t[3][0], t[3][1]);
                *(PG8_GAS u32x4*)(H + (size_t)row * ldh + col0) = w;
            }
    }
};
struct EpiResid {
    static constexpr bool PERM = true, AFTER_DRAIN = false, CARRY = false;
    bf16_t* xb; float* ssq; float alpha;
    __device__ __forceinline__ void operator()(const f32x4 (&acc)[2][2][4][2], const Unit& u, int wr, int wc, int fr, int fq) const {
        const int row0 = u.pm * BM + wr * 64 + fr, col0 = u.pn * BM + wc * 32 + 8 * fq;
#pragma unroll
        for (int ai = 0; ai < 2; ++ai)
        {
            u32x4 xov[4][2];
#pragma unroll
            for (int m = 0; m < 4; ++m)
#pragma unroll
                for (int bj = 0; bj < 2; ++bj) xov[m][bj] = *(const PG8_GAS u32x4*)(xb + (size_t)(row0 + ai * HALF + m * 16) * 1024 + col0 + bj * HALF);
#pragma unroll
            for (int m = 0; m < 4; ++m) {
                const int row = row0 + ai * HALF + m * 16; float sq = 0.f;
#pragma unroll
                for (int bj = 0; bj < 2; ++bj) {
                    const u32x4 xo = xov[m][bj];
                    f32x4 x0, x1; x0[0] = bf_lo(xo.x); x0[1] = bf_hi(xo.x); x0[2] = bf_lo(xo.y); x0[3] = bf_hi(xo.y); x1[0] = bf_lo(xo.z); x1[1] = bf_hi(xo.z); x1[2] = bf_lo(xo.w); x1[3] = bf_hi(xo.w);
                    x0 += acc[ai][bj][m][0] * alpha; x1 += acc[ai][bj][m][1] * alpha;
                    u32x4 w; w.x = cvt_pk_bf16(x0[0], x0[1]); w.y = cvt_pk_bf16(x0[2], x0[3]); w.z = cvt_pk_bf16(x1[0], x1[1]); w.w = cvt_pk_bf16(x1[2], x1[3]);
                    *(PG8_GAS u32x4*)(xb + (size_t)row * 1024 + col0 + bj * HALF) = w;
                    sq += ((x0[0] * x0[0] + x0[1] * x0[1]) + (x0[2] * x0[2] + x0[3] * x0[3])) + ((x1[0] * x1[0] + x1[1] * x1[1]) + (x1[2] * x1[2] + x1[3] * x1[3]));
                }
                { const int ln_ = fq * 16 + fr;
                  sq += __int_as_float(__builtin_amdgcn_ds_bpermute((ln_ ^ 16) << 2, __float_as_int(sq))); sq += __int_as_float(__builtin_amdgcn_ds_bpermute((ln_ ^ 32) << 2, __float_as_int(sq))); }
                if (fq == 0) *(PG8_GAS float*)(ssq + (size_t)row * 16 + u.pn * 4 + wc) = sq;
            }
        }
    }
};
struct EpiWin {
    static constexpr bool PERM = true, AFTER_DRAIN = false, CARRY = false;
    static constexpr int KA0 = 384, NHA = 6, KB0 = 1472, NHB = 5, SEQL = 2048; static constexpr long KAI_OFF = (364L - 120L) << 20, KBI_OFF = (376L - 120L) << 20;
    const PG8_LAS float* rsT; bf16_t* P; float* Pf; int ldp;
    __device__ __forceinline__ void operator()(const f32x4 (&acc)[2][2][4][2], const Unit& u, int wr, int wc, int fr, int fq) const {
        const int row0 = u.pm * BM + wr * 64 + fr, cin = wc * 32 + 8 * fq;
#pragma unroll
        for (int ai = 0; ai < 2; ++ai)
#pragma unroll
            for (int m = 0; m < 4; ++m) {
                const int row = row0 + ai * HALF + m * 16; const float r = rsT[u.ui * BM + wr * 64 + fr + ai * HALF + m * 16];
                if (u.pn == 11) {
#pragma unroll
                    for (int bj = 0; bj < 2; ++bj) { const f32x4 v0 = acc[ai][bj][m][0] * r, v1 = acc[ai][bj][m][1] * r;
                        PG8_GAS float* o = (PG8_GAS float*)(Pf + (size_t)row * 256 + cin + bj * HALF); *(PG8_GAS f32x4*)o = v0; *(PG8_GAS f32x4*)(o + 4) = v1; }
                } else if (u.pn >= 12) {
                    const float rn = r * -1.4426950408889634f;
                    f32x2 t[8];
#pragma unroll
                    for (int bj = 0; bj < 2; ++bj)
#pragma unroll
                        for (int n = 0; n < 2; ++n) { const f32x4 A4 = acc[ai][bj][m][n]; t[4 * bj + 2 * n] = f32x2{A4[0], A4[1]} * rn; t[4 * bj + 2 * n + 1] = f32x2{A4[2], A4[3]} * rn; }
                    PIN4X2(t); PIN4X2(t + 4);
#pragma unroll
                    for (int i = 0; i < 8; ++i) { t[i][0] = __builtin_amdgcn_exp2f(t[i][0]); t[i][1] = __builtin_amdgcn_exp2f(t[i][1]); }
                    PIN4X2(t); PIN4X2(t + 4);
#pragma unroll
                    for (int i = 0; i < 8; ++i) t[i] = t[i] + 1.0f;
                    PIN4X2(t); PIN4X2(t + 4);
#pragma unroll
                    for (int i = 0; i < 8; ++i) { t[i][0] = __builtin_amdgcn_rcpf(t[i][0]); t[i][1] = __builtin_amdgcn_rcpf(t[i][1]); }
#pragma unroll
                    for (int bj = 0; bj < 2; ++bj) { u32x4 w; w.x = cvt_pk_bf16(t[4 * bj][0], t[4 * bj][1]); w.y = cvt_pk_bf16(t[4 * bj + 1][0], t[4 * bj + 1][1]); w.z = cvt_pk_bf16(t[4 * bj + 2][0], t[4 * bj + 2][1]); w.w = cvt_pk_bf16(t[4 * bj + 3][0], t[4 * bj + 3][1]);
                        *(PG8_GAS u32x4*)(P + (size_t)row * ldp + u.pn * BM + cin + bj * HALF) = w; }
                } else {
#pragma unroll
                    for (int bj = 0; bj < 2; ++bj) { const f32x4 v0 = acc[ai][bj][m][0] * r, v1 = acc[ai][bj][m][1] * r;
                        u32x4 w; w.x = cvt_pk_bf16(v0[0], v0[1]); w.y = cvt_pk_bf16(v0[2], v0[3]); w.z = cvt_pk_bf16(v1[0], v1[1]); w.w = cvt_pk_bf16(v1[2], v1[3]);
                        const int gb = u.pn * BM + wc * 32 + bj * HALF;
                        const bool isKa = gb >= KA0 && gb < KA0 + 64 * NHA, isKb = gb >= KB0 && gb < KB0 + 64 * NHB;
                        if (isKa || isKb) {
                            const int rel = gb - (isKa ? KA0 : KB0), head = rel >> 6, c = ((rel & 63) >> 3) + fq, bt = row / SEQL, pos = row % SEQL;
                            bf16_t* img = (bf16_t*)((char*)P + (isKa ? KAI_OFF : KBI_OFF)) + (size_t)(bt * (isKa ? NHA : NHB) + head) * 64 * SEQL;
                            *(PG8_GAS u32x4*)(img + ((size_t)((pos >> 5) * 4 + (c >> 1)) * 64 + (pos & 31) + 32 * (c & 1)) * 8) = w;
                        } else *(PG8_GAS u32x4*)(P + (size_t)row * ldp + gb + 8 * fq) = w; }
                }
            }
    }
};
template <int MODE> struct EpiGate {
    static constexpr bool PERM = true, AFTER_DRAIN = false, CARRY = false;
    const bf16_t* G; int ldg; bf16_t* part; bf16_t* mgb;
    __device__ __forceinline__ void operator()(const f32x4 (&acc)[2][2][4][2], const Unit& u, int wr, int wc, int fr, int fq) const {
        const int row0 = u.pm * BM + wr * 64 + fr, col0 = u.pn * BM + wc * 32 + 8 * fq;
#pragma unroll
        for (int ai = 0; ai < 2; ++ai)
        {
            u32x4 gwv[4][2], pwv[4][2];
#pragma unroll
            for (int m = 0; m < 4; ++m)
#pragma unroll
                for (int bj = 0; bj < 2; ++bj) { const int row = row0 + ai * HALF + m * 16, col = col0 + bj * HALF;
                    gwv[m][bj] = *(const PG8_GAS u32x4*)(G + (size_t)row * ldg + col);
                    if (MODE >= 1) pwv[m][bj] = *(const PG8_GAS u32x4*)(part + (size_t)row * 1024 + col); }
#pragma unroll
            for (int m = 0; m < 4; ++m) {
                const int row = row0 + ai * HALF + m * 16;
#pragma unroll
                for (int bj = 0; bj < 2; ++bj) {
                    const int col = col0 + bj * HALF;
                    const u32x4 gw = gwv[m][bj];
                    f32x4 v0 = acc[ai][bj][m][0], v1 = acc[ai][bj][m][1];
                    v0[0] *= bf_lo(gw.x); v0[1] *= bf_hi(gw.x); v0[2] *= bf_lo(gw.y); v0[3] *= bf_hi(gw.y);
                    v1[0] *= bf_lo(gw.z); v1[1] *= bf_hi(gw.z); v1[2] *= bf_lo(gw.w); v1[3] *= bf_hi(gw.w);
                    if (MODE >= 1) { const u32x4 pw = pwv[m][bj];
                        v0[0] += bf_lo(pw.x); v0[1] += bf_hi(pw.x); v0[2] += bf_lo(pw.y); v0[3] += bf_hi(pw.y); v1[0] += bf_lo(pw.z); v1[1] += bf_hi(pw.z); v1[2] += bf_lo(pw.w); v1[3] += bf_hi(pw.w); }
                    u32x4 w; w.x = cvt_pk_bf16(v0[0], v0[1]); w.y = cvt_pk_bf16(v0[2], v0[3]); w.z = cvt_pk_bf16(v1[0], v1[1]); w.w = cvt_pk_bf16(v1[2], v1[3]);
                    *(PG8_GAS u32x4*)((MODE <= 1 ? part : mgb) + (size_t)row * 1024 + col) = w;
                }
            }
        }
    }
};

struct SegOrder3 : StaticOrder {
    __host__ __device__ bool next(int i, Unit& u) const { const bool ok = StaticOrder::next(i / 3, u); u.ks = i % 3; u.ui = i; return ok; }
};
struct EpiGateU {
    static constexpr bool PERM = true, AFTER_DRAIN = false, CARRY = false;
    const bf16_t* G; bf16_t* mgb; static constexpr int ldg = 6144;
    __device__ __forceinline__ void operator()(const f32x4 (&acc)[2][2][4][2], const Unit& u, int wr, int wc, int fr, int fq) const {
        const int row0 = u.pm * BM + wr * 64 + fr, col0 = u.pn * BM + wc * 32 + 8 * fq;
        const bf16_t* Gs = G + u.ks * 1024; const unsigned keep = u.ks ? 0xffffffffu : 0u;
#pragma unroll
        for (int ai = 0; ai < 2; ++ai)
        {
            u32x4 gwv[4][2], pwv[4][2];
#pragma unroll
            for (int m = 0; m < 4; ++m)
#pragma unroll
                for (int bj = 0; bj < 2; ++bj) { const int row = row0 + ai * HALF + m * 16, col = col0 + bj * HALF;
                    gwv[m][bj] = *(const PG8_GAS u32x4*)(Gs + (size_t)row * ldg + col);
                    pwv[m][bj] = *(const PG8_GAS u32x4*)(mgb + (size_t)row * 1024 + col); }
#pragma unroll
            for (int m = 0; m < 4; ++m) {
                const int row = row0 + ai * HALF + m * 16;
#pragma unroll
                for (int bj = 0; bj < 2; ++bj) {
                    const int col = col0 + bj * HALF;
                    const u32x4 gw = gwv[m][bj]; u32x4 pw = pwv[m][bj]; pw.x &= keep; pw.y &= keep; pw.z &= keep; pw.w &= keep;
                    f32x4 v0 = acc[ai][bj][m][0], v1 = acc[ai][bj][m][1];
                    v0[0] = fmaf(v0[0], bf_lo(gw.x), bf_lo(pw.x)); v0[1] = fmaf(v0[1], bf_hi(gw.x), bf_hi(pw.x)); v0[2] = fmaf(v0[2], bf_lo(gw.y), bf_lo(pw.y)); v0[3] = fmaf(v0[3], bf_hi(gw.y), bf_hi(pw.y));
                    v1[0] = fmaf(v1[0], bf_lo(gw.z), bf_lo(pw.z)); v1[1] = fmaf(v1[1], bf_hi(gw.z), bf_hi(pw.z)); v1[2] = fmaf(v1[2], bf_lo(gw.w), bf_lo(pw.w)); v1[3] = fmaf(v1[3], bf_hi(gw.w), bf_hi(pw.w));
                    u32x4 w; w.x = cvt_pk_bf16(v0[0], v0[1]); w.y = cvt_pk_bf16(v0[2], v0[3]); w.z = cvt_pk_bf16(v1[0], v1[1]); w.w = cvt_pk_bf16(v1[2], v1[3]);
                    *(PG8_GAS u32x4*)(mgb + (size_t)row * 1024 + col) = w;
                }
            }
        }
    }
};

struct EpiGateR {
    static constexpr bool PERM = true, AFTER_DRAIN = false, CARRY = true;
    const bf16_t* G; bf16_t* mgb; static constexpr int ldg = 6144;
    __device__ __forceinline__ void operator()(const f32x4 (&acc)[2][2][4][2], const Unit& u, int wr, int wc, int fr, int fq) const {
        if (u.ks != 2) return;
        const int row0 = u.pm * BM + wr * 64 + fr, col0 = u.pn * BM + wc * 32 + 8 * fq;
        const bf16_t* Gs = G + 2 * 1024;
#pragma unroll
        for (int ai = 0; ai < 2; ++ai)
        {
            u32x4 gwv[4][2];
#pragma unroll
            for (int m = 0; m < 4; ++m)
#pragma unroll
                for (int bj = 0; bj < 2; ++bj) gwv[m][bj] = *(const PG8_GAS u32x4*)(Gs + (size_t)(row0 + ai * HALF + m * 16) * ldg + col0 + bj * HALF);
#pragma unroll
            for (int m = 0; m < 4; ++m)
#pragma unroll
                for (int bj = 0; bj < 2; ++bj) {
                    const u32x4 gw = gwv[m][bj]; f32x4 v0 = acc[ai][bj][m][0], v1 = acc[ai][bj][m][1];
                    v0[0] *= bf_lo(gw.x); v0[1] *= bf_hi(gw.x); v0[2] *= bf_lo(gw.y); v0[3] *= bf_hi(gw.y); v1[0] *= bf_lo(gw.z); v1[1] *= bf_hi(gw.z); v1[2] *= bf_lo(gw.w); v1[3] *= bf_hi(gw.w);
                    u32x4 w; w.x = cvt_pk_bf16(v0[0], v0[1]); w.y = cvt_pk_bf16(v0[2], v0[3]); w.z = cvt_pk_bf16(v1[0], v1[1]); w.w = cvt_pk_bf16(v1[2], v1[3]);
                    *(PG8_GAS u32x4*)(mgb + (size_t)(row0 + ai * HALF + m * 16) * 1024 + col0 + bj * HALF) = w;
                }
        }
    }
    __device__ __forceinline__ void carry(f32x4 (&acc)[2][2][4][2], const Unit& u, int wr, int wc, int fr, int fq) const {
        const int row0 = u.pm * BM + wr * 64 + fr, col0 = u.pn * BM + wc * 32 + 8 * fq;
        const int kn = u.ks < 2 ? u.ks + 1 : 2; const float z = u.ks < 2 ? 1.0f : 0.0f;
        const bf16_t* Ga = G + u.ks * 1024; const bf16_t* Gb = G + kn * 1024;
#pragma unroll
        for (int ai = 0; ai < 2; ++ai)
#pragma unroll
        for (int mh = 0; mh < 2; ++mh)
        {
            u32x4 ga[2][2], gb[2][2];
#pragma unroll
            for (int m2 = 0; m2 < 2; ++m2)
#pragma unroll
                for (int bj = 0; bj < 2; ++bj) { const size_t o_ = (size_t)(row0 + ai * HALF + (2 * mh + m2) * 16) * ldg + col0 + bj * HALF; ga[m2][bj] = *(const PG8_GAS u32x4*)(Ga + o_); gb[m2][bj] = *(const PG8_GAS u32x4*)(Gb + o_); }
#pragma unroll
            for (int m2 = 0; m2 < 2; ++m2)
#pragma unroll
                for (int bj = 0; bj < 2; ++bj) { const int m = 2 * mh + m2; const u32x4 a_ = ga[m2][bj], b_ = gb[m2][bj];
                    float fa[8] = {bf_lo(a_.x), bf_hi(a_.x), bf_lo(a_.y), bf_hi(a_.y), bf_lo(a_.z), bf_hi(a_.z), bf_lo(a_.w), bf_hi(a_.w)};
                    float fb[8] = {bf_lo(b_.x), bf_hi(b_.x), bf_lo(b_.y), bf_hi(b_.y), bf_lo(b_.z), bf_hi(b_.z), bf_lo(b_.w), bf_hi(b_.w)};
#pragma unroll
                    for (int e_ = 0; e_ < 8; ++e_) fb[e_] = __builtin_amdgcn_rcpf(fb[e_]);
#pragma unroll
                    for (int e_ = 0; e_ < 8; ++e_) fa[e_] = fa[e_] * fb[e_] * z;
#pragma unroll
                    for (int n_ = 0; n_ < 2; ++n_) { f32x4 v_ = acc[ai][bj][m][n_];
                        asm volatile("v_mul_f32 %0, %0, %4\n\tv_mul_f32 %1, %1, %5\n\tv_mul_f32 %2, %2, %6\n\tv_mul_f32 %3, %3, %7" : "+v"(v_[0]), "+v"(v_[1]), "+v"(v_[2]), "+v"(v_[3]) : "v"(fa[4 * n_ + 0]), "v"(fa[4 * n_ + 1]), "v"(fa[4 * n_ + 2]), "v"(fa[4 * n_ + 3]));
                        acc[ai][bj][m][n_] = v_; } }
            asm volatile("" ::: "memory");
        }
    }
};

struct NoPre { __device__ __forceinline__ void operator()() const {} };
template <class Epi, class Sched, bool ALIGN_EPI = false, bool SP2 = false, class Pre = NoPre>
__device__ __forceinline__ void gemm_phase(PG8_LAS unsigned char* lds, const Gemm g, const Sched& S, const Epi& E, int tid_in, const Pre& pre = Pre()) {
    int tid_ = tid_in; asm volatile("" : "+v"(tid_));
    const int tid = tid_, wid = __builtin_amdgcn_readfirstlane(tid >> 6), lane = tid & 63, wr = wid >> 2, wc = wid & 3, fr = lane & 15, fq = lane >> 4;
    const int K = g.K, nt = K / BK, ld = g.ld ? g.ld : g.K;
    unsigned voffA[2], voffB[2];
#pragma unroll
    for (int i = 0; i < 2; ++i) { int R, C; stage_rc(tid * 16 + i * 8192, R, C); const int Rb = Epi::PERM ? ((R & ~31) + perm32(R & 31)) : R;
        voffA[i] = (unsigned)(R * ld + C) * 2u; voffB[i] = (unsigned)(Rb * ld + C) * 2u; }
    const size_t kstep = (size_t)(BK * 2);
    const size_t hstep = (size_t)HALF * ld * 2;
    const size_t tstep = 2 * hstep;
    const unsigned ldsw = (unsigned)wid * 1024u;
    const int aoff = lds_byte(wr * 64 + fr, fq * 8), boff = lds_byte(wc * 32 + fr, fq * 8);
#define PG8_SA(b, h) (((b) * 2 + (h)) * HTB)
#define PG8_SB(b, h) ((4 + (b) * 2 + (h)) * HTB)
#define PG8_STAGE(bufoff, gbase, voff) do { _Pragma("unroll") for (int _i = 0; _i < 2; ++_i) \
        __builtin_amdgcn_global_load_lds((const unsigned*)((const char*)(gbase) + (voff)[_i]), (PG8_LAS unsigned*)(lds + (bufoff) + ldsw + _i * 8192), 16, 0, 0); } while (0)
#define PG8_LDA(dst, b, h) do { _Pragma("unroll") for (int m = 0; m < 4; ++m) _Pragma("unroll") for (int k = 0; k < 2; ++k) dst[m][k] = *(const PG8_LAS bf16x8*)(lds + PG8_SA(b, h) + aoff + m * 2048 + k * 1024); } while (0)
#define PG8_LDB(dst, b, h) do { _Pragma("unroll") for (int n = 0; n < 2; ++n) _Pragma("unroll") for (int k = 0; k < 2; ++k) dst[n][k] = *(const PG8_LAS bf16x8*)(lds + PG8_SB(b, h) + boff + n * 2048 + k * 1024); } while (0)
#define PG8_MMA(ai, bj, At, Bt) do { __builtin_amdgcn_s_setprio(1); _Pragma("unroll") for (int m = 0; m < 4; ++m) _Pragma("unroll") for (int n = 0; n < 2; ++n) _Pragma("unroll") for (int k = 0; k < 2; ++k) \
        acc[ai][bj][m][n] = __builtin_amdgcn_mfma_f32_16x16x32_bf16(Bt[n][k], At[m][k], acc[ai][bj][m][n], 0, 0, 0); __builtin_amdgcn_s_setprio(0); } while (0)
#define PG8_WAIT_V(n) asm volatile("s_waitcnt vmcnt(" #n ")" ::: "memory")
#define PG8_WAIT_L(n) asm volatile("s_waitcnt lgkmcnt(" #n ")" ::: "memory")
#define PG8_BAR __builtin_amdgcn_s_barrier()
#define PG8_SCHED __builtin_amdgcn_sched_barrier(0)
    Unit cur, nxt; int ui = 0;
    if (!S.next(0, cur)) return;
#define PG8_UNI(u_) do { (u_).pm = __builtin_amdgcn_readfirstlane((u_).pm); (u_).pn = __builtin_amdgcn_readfirstlane((u_).pn); (u_).ks = __builtin_amdgcn_readfirstlane((u_).ks); } while (0)
    PG8_UNI(cur);
    f32x4 acc[2][2][4][2];
#pragma unroll
    for (int a = 0; a < 2; ++a)
#pragma unroll
        for (int b = 0; b < 2; ++b)
#pragma unroll
            for (int m = 0; m < 4; ++m)
#pragma unroll
                for (int n = 0; n < 2; ++n) acc[a][b][m][n] = (f32x4){0.f, 0.f, 0.f, 0.f};
    bf16x8 At[4][2], B0[2][2], B1[2][2];
    const char* cA = (const char*)g.A + (size_t)cur.pm * tstep + (size_t)cur.ks * K * 2; const char* cB = (const char*)g.Bt + (size_t)cur.pn * tstep + (size_t)cur.ks * K * 2;
    S.a_ready(cur);
    if constexpr (SP2) {
        PG8_STAGE(PG8_SB(0, 0), cB, voffB); PG8_STAGE(PG8_SB(0, 1), cB + hstep, voffB); PG8_STAGE(PG8_SA(0, 0), cA, voffA); PG8_STAGE(PG8_SA(0, 1), cA + hstep, voffA);
        pre();
        if (wr == 1) PG8_BAR;
        PG8_WAIT_V(2); PG8_BAR;
        PG8_STAGE(PG8_SB(1, 0), cB + kstep, voffB); PG8_STAGE(PG8_SA(1, 0), cA + kstep, voffA); PG8_STAGE(PG8_SB(1, 1), cB + hstep + kstep, voffB);
        PG8_WAIT_V(6); PG8_BAR;
    } else {
        PG8_STAGE(PG8_SB(0, 0), cB, voffB); PG8_STAGE(PG8_SA(0, 0), cA, voffA); PG8_STAGE(PG8_SB(0, 1), cB + hstep, voffB); PG8_STAGE(PG8_SA(0, 1), cA + hstep, voffA);
        if (wr == 1) PG8_BAR;
        PG8_WAIT_V(4); PG8_BAR;
        PG8_STAGE(PG8_SB(1, 0), cB + kstep, voffB); PG8_STAGE(PG8_SA(1, 0), cA + kstep, voffA); PG8_STAGE(PG8_SB(1, 1), cB + hstep + kstep, voffB);
        PG8_WAIT_V(6); PG8_BAR;
    }
    for (;;) {
        const bool has_next = S.next(ui + 1, nxt); PG8_UNI(nxt);
        const char* nA = has_next ? (const char*)g.A + (size_t)nxt.pm * tstep + (size_t)nxt.ks * K * 2 : cA; const char* nB = has_next ? (const char*)g.Bt + (size_t)nxt.pn * tstep + (size_t)nxt.ks * K * 2 : cB;
        for (int t = 0; t < nt; t += 2) {
            const bool last = (t == nt - 2);
            const char* a1 = cA + (size_t)(t + 1) * kstep;
            const char* a2 = last ? nA : cA + (size_t)(t + 2) * kstep; const char* b2 = last ? nB : cB + (size_t)(t + 2) * kstep;
            const char* a3 = a2 + kstep; const char* b3 = b2 + kstep;
            if (last && has_next) S.a_ready(nxt);
            if constexpr (SP2) {
            PG8_LDB(B0, 0, 0); PG8_LDB(B1, 0, 1); PG8_SCHED; PG8_LDA(At, 0, 0); PG8_STAGE(PG8_SA(1, 1), a1 + hstep, voffA);
            PG8_WAIT_V(8); PG8_WAIT_L(0); PG8_BAR; PG8_MMA(0, 0, At, B0); PG8_MMA(0, 1, At, B1); PG8_BAR; PG8_SCHED;
            PG8_LDA(At, 0, 1); PG8_STAGE(PG8_SB(0, 0), b2, voffB); PG8_STAGE(PG8_SB(0, 1), b2 + hstep, voffB); PG8_STAGE(PG8_SA(0, 0), a2, voffA);
            PG8_WAIT_V(8); PG8_WAIT_L(0); PG8_BAR; PG8_MMA(1, 0, At, B0); PG8_MMA(1, 1, At, B1); PG8_BAR; PG8_SCHED;
            PG8_LDB(B0, 1, 0); PG8_LDB(B1, 1, 1); PG8_SCHED; PG8_LDA(At, 1, 0); PG8_STAGE(PG8_SA(0, 1), a2 + hstep, voffA);
            PG8_WAIT_V(8); PG8_WAIT_L(0); PG8_BAR; PG8_MMA(0, 0, At, B0); PG8_MMA(0, 1, At, B1); PG8_BAR; PG8_SCHED;
            PG8_LDA(At, 1, 1); PG8_STAGE(PG8_SB(1, 0), b3, voffB); PG8_STAGE(PG8_SB(1, 1), b3 + hstep, voffB); PG8_STAGE(PG8_SA(1, 0), a3, voffA);
            PG8_WAIT_V(8); PG8_WAIT_L(0); PG8_BAR; PG8_MMA(1, 0, At, B0); PG8_MMA(1, 1, At, B1); PG8_BAR; PG8_SCHED;
            } else {
            PG8_LDB(B0, 0, 0); PG8_SCHED; PG8_LDA(At, 0, 0); PG8_STAGE(PG8_SA(1, 1), a1 + hstep, voffA);
            PG8_WAIT_L(8); PG8_BAR; PG8_WAIT_L(0); PG8_MMA(0, 0, At, B0); PG8_BAR; PG8_SCHED;
            PG8_LDB(B1, 0, 1); PG8_STAGE(PG8_SB(0, 0), b2, voffB);
            PG8_BAR; PG8_WAIT_L(0); PG8_MMA(0, 1, At, B1); PG8_BAR;
            PG8_LDA(At, 0, 1); PG8_STAGE(PG8_SA(0, 0), a2, voffA);
            PG8_BAR; PG8_WAIT_L(0); PG8_MMA(1, 0, At, B0); PG8_BAR; PG8_SCHED;
            PG8_STAGE(PG8_SB(0, 1), b2 + hstep, voffB);
            PG8_WAIT_V(6); PG8_BAR; PG8_MMA(1, 1, At, B1); PG8_BAR;
            PG8_LDB(B0, 1, 0); PG8_SCHED; PG8_LDA(At, 1, 0); PG8_STAGE(PG8_SA(0, 1), a2 + hstep, voffA);
            PG8_WAIT_L(8); PG8_BAR; PG8_WAIT_L(0); PG8_MMA(0, 0, At, B0); PG8_BAR; PG8_SCHED;
            PG8_LDB(B1, 1, 1); PG8_STAGE(PG8_SB(1, 0), b3, voffB);
            PG8_BAR; PG8_WAIT_L(0); PG8_MMA(0, 1, At, B1); PG8_BAR;
            PG8_LDA(At, 1, 1); PG8_STAGE(PG8_SA(1, 0), a3, voffA);
            PG8_BAR; PG8_WAIT_L(0); PG8_MMA(1, 0, At, B0); PG8_BAR; PG8_SCHED;
            PG8_STAGE(PG8_SB(1, 1), b3 + hstep, voffB);
            PG8_WAIT_V(6); PG8_BAR; PG8_MMA(1, 1, At, B1); PG8_BAR;
            }
        }
        if constexpr (ALIGN_EPI) { if (wr == 0) PG8_BAR; }
        if constexpr (!Epi::AFTER_DRAIN) { unsigned ln_e; asm volatile("v_mbcnt_lo_u32_b32 %0, -1, 0\n\tv_mbcnt_hi_u32_b32 %0, -1, %0" : "=v"(ln_e)); const int fr_e = (int)(ln_e & 15u), fq_e = (int)(ln_e >> 4);
            E(acc, cur, wr, wc, fr_e, fq_e);
#ifdef PG8_EPI_TWICE
            if constexpr (Epi::TWICE_OK) { asm volatile("" ::: "memory"); E(acc, cur, wr, wc, fr, fq); }
#endif
            S.done(cur); }
        if (!has_next) break;
        if constexpr (Epi::CARRY) {
            unsigned ln_c; asm volatile("v_mbcnt_lo_u32_b32 %0, -1, 0\n\tv_mbcnt_hi_u32_b32 %0, -1, %0" : "=v"(ln_c)); E.carry(acc, cur, wr, wc, (int)(ln_c & 15u), (int)(ln_c >> 4));
        } else {
#pragma unroll
        for (int a = 0; a < 2; ++a)
#pragma unroll
            for (int b = 0; b < 2; ++b)
#pragma unroll
                for (int m = 0; m < 4; ++m)
#pragma unroll
                    for (int n = 0; n < 2; ++n) acc[a][b][m][n] = (f32x4){0.f, 0.f, 0.f, 0.f};
        }
        cur = nxt; cA = nA; cB = nB; ++ui;
        if constexpr (ALIGN_EPI) { if (wr == 1) PG8_BAR; }
    }
    PG8_WAIT_V(0);
    if constexpr (!ALIGN_EPI) { if (wr == 0) PG8_BAR; }
    PG8_BAR;
    if constexpr (Epi::AFTER_DRAIN) { E.fused(acc, cur, wr, wc, fr, fq, lds, wid, lane); S.done(cur); }
#undef PG8_SA
#undef PG8_SB
#undef PG8_STAGE
#undef PG8_LDA
#undef PG8_LDB
#undef PG8_MMA
#undef PG8_WAIT_V
#undef PG8_WAIT_L
#undef PG8_BAR
#undef PG8_SCHED
}
}


constexpr int NWAVES = 8;
constexpr int DM = 1024, BATCH = 16, SEQ = 2048, MTOK = BATCH * SEQ, HB = 8, MH = HB * SEQ, DFF = 2816, NGU = 2 * DFF, NIN = 6144, DEPTH = 2, KUP = 1152  ;
constexpr int NFOX = 6, NSB = 5, NDSA = 5;
constexpr int C_QA = 0, C_KA = 384, C_VA = 768, C_QB = 1152, C_KB = 1472, C_VB = 1792, C_QC = 2112, C_CKV = 2432, C_QI = 2560, C_GATE = 3072;
constexpr int F_KI = 0, F_FA = 64, F_WI = 70;
constexpr float EPS = 1e-6f;

constexpr size_t MiB = 1u << 20;
constexpr size_t WS_CTL = 0, CTL_ZERO_BYTES = 1 * MiB;
constexpr size_t WS_WGU1 = 2 * MiB, WS_WD1 = 13 * MiB, WS_WIN = 19 * MiB, WS_WUP = 31 * MiB, WS_WOUT = 34 * MiB, WS_WGU2 = 36 * MiB, WS_WD2 = 47 * MiB;
constexpr size_t WS_XB = 54 * MiB;
constexpr size_t WS_SSQ = 118 * MiB;
constexpr size_t WS_P = 120 * MiB;
constexpr size_t WS_HFF = 120 * MiB;
constexpr size_t WS_PF = 312 * MiB;
constexpr size_t WS_Y = 328 * MiB;
constexpr size_t WS_KAI = 364 * MiB, WS_KBI = 376 * MiB;
constexpr size_t WS_MGB = 428 * MiB;
constexpr size_t WS_KC = 460 * MiB, WS_VC = 462 * MiB, WS_KI = 464 * MiB;
constexpr size_t WS_CF = 466 * MiB;
constexpr size_t WS_VTA = 468 * MiB, WS_VTB = 481 * MiB, WS_VTC = 492 * MiB;
constexpr size_t WS_END = 494 * MiB;
constexpr size_t WS_SINK = 960 * 1024;
constexpr int CW_BAR = 4096;
constexpr int MAX_LAUNCHES = 60;

constexpr int RING_OFF = 0, RING_BYTES = 131072;
constexpr int LDSCTL_OFF = RING_BYTES, MISC_OFF = LDSCTL_OFF + 320;
constexpr int VCT_OFF = 132096;
constexpr int RST_OFF = 132096;
constexpr int LDS_BYTES = 147456;

#define GAS __attribute__((address_space(1)))
#define LAS __attribute__((address_space(3)))
typedef unsigned short bf16;
typedef unsigned v4u __attribute__((ext_vector_type(4)));
typedef float f32x4 __attribute__((ext_vector_type(4)));
typedef short bf16x8 __attribute__((ext_vector_type(8)));
typedef GAS unsigned gu32;
typedef GAS unsigned long long gu64;
#define RLX_AGENT __ATOMIC_RELAXED, __HIP_MEMORY_SCOPE_AGENT
#define LDS_WAIT() asm volatile("s_waitcnt lgkmcnt(0)" ::: "memory")
#define VM_WAIT() asm volatile("s_waitcnt vmcnt(0)" ::: "memory")
__device__ __forceinline__ unsigned long long rt() { return __builtin_amdgcn_s_memrealtime(); }
__device__ __forceinline__ unsigned f2bf(float f) { unsigned u = __builtin_bit_cast(unsigned, f); return (u + 0x7fffu + ((u >> 16) & 1u)) >> 16; }
__device__ __forceinline__ unsigned pk2(float lo, float hi) { return f2bf(lo) | (f2bf(hi) << 16); }

#define XB_TMO      128
#define XB_XCNT(j)  (256  + 64 * (j))
#define XB_XSUB(j)  (1280 + 64 * (j))
#define XB_XGEN(j)  (2304 + 64 * (j))
#define XB_TOP      3328
#define XB_TOPGEN   3392
#define XCD_BAR_WORDS 3456
#define XB_SPIN_CAP (1u << 18)

__device__ __forceinline__ unsigned xb_ld(unsigned* p)              { return __hip_atomic_load(p, __ATOMIC_RELAXED, __HIP_MEMORY_SCOPE_AGENT); }
__device__ __forceinline__ unsigned xb_add(unsigned* p, unsigned v) { return __hip_atomic_fetch_add(p, v, __ATOMIC_RELAXED, __HIP_MEMORY_SCOPE_AGENT); }
__device__ __forceinline__ unsigned xb_xcc_id() { return (unsigned)__builtin_amdgcn_s_getreg((3 << 11) | 20) & 0xFu; }
#define XB_SPIN(cond, bar) do { unsigned _sp = 0; while (cond) { __builtin_amdgcn_s_sleep(1); \
    if ((++_sp & 255u) == 0u) { if (xb_ld(&(bar)[XB_TMO])) break; if (_sp > XB_SPIN_CAP) { atomicAdd(&(bar)[XB_TMO], 1u); break; } } } } while (0)

struct XcdBarrier {
    unsigned* bar; unsigned x;
    volatile LAS unsigned* st;
};

__device__ __forceinline__ XcdBarrier xcd_barrier_post(unsigned* bar, volatile LAS unsigned* st, bool leader_thread  ) {
    XcdBarrier b; b.bar = bar; b.x = xb_xcc_id(); b.st = st;
    if (leader_thread) (void)xb_add(&bar[XB_XCNT(b.x)], 1u);
    return b;
}
__device__ __forceinline__ void xcd_barrier_complete(unsigned* bar, unsigned x, unsigned& nloc, unsigned& nx) {
    const unsigned G = gridDim.x * gridDim.y * gridDim.z;
    unsigned sum, cnt, mine, sp = 0u;
    for (;;) {
        sum = 0u; cnt = 0u; mine = 0u;
#pragma unroll
        for (unsigned j = 0; j < 16; ++j) { const unsigned c = xb_ld(&bar[XB_XCNT(j)]); sum += c; cnt += (c > 0u) ? 1u : 0u; mine = (j == x) ? c : mine; }
        if (sum == G) break;
        __builtin_amdgcn_s_sleep(1);
        if ((++sp & 255u) == 0u) { if (xb_ld(&bar[XB_TMO])) break; if (sp > XB_SPIN_CAP) { atomicAdd(&bar[XB_TMO], 1u); break; } }
    }
    nloc = mine > 0u ? mine : 1u; nx = cnt > 0u ? cnt : 1u;
}

__device__ __forceinline__ void xcd_barrier(const XcdBarrier& b, bool leader_thread  ) {
    asm volatile("s_waitcnt vmcnt(0)" ::: "memory");
    __syncthreads();
    if (leader_thread) {
        unsigned* bar = b.bar; unsigned bx_ = b.x; asm volatile("" : "+s"(bar), "+s"(bx_));
        __builtin_amdgcn_s_waitcnt(0);
        unsigned nloc = b.st[0], nx = b.st[1];
        if (nloc == 0u) { xcd_barrier_complete(bar, bx_, nloc, nx); b.st[0] = nloc; b.st[1] = nx; }
        const unsigned old = xb_add(&bar[XB_XSUB(bx_)], 1u);
        const unsigned gen = old / nloc;
        if (old + 1u == (gen + 1u) * nloc) {
            __builtin_amdgcn_fence(__ATOMIC_RELEASE, "agent");
            asm volatile("s_waitcnt vmcnt(0)" ::: "memory");
            const unsigned og = xb_add(&bar[XB_TOP], 1u);
            const unsigned tg = og / nx;
            if (og + 1u == (tg + 1u) * nx) xb_add(&bar[XB_TOPGEN], 1u);
            else XB_SPIN(xb_ld(&bar[XB_TOPGEN]) == tg, bar);
            __builtin_amdgcn_fence(__ATOMIC_ACQUIRE, "agent");
            xb_add(&bar[XB_XGEN(bx_)], 1u);
            asm volatile("s_waitcnt vmcnt(0)" ::: "memory");
        } else {
            XB_SPIN(xb_ld(&bar[XB_XGEN(bx_)]) == gen, bar);
            __builtin_amdgcn_fence(__ATOMIC_ACQUIRE, "agent");
            asm volatile("s_waitcnt vmcnt(0)" ::: "memory");
        }
    }
    __syncthreads();
}


typedef unsigned u32x2 __attribute__((ext_vector_type(2)));
__device__ __forceinline__ float bflo(unsigned w) { return __uint_as_float(w << 16); }
__device__ __forceinline__ float bfhi(unsigned w) { return __uint_as_float(w & 0xffff0000u); }
__device__ __forceinline__ float bf2f(bf16 v) { return __uint_as_float((unsigned)v << 16); }
__device__ __forceinline__ float bperm_f(float v, int srclane) { return __int_as_float(__builtin_amdgcn_ds_bpermute(srclane << 2, __float_as_int(v))); }
__device__ __forceinline__ unsigned bperm_u(unsigned v, int srclane) { return (unsigned)__builtin_amdgcn_ds_bpermute(srclane << 2, (int)v); }
__device__ __forceinline__ float wave_sum(float v, int lane) {
#pragma unroll
    for (int o = 1; o < 64; o <<= 1) v += bperm_f(v, lane ^ o);
    return v;
}
__device__ __forceinline__ float xhalf_max(float v) { auto rr = __builtin_amdgcn_permlane32_swap(__float_as_uint(v), __float_as_uint(v), false, false); return fmaxf(__uint_as_float(rr[0]), __uint_as_float(rr[1])); }
__device__ __forceinline__ float xhalf_sum(float v) { auto rr = __builtin_amdgcn_permlane32_swap(__float_as_uint(v), __float_as_uint(v), false, false); return __uint_as_float(rr[0]) + __uint_as_float(rr[1]); }
__device__ __forceinline__ unsigned xhalf_sum_u(unsigned v) { auto rr = __builtin_amdgcn_permlane32_swap(v, v, false, false); return rr[0] + rr[1]; }
__device__ __forceinline__ float xhalf_other(float v, int hh) { auto rr = __builtin_amdgcn_permlane32_swap(__float_as_uint(v), __float_as_uint(v), false, false); return __uint_as_float(hh ? rr[0] : rr[1]); }
__device__ __forceinline__ void rope_cs(int pos, int i, float& c, float& s) {
    const float cf = i == 0 ? 0.15915494309189535f : i == 1 ? 0.03086376340470123f : i == 2 ? 0.005985185712713705f : i == 3 ? 0.001160663641240061f
                   : i == 4 ? 0.00022507907903927653f : i == 5 ? 4.364795279280289e-05f : i == 6 ? 8.464330808241401e-06f : 1.6414262627950345e-06f;
    const float hi = __uint_as_float(__float_as_uint(cf) & 0xfffff000u), lo = cf - hi;
    const float p = (float)pos; const float a = p * hi; float r = a - floorf(a); r += p * lo;
    s = __builtin_amdgcn_sinf(r); c = __builtin_amdgcn_cosf(r);
}

template <int MODE> __device__ __forceinline__ int colmap(int n) {
    if (MODE == 0) return n;
    if (MODE == 1) { const int t = n >> 8, r = n & 255; return r < 128 ? t * 128 + r : DFF + t * 128 + (r - 128); }
    if (n < 1152) return n;
    if (n < 2880) return n + 6;
    if (n < 2886) return n - 2880 + 1152;
    if (n < 2890) return n;
    if (n < 3072) return -1;
    return n - 182;
}
template <int MODE> __device__ __forceinline__ float colscale(int n) {
    if (MODE != 2) return 1.0f;
    if (n < 384 || (n >= 2112 && n < 2432)) return 0.125f * 1.4426950408889634f;
    if (n >= 1152 && n < 1472) return 0.125f;
    return 1.0f;
}
template <int MODE> __device__ __forceinline__ void conv_job(const float* W, int Nsrc, int Ksrc, const float* gain, bf16* WT, int Ndst, int Kdst, LAS float* scr, int gw, int ngw, int lane, int& coff, int ldd = 0) {
    if (ldd == 0) ldd = Kdst;
    const int nblk = Ndst / 32, nitems = (Kdst / 64) * nblk;
    int it0 = gw - coff; if (it0 < 0) it0 += ngw;
    coff = (coff + nitems) % ngw;
    for (int it = it0; it < nitems; it += ngw) {
        const int kb = it / nblk, nb = it % nblk, k0 = 64 * kb, n0 = 32 * nb;
        const int sc = colmap<MODE>(n0 + (lane & 31));
        float wv_[32];
#pragma unroll
        for (int i = 0; i < 32; ++i) { const int k = k0 + 2 * i + (lane >> 5); wv_[i] = (sc >= 0 && k < Ksrc) ? W[(size_t)k * Nsrc + sc] : 0.f; }
        if (gain) {
#pragma unroll
            for (int i = 0; i < 32; ++i) { const int k = k0 + 2 * i + (lane >> 5); wv_[i] *= k < Ksrc ? gain[k] : 0.f; } }
        if (MODE == 2) { const float cs = colscale<MODE>(n0 + (lane & 31));
#pragma unroll
            for (int i = 0; i < 32; ++i) wv_[i] *= cs; }
#pragma unroll
        for (int i = 0; i < 32; ++i) scr[(2 * i + (lane >> 5)) * 33 + (lane & 31)] = wv_[i];
        LDS_WAIT(); asm volatile("" ::: "memory");
        const int c = lane & 7;
#pragma unroll
        for (int j = 0; j < 4; ++j) { const int n = (lane >> 3) + 8 * j; const LAS float* s = scr + (8 * c) * 33 + n;
            v4u o; o.x = pk2(s[0 * 33], s[1 * 33]); o.y = pk2(s[2 * 33], s[3 * 33]); o.z = pk2(s[4 * 33], s[5 * 33]); o.w = pk2(s[6 * 33], s[7 * 33]);
            *(GAS v4u*)(WT + (size_t)(n0 + n) * ldd + k0 + 8 * c) = o; }
        LDS_WAIT(); asm volatile("" ::: "memory");
    }
}


typedef short bf16x8 __attribute__((ext_vector_type(8)));
typedef float f32x16 __attribute__((ext_vector_type(16)));
typedef float f32x2_t __attribute__((ext_vector_type(2))); typedef __bf16 bf16x2_t __attribute__((ext_vector_type(2)));
__device__ __forceinline__ unsigned cvtpk(float lo, float hi) { f32x2_t v = {lo, hi}; bf16x2_t b = __builtin_convertvector(v, bf16x2_t); return __builtin_bit_cast(unsigned, b); }
#define MFMA32(a, b, c) __builtin_amdgcn_mfma_f32_32x32x16_bf16((a), (b), (c), 0, 0, 0)
__device__ __forceinline__ int crow(int i, int hh) { return (i & 3) + 8 * (i >> 2) + 4 * hh; }
__device__ __forceinline__ bf16x8 ldg16(const bf16* p) { return *(const GAS bf16x8*)p; }
__device__ __forceinline__ bf16x8 pack8(const f32x16& x, int s) {
    v4u p; p.x = cvtpk(x[8 * s + 0], x[8 * s + 1]); p.y = cvtpk(x[8 * s + 2], x[8 * s + 3]); p.z = cvtpk(x[8 * s + 4], x[8 * s + 5]); p.w = cvtpk(x[8 * s + 6], x[8 * s + 7]);
    return __builtin_bit_cast(bf16x8, p);
}
__device__ __forceinline__ void store_ot(bf16* yrow, const f32x16 (&o)[2], float scale, int hh) {
#pragma unroll
    for (int dt = 0; dt < 2; ++dt)
#pragma unroll
        for (int gp = 0; gp < 2; ++gp) {
            unsigned a0 = cvtpk(o[dt][8 * gp + 0] * scale, o[dt][8 * gp + 1] * scale), a1 = cvtpk(o[dt][8 * gp + 2] * scale, o[dt][8 * gp + 3] * scale);
            unsigned b0 = cvtpk(o[dt][8 * gp + 4] * scale, o[dt][8 * gp + 5] * scale), b1 = cvtpk(o[dt][8 * gp + 6] * scale, o[dt][8 * gp + 7] * scale);
            auto r0 = __builtin_amdgcn_permlane32_swap(a0, b0, false, false); auto r1 = __builtin_amdgcn_permlane32_swap(a1, b1, false, false);
            v4u w; w.x = r0[0]; w.y = r1[0]; w.z = r0[1]; w.w = r1[1];
            *(GAS v4u*)(yrow + 32 * dt + 16 * gp + 8 * hh) = w; }
}
constexpr float LOG2E = 1.4426950408889634f, LN2 = 0.6931471805599453f;

#define FOX_LOAD(KF, VF, kt_) do { _Pragma("unroll") for (int s_ = 0; s_ < 4; ++s_) KF[s_] = ldg16(kb + (size_t)2048 * (kt_) + 512 * s_); \
    _Pragma("unroll") for (int d_ = 0; d_ < 2; ++d_) _Pragma("unroll") for (int s_ = 0; s_ < 2; ++s_) VF[d_][s_] = ldg16(vb + (size_t)2048 * (kt_) + 512 * (2 * d_ + s_)); } while (0)
#define FOX_REF 24.0f
#define FOX_STEP(KF, VF, NKF, NVF, kt_) do { \
    { const int kn_ = (kt_) + 2 <= qs ? (kt_) + 2 : qs; FOX_LOAD(NKF, NVF, kn_); } \
    f32x4 cf_[4]; _Pragma("unroll") for (int g_ = 0; g_ < 4; ++g_) cf_[g_] = *(const LAS f32x4*)(cfL + 32 * (kt_) + 8 * g_ + 4 * hh); \
    f32x16 sacc; _Pragma("unroll") for (int i = 0; i < 16; ++i) sacc[i] = cf_[i >> 2][i & 3] - rt;        \
    _Pragma("unroll") for (int s_ = 0; s_ < 4; ++s_) sacc = MFMA32(KF[s_], qf[s_], sacc); \
    if ((kt_) == qs) { _Pragma("unroll") for (int i = 0; i < 16; ++i) { float p = __builtin_amdgcn_exp2f(sacc[i]); if (crow(i, hh) > r) p = 0.f; sacc[i] = p; l += p; } } \
    else { _Pragma("unroll") for (int i = 0; i < 16; ++i) { const float p = __builtin_amdgcn_exp2f(sacc[i]); sacc[i] = p; l += p; } } \
    const bf16x8 p0 = pack8(sacc, 0), p1 = pack8(sacc, 1); \
    _Pragma("unroll") for (int d_ = 0; d_ < 2; ++d_) { o[d_] = MFMA32(VF[d_][0], p0, o[d_]); o[d_] = MFMA32(VF[d_][1], p1, o[d_]); } } while (0)
__device__ __forceinline__ void fox_strip(const bf16* P, const bf16* KAI, const LAS float* cfL, const bf16* VTA, bf16* YA, int b, int h, int qs, int lane) {
    const int r = lane & 31, hh = lane >> 5;
    const size_t rowq = (size_t)b * SEQ + qs * 32 + r;
    bf16x8 qf[4];
#pragma unroll
    for (int s = 0; s < 4; ++s) qf[s] = ldg16(P + rowq * NIN + C_QA + h * 64 + 16 * s + 8 * hh);
    const float rt = cfL[qs * 32 + r] + FOX_REF;
    const bf16* kb = KAI + (size_t)(b * NFOX + h) * 64 * SEQ + 8 * lane;
    const bf16* vb = VTA + (size_t)(b * NFOX + h) * 64 * SEQ + 8 * lane;
    f32x16 o[2]; o[0] = f32x16{}; o[1] = f32x16{};
    float l = 0.f;
    bf16x8 kA[4], vA[2][2], kB[4], vB[2][2], kC[4], vC[2][2];
    FOX_LOAD(kA, vA, 0); { const int k1 = qs >= 1 ? 1 : 0; FOX_LOAD(kB, vB, k1); }
    for (int kt = 0; kt <= qs; kt += 3) {
        FOX_STEP(kA, vA, kC, vC, kt);
        if (kt + 1 > qs) break;
        FOX_STEP(kB, vB, kA, vA, kt + 1);
        if (kt + 2 > qs) break;
        FOX_STEP(kC, vC, kB, vB, kt + 2);
    }
    l = xhalf_sum(l);
    store_ot(YA + rowq * KUP + h * 64, o, 1.0f / l, hh);
}

__device__ __forceinline__ void sb_strip(const bf16* P, const bf16* KBI, const bf16* VTB, bf16* YB, int b, int h, int qs, int lane) {
    const int r = lane & 31, hh = lane >> 5;
    const size_t rowq = (size_t)b * SEQ + qs * 32 + r;
    bf16x8 qf[4];
#pragma unroll
    for (int s = 0; s < 4; ++s) qf[s] = ldg16(P + rowq * NIN + C_QB + h * 64 + 16 * s + 8 * hh);
    const bf16* kb = KBI + (size_t)(b * NSB + h) * 64 * SEQ + 8 * lane;
    const bf16* vb = VTB + (size_t)(b * NSB + h) * 64 * SEQ + 8 * lane;
    f32x16 o[2]; o[0] = f32x16{}; o[1] = f32x16{};
    float R = 0.f;
    bf16x8 kf[4], vf[2][2];
#pragma unroll
    for (int s = 0; s < 4; ++s) kf[s] = ldg16(kb + (size_t)2048 * qs + 512 * s);
#pragma unroll
    for (int dt = 0; dt < 2; ++dt)
#pragma unroll
        for (int s = 0; s < 2; ++s) vf[dt][s] = ldg16(vb + (size_t)2048 * qs + 512 * (2 * dt + s));
    asm volatile("" ::: "memory");
    for (int kt = qs; kt >= 0; --kt) {
        bf16x8 nk[4], nv[2][2];
        const int kn = kt > 0 ? kt - 1 : 0;
#pragma unroll
        for (int s = 0; s < 4; ++s) nk[s] = ldg16(kb + (size_t)2048 * kn + 512 * s);
#pragma unroll
        for (int dt = 0; dt < 2; ++dt)
#pragma unroll
            for (int s = 0; s < 2; ++s) nv[dt][s] = ldg16(vb + (size_t)2048 * kn + 512 * (2 * dt + s));
        asm volatile("" ::: "memory");
        f32x16 z = f32x16{};
#pragma unroll
        for (int s = 0; s < 4; ++s) z = MFMA32(kf[s], qf[s], z);
        f32x16 sp;
#pragma unroll
        for (int i = 0; i < 16; ++i) { const float zz = z[i]; const float e = __builtin_amdgcn_exp2f(-fabsf(zz) * LOG2E); float s_ = fmaxf(zz, 0.f) + LN2 * __builtin_amdgcn_logf(1.0f + e);
            const bool valid = (kt < qs) || (crow(i, hh) < r); sp[i] = valid ? s_ : 0.f; z[i] = valid ? zz - s_ : -INFINITY; }
        float tg[4], tp[4];
#pragma unroll
        for (int g = 0; g < 4; ++g) { tg[g] = (sp[4 * g] + sp[4 * g + 1]) + (sp[4 * g + 2] + sp[4 * g + 3]); tp[g] = xhalf_other(tg[g], hh); }
        float above = R;
#pragma unroll
        for (int g = 3; g >= 0; --g) {
            const float ab = above + (hh == 0 ? tp[g] : 0.f);
            const float w3 = ab, w2 = w3 + sp[4 * g + 3], w1 = w2 + sp[4 * g + 2], w0 = w1 + sp[4 * g + 1];
            z[4 * g + 3] = __builtin_amdgcn_exp2f((z[4 * g + 3] - w3) * LOG2E); z[4 * g + 2] = __builtin_amdgcn_exp2f((z[4 * g + 2] - w2) * LOG2E);
            z[4 * g + 1] = __builtin_amdgcn_exp2f((z[4 * g + 1] - w1) * LOG2E); z[4 * g + 0] = __builtin_amdgcn_exp2f((z[4 * g + 0] - w0) * LOG2E);
            above += tg[g] + tp[g];
        }
        R = above;
        const bf16x8 p0 = pack8(z, 0), p1 = pack8(z, 1);
#pragma unroll
        for (int dt = 0; dt < 2; ++dt) { o[dt] = MFMA32(vf[dt][0], p0, o[dt]); o[dt] = MFMA32(vf[dt][1], p1, o[dt]); }
        if (__all(R > 104.0f)) break;
#pragma unroll
        for (int s = 0; s < 4; ++s) kf[s] = nk[s];
#pragma unroll
        for (int dt = 0; dt < 2; ++dt)
#pragma unroll
            for (int s = 0; s < 2; ++s) vf[dt][s] = nv[dt][s];
    }
    store_ot(YB + rowq * KUP + h * 64, o, 1.0f, hh);
}

template <int NH> __device__ __forceinline__ void dsa_attend(f32x16 (&o)[NH][2], float (&m)[NH], float (&l)[NH], const bf16* kcb, const bf16* vtb, const LAS unsigned char* qcl, int hbase,
                                                              const unsigned (&selm)[4], int ntiles, int wave) {
    const float SC = 0.125f * LOG2E;
#pragma unroll
    for (int h = 0; h < NH; ++h) { o[h][0] = f32x16{}; o[h][1] = f32x16{}; m[h] = 0.f; l[h] = 0.f; }
#define DSA_LOADKV(KF, VF, j_) do { _Pragma("unroll") for (int s_ = 0; s_ < 4; ++s_) KF[s_] = ldg16(kcb + (size_t)2048 * (j_) + 512 * s_); \
    _Pragma("unroll") for (int d_ = 0; d_ < 2; ++d_) _Pragma("unroll") for (int s_ = 0; s_ < 2; ++s_) VF[d_][s_] = ldg16(vtb + (size_t)2048 * (j_) + 512 * (2 * d_ + s_)); } while (0)
    bf16x8 kc[4], vt[2][2];
    if (wave < ntiles) DSA_LOADKV(kc, vt, wave);
    asm volatile("" ::: "memory");
    __builtin_amdgcn_s_waitcnt(0x0F70);
#pragma unroll 1
    for (int sl = 0; sl < 8; ++sl) {
        const int j = sl * 8 + wave;
        if (j < ntiles) {
            const int jn = j + 8 < ntiles ? j + 8 : j;
            const unsigned sw = sl < 2 ? selm[0] : sl < 4 ? selm[1] : sl < 6 ? selm[2] : selm[3];
            const unsigned bits = sw >> ((sl & 1) * 16);
            f32x16 minit;
#pragma unroll
            for (int i = 0; i < 16; ++i) minit[i] = ((bits >> i) & 1u) ? -FOX_REF : -INFINITY;
            f32x16 sa[NH];
#pragma unroll
            for (int h = 0; h < NH; ++h) { sa[h] = minit;
#pragma unroll
                for (int s = 0; s < 4; ++s) sa[h] = MFMA32(kc[s], *(const LAS bf16x8*)(qcl + ((hbase + h) * 64 + 16 * s) * 2), sa[h]); }
            asm volatile("" ::: "memory");
#pragma unroll
            for (int s_ = 0; s_ < 4; ++s_) kc[s_] = ldg16(kcb + (size_t)2048 * jn + 512 * s_);
            asm volatile("" ::: "memory");
#pragma unroll
            for (int i = 0; i < 16; ++i)
#pragma unroll
                for (int h = 0; h < NH; ++h) { const float p = __builtin_amdgcn_exp2f(sa[h][i]); sa[h][i] = p; l[h] += p; }
#pragma unroll
            for (int h = 0; h < NH; ++h) { const bf16x8 p0 = pack8(sa[h], 0), p1 = pack8(sa[h], 1);
#pragma unroll
                for (int dt = 0; dt < 2; ++dt) { o[h][dt] = MFMA32(vt[dt][0], p0, o[h][dt]); o[h][dt] = MFMA32(vt[dt][1], p1, o[h][dt]); } }
            asm volatile("" ::: "memory");
#pragma unroll
            for (int d_ = 0; d_ < 2; ++d_)
#pragma unroll
                for (int s_ = 0; s_ < 2; ++s_) vt[d_][s_] = ldg16(vtb + (size_t)2048 * jn + 512 * (2 * d_ + s_));
            asm volatile("" ::: "memory");
        }
    }
#undef DSA_LOADKV
#pragma unroll
    for (int h = 0; h < NH; ++h) l[h] = xhalf_sum(l[h]);
}
__device__ __forceinline__ void dsa_combine(const f32x16 (&o)[2], float m, float l, LAS float* Ml, LAS float* Ob, bf16* yq, int h5, int wave, int lane) {
    const int r = lane & 31, hh = lane >> 5;
    if (lane < 32) { Ml[(wave * 2 + 0) * 32 + r] = m; Ml[(wave * 2 + 1) * 32 + r] = l; }
#pragma unroll
    for (int dt = 0; dt < 2; ++dt)
#pragma unroll
        for (int i = 0; i < 16; ++i) Ob[(wave * 64 + 32 * dt + crow(i, hh)) * 32 + r] = o[dt][i];
    __syncthreads();
    {
        float ls = 0.f, acc4[4] = {0.f, 0.f, 0.f, 0.f};
#pragma unroll
        for (int w = 0; w < 8; ++w) { ls += Ml[(w * 2 + 1) * 32 + r];
#pragma unroll
            for (int e = 0; e < 4; ++e) acc4[e] += Ob[(w * 64 + 8 * wave + 4 * hh + e) * 32 + r]; }
        const float il = 1.0f / ls;
        u32x2 wv; wv.x = cvtpk(acc4[0] * il, acc4[1] * il); wv.y = cvtpk(acc4[2] * il, acc4[3] * il);
        *(GAS u32x2*)(yq + h5 * 64 + 8 * wave + 4 * hh) = wv;
    }
    __syncthreads();
}
__device__ __forceinline__ unsigned wg_sum32(unsigned c, LAS unsigned* cnt, int& seq, int wave, int r, int lane) {
    c = xhalf_sum_u(c);
    const int buf = seq & 1; ++seq;
    if (lane < 32) cnt[(buf * 8 + wave) * 32 + r] = c;
    __syncthreads();
    unsigned t = 0;
#pragma unroll
    for (int w = 0; w < 8; ++w) t += cnt[(buf * 8 + w) * 32 + r];
    return t;
}
__device__ __forceinline__ void dsa_unit(const bf16* P, const float* Pf, const bf16* KI, const bf16* KC, const bf16* VTC, bf16* YC, int b, int g, int wave, int lane, LAS unsigned char* lds) {
    asm volatile("" : "+v"(lane), "+s"(wave));
    const int r = lane & 31, hh = lane >> 5;
    const int N = 64 * (g / 2 + 1), ntiles = N / 32;
    const size_t rowq = (size_t)b * SEQ + 32 * g + r;
    LAS unsigned* cnt = (LAS unsigned*)lds; LAS float* Ml = (LAS float*)(lds + 2048); LAS float* Ob = (LAS float*)(lds + 4096);
    LAS unsigned char* QiL = lds + 69632;
    LAS unsigned char* QcL = lds + 86528;
    int seq = 0;
    {
        const int t = wave * 64 + lane;
        v4u qs_[5];
#pragma unroll
        for (int i = 0; i < 2; ++i) { const int c = t + 512 * i, row = c >> 5, ch = c & 31; qs_[i] = *(const GAS v4u*)(P + ((size_t)b * SEQ + 32 * g + row) * NIN + C_QI + 8 * ch); }
#pragma unroll
        for (int i = 0; i < 3; ++i) { const int c = t + 512 * i < 32 * 40 ? t + 512 * i : 0; const int row = c / 40, ch = c % 40; qs_[2 + i] = *(const GAS v4u*)(P + ((size_t)b * SEQ + 32 * g + row) * NIN + C_QC + 8 * ch); }
#pragma unroll
        for (int i = 0; i < 2; ++i) { const int c = t + 512 * i, row = c >> 5, ch = c & 31; *(LAS v4u*)(QiL + row * 528 + ch * 16) = qs_[i]; }
#pragma unroll
        for (int i = 0; i < 3; ++i) { const int c = t + 512 * i; if (c < 32 * 40) { const int row = c / 40, ch = c % 40; *(LAS v4u*)(QcL + row * 656 + ch * 16) = qs_[2 + i]; } }
    }
    const float w0 = Pf[rowq * 256 + F_WI + 0], w1 = Pf[rowq * 256 + F_WI + 1], w2 = Pf[rowq * 256 + F_WI + 2], w3 = Pf[rowq * 256 + F_WI + 3];
    __syncthreads();
    unsigned key[8][16];
    const bf16* kib = KI + (size_t)b * SEQ * 64 + 8 * lane;
    bf16x8 kf[4];
    if (wave < ntiles) {
#pragma unroll
        for (int s = 0; s < 4; ++s) kf[s] = ldg16(kib + (size_t)2048 * wave + 512 * s); }
    asm volatile("" ::: "memory");
    __builtin_amdgcn_s_waitcnt(0x0F70);
#pragma unroll
    for (int sl = 0; sl < 8; ++sl) {
        const int j = sl * 8 + wave;
        if (j < ntiles) {
            bf16x8 kn[4];
            { const int jn = j + 8 < ntiles ? j + 8 : j;
#pragma unroll
              for (int s = 0; s < 4; ++s) kn[s] = ldg16(kib + (size_t)2048 * jn + 512 * s); }
            asm volatile("" ::: "memory");
            float sc[16];
#pragma unroll
            for (int hp = 0; hp < 2; ++hp) {
                f32x16 accA = f32x16{}, accB = f32x16{};
#pragma unroll
                for (int s = 0; s < 4; ++s) { accA = MFMA32(kf[s], *(const LAS bf16x8*)(QiL + r * 528 + ((2 * hp) * 64 + 16 * s + 8 * hh) * 2), accA);
                                              accB = MFMA32(kf[s], *(const LAS bf16x8*)(QiL + r * 528 + ((2 * hp + 1) * 64 + 16 * s + 8 * hh) * 2), accB); }
                const float wA = hp == 0 ? w0 : w2, wB = hp == 0 ? w1 : w3;
#pragma unroll
                for (int i = 0; i < 16; ++i) { const float t = hp == 0 ? wA * fmaxf(accA[i], 0.f) : fmaf(wA, fmaxf(accA[i], 0.f), sc[i]); sc[i] = fmaf(wB, fmaxf(accB[i], 0.f), t); }
            }
#pragma unroll
            for (int i = 0; i < 16; ++i) { const unsigned ub = __float_as_uint(sc[i] + 0.0f); key[sl][i] = (ub & 0x80000000u) ? ~ub : (ub | 0x80000000u); }
#pragma unroll
            for (int s = 0; s < 4; ++s) kf[s] = kn[s];
        } else {
#pragma unroll
            for (int i = 0; i < 16; ++i) key[sl][i] = 0u;
        }
    }
#ifndef DSA_REP_ATT
#define DSA_REP_ATT 1
#endif
    unsigned T = 0u; bool tie = false;
    if (N > 256) {
        LAS unsigned* hist = (LAS unsigned*)(lds + 4096);
        LAS unsigned* res = (LAS unsigned*)lds;
        const int tw = wave * 64 + lane;
        if (tw < 32) res[32 + tw] = 256u;
        bool done = false; unsigned need = 256u, ceq = 0u;
#pragma unroll 1
        for (int sh = 24; sh >= 0; sh -= 8) {
            for (int i = tw; i < 32 * 257; i += 512) hist[i] = 0u;
            __syncthreads();
            if (!done) {
                LAS unsigned* hq = hist + r * 257;
#pragma unroll
                for (int sl = 0; sl < 8; ++sl) if (sl * 8 + wave < ntiles) {
#pragma unroll
                    for (int i = 0; i < 16; ++i) { const unsigned k = key[sl][i];
                        if (sh == 24 || (k >> ((sh + 8) & 31)) == (T >> ((sh + 8) & 31))) { __hip_atomic_fetch_add(hq + ((k >> sh) & 255u), 1u, __ATOMIC_RELAXED, __HIP_MEMORY_SCOPE_WORKGROUP);
#ifdef PROBE_AT2
                            __hip_atomic_fetch_add(hq + 9216 + ((k >> sh) & 255u), 1u, __ATOMIC_RELAXED, __HIP_MEMORY_SCOPE_WORKGROUP);
#endif
                        } } }
            }
            __syncthreads();
#pragma unroll
            for (int qi = 0; qi < 4; ++qi) {
                const int q = 4 * wave + qi; const LAS unsigned* hq = hist + q * 257 + 4 * lane;
                const unsigned h0 = hq[0], h1 = hq[1], h2 = hq[2], h3 = hq[3], sl_ = (h0 + h1) + (h2 + h3);
                unsigned v = sl_;
#pragma unroll
                for (int o = 1; o < 64; o <<= 1) { const unsigned n = bperm_u(v, lane + o); if (lane + o < 64) v += n; }
                const unsigned E = v - sl_, nd = res[32 + q];
                if (E < nd && nd <= E + sl_) {
                    unsigned cum = E, dg, hb;
                    if (cum + h3 >= nd) { dg = 3; hb = h3; } else { cum += h3; if (cum + h2 >= nd) { dg = 2; hb = h2; } else { cum += h2; if (cum + h1 >= nd) { dg = 1; hb = h1; } else { cum += h1; dg = 0; hb = h0; } } }
                    res[q] = (4u * lane + dg) | ((cum + hb == nd) ? 256u : 0u); res[32 + q] = nd - cum; res[64 + q] = hb;
                }
            }
            __syncthreads();
            if (!done) { const unsigned rr = res[r]; T |= (rr & 255u) << sh; need = res[32 + r]; ceq = res[64 + r]; done = (rr & 256u) != 0u; }
            if (!__any(!done)) break;
        }
        tie = !done && ceq > need;
    }
    unsigned selm[4], tm[4];
#pragma unroll
    for (int q = 0; q < 4; ++q) { selm[q] = 0u; tm[q] = 0u; }
#pragma unroll
    for (int sl = 0; sl < 8; ++sl)
#pragma unroll
        for (int i = 0; i < 16; ++i) { selm[sl >> 1] |= (key[sl][i] > T ? 1u : 0u) << ((sl & 1) * 16 + i); tm[sl >> 1] |= (key[sl][i] == T ? 1u : 0u) << ((sl & 1) * 16 + i); }
    int J = 4095;
    if (N > 256 && __any(tie)) {
        LAS unsigned* res = (LAS unsigned*)lds;
        LAS unsigned* cntL = (LAS unsigned*)(lds + 4096);
#pragma unroll
        for (int sl = 0; sl < 8; ++sl) { const unsigned c = xhalf_sum_u((unsigned)__builtin_popcount((tm[sl >> 1] >> ((sl & 1) * 16)) & 0xffffu)); if (hh == 0) cntL[r * 64 + sl * 8 + wave] = c; }
        __syncthreads();
#pragma unroll
        for (int qi = 0; qi < 4; ++qi) {
            const int q = 4 * wave + qi; const unsigned c = cntL[q * 64 + lane]; unsigned v = c;
#pragma unroll
            for (int o = 1; o < 64; o <<= 1) { const unsigned n = bperm_u(v, lane - o); if (lane >= o) v += n; }
            const unsigned nd = res[32 + q], ex = v - c;
            if (ex < nd && nd <= v) res[96 + q] = (unsigned)lane | ((nd - ex) << 8);
        }
        __syncthreads();
        const unsigned rj = res[96 + r]; const int Jt = (int)(rj & 255u), nn = (int)(rj >> 8);
        { const int st = Jt >> 3; const unsigned wsel = st < 2 ? tm[0] : st < 4 ? tm[1] : st < 6 ? tm[2] : tm[3]; const unsigned m16 = (wsel >> ((st & 1) * 16)) & 0xffffu;
          const unsigned mo = xhalf_sum_u(m16) - m16;
          const unsigned m0 = hh ? mo : m16, m1 = hh ? m16 : mo;
          unsigned rm = 0u;
#pragma unroll
          for (int g4 = 0; g4 < 4; ++g4) rm |= (((m0 >> (4 * g4)) & 15u) << (8 * g4)) | (((m1 >> (4 * g4)) & 15u) << (8 * g4 + 4));
          int p = 0;
#pragma unroll
          for (int bs = 16; bs >= 1; bs >>= 1) { if (__builtin_popcount(rm & ((1u << (p + bs)) - 1u)) < nn) p += bs; }
          if (tie && wave == (Jt & 7) && hh == 0) res[128 + r] = (unsigned)(32 * Jt + p); }
        __syncthreads();
        if (tie) J = (int)res[128 + r];
    }
    {
        const int Jt = J >> 5, Jr = J & 31; unsigned rm16 = 0u;
#pragma unroll
        for (int g4 = 0; g4 < 4; ++g4) { int n = Jr - 8 * g4 - 4 * hh + 1; n = n < 0 ? 0 : n > 4 ? 4 : n; rm16 |= ((1u << n) - 1u) << (4 * g4); }
#pragma unroll
        for (int sl = 0; sl < 8; ++sl) { const int j = sl * 8 + wave; const unsigned lm = j < Jt ? 0xffffu : j > Jt ? 0u : rm16; selm[sl >> 1] |= tm[sl >> 1] & (lm << ((sl & 1) * 16)); }
    }
    const bf16* kcb = KC + (size_t)b * SEQ * 64 + 8 * lane;
    const bf16* vtb = VTC + (size_t)b * 64 * SEQ + 8 * lane;
    const LAS unsigned char* qcl = QcL + r * 656 + 16 * hh;
    bf16* yq = YC + rowq * KUP;
    { f32x16 o[3][2]; float m[3], l[3]; dsa_attend<3>(o, m, l, kcb, vtb, qcl, 0, selm, ntiles, wave);
      dsa_combine(o[0], m[0], l[0], Ml, Ob, yq, 0, wave, lane); dsa_combine(o[1], m[1], l[1], Ml, Ob, yq, 1, wave, lane); dsa_combine(o[2], m[2], l[2], Ml, Ob, yq, 2, wave, lane); }
    { f32x16 o[2][2]; float m[2], l[2]; dsa_attend<2>(o, m, l, kcb, vtb, qcl, 3, selm, ntiles, wave);
      dsa_combine(o[0], m[0], l[0], Ml, Ob, yq, 3, wave, lane); dsa_combine(o[1], m[1], l[1], Ml, Ob, yq, 4, wave, lane); }
}


struct Args { const float* in[18]; float* out; unsigned char* ws; int ph_lo, ph_hi, li, pad; };

static_assert(pg8::EpiWin::KA0 == C_KA && pg8::EpiWin::KB0 == C_KB && pg8::EpiWin::NHA == NFOX && pg8::EpiWin::NHB == NSB && pg8::EpiWin::SEQL == SEQ && pg8::EpiWin::KAI_OFF == (long)(WS_KAI - WS_P) && pg8::EpiWin::KBI_OFF == (long)(WS_KBI - WS_P), "EpiWin's copy of the layout constants");
__global__ void __launch_bounds__(NWAVES * 64, 2) mk_fwd(Args args) {
    extern __shared__ __attribute__((aligned(16))) unsigned char lds_raw[];
    LAS unsigned char* lds = (LAS unsigned char*)lds_raw;
    volatile LAS unsigned* MISC = (volatile LAS unsigned*)(lds + MISC_OFF);
    const int tid = threadIdx.x, lane0 = tid & 63, wave0 = __builtin_amdgcn_readfirstlane(tid >> 6);
    const int G0 = gridDim.x; const int bx0 = blockIdx.x; const int vcu = (G0 % 8 == 0) ? (bx0 % 8) * (G0 / 8) + bx0 / 8 : bx0;
    const int gw0 = vcu * NWAVES + wave0;
    unsigned char* ws0 = args.ws;
    gu32* ctl = (gu32*)(ws0 + WS_CTL);
    for (int u = tid; u < (LDS_BYTES - LDSCTL_OFF) / 4; u += NWAVES * 64) ((LAS unsigned*)(lds + LDSCTL_OFF))[u] = 0u;
    __syncthreads();
    XcdBarrier bar = xcd_barrier_post((unsigned*)(ctl + CW_BAR) + args.li * XCD_BAR_WORDS, MISC + 8, tid == 0);
    typedef const Args __attribute__((address_space(4)))* kargs_t;
    const kargs_t ka0 = (kargs_t)__builtin_amdgcn_kernarg_segment_ptr();
    const int lo = args.ph_lo, hi = args.ph_hi;
    int layer = 0, f = 0, hf = 0;
#define TX_NOW() ({ unsigned t_; asm volatile("v_mbcnt_lo_u32_b32 %0, -1, 0\n\tv_mbcnt_hi_u32_b32 %0, -1, %0" : "=v"(t_)); t_ | ((unsigned)wave0 << 6); })
    int ph = 0;
#define PH_BEGIN if (ph >= lo && ph < hi) { unsigned char* ws = ws0; kargs_t ka = ka0; unsigned tx_; asm volatile("v_mbcnt_lo_u32_b32 %0, -1, 0\n\tv_mbcnt_hi_u32_b32 %0, -1, %0" : "=v"(tx_)); tx_ |= (unsigned)wave0 << 6; int gw = gw0, G = G0, bx = bx0, Lr = layer; asm volatile("" : "+s"(ws), "+s"(ka), "+v"(tx_), "+s"(gw), "+s"(G), "+s"(bx), "+s"(Lr)); const int lane = (int)(tx_ & 63u), wave = __builtin_amdgcn_readfirstlane((int)(tx_ >> 6)); float* xf = ka->out; unsigned char* wbase = Lr ? (unsigned char*)xf : ws; const int NGW = G * NWAVES;
#define PH_END   if (ph + 1 < hi) xcd_barrier(bar, TX_NOW() == 0u); } ++ph;

#define WGU1 ((bf16*)(wbase + WS_WGU1))
#define WD1 ((bf16*)(wbase + WS_WD1))
#define WIN ((bf16*)(wbase + WS_WIN))
#define WUP ((bf16*)(wbase + WS_WUP))
#define WOUT ((bf16*)(wbase + WS_WOUT))
#define WGU2 ((bf16*)(wbase + WS_WGU2))
#define WD2 ((bf16*)(wbase + WS_WD2))
#define XB ((bf16*)(ws + WS_XB))
#define SSQ ((float*)(ws + WS_SSQ))
#define P ((bf16*)(ws + WS_P))
#define HFF ((bf16*)(ws + WS_HFF))
#define PF ((float*)(ws + WS_PF))
#define YA ((bf16*)(ws + WS_Y))
#define YB ((bf16*)(ws + WS_Y) + 384)
#define YC ((bf16*)(ws + WS_Y) + 768)
#define MGB ((bf16*)(ws + WS_MGB))
#define KAI ((bf16*)(ws + WS_KAI))
#define KBI ((bf16*)(ws + WS_KBI))
#define KC ((bf16*)(ws + WS_KC))
#define KI ((bf16*)(ws + WS_KI))
#define CF ((float*)(ws + WS_CF))
#define VTA ((bf16*)(ws + WS_VTA))
#define VTB ((bf16*)(ws + WS_VTB))
#define VTC ((bf16*)(ws + WS_VTC))
#define XF (xf)
#define scr ((LAS float*)(lds + RING_OFF + wave * 16384))
#define CONV_FFN(l, which) do { unsigned char* wbase = (l) ? (unsigned char*)xf : ws; const float* gg = ka->in[(which) ? 14 : 1] + (size_t)(l) * DM; const float* wgu = ka->in[(which) ? 15 : 2] + (size_t)(l) * DM * NGU; const float* wd = ka->in[(which) ? 16 : 3] + (size_t)(l) * DFF * DM; \
        conv_job<1>(wgu, NGU, DM, gg, (which) ? WGU2 : WGU1, NGU, DM, scr, gw, NGW, lane, coff); conv_job<0>(wd, DM, DFF, nullptr, (which) ? WD2 : WD1, DM, DFF, scr, gw, NGW, lane, coff); } while (0)
#define CONV_MIX(l) do { unsigned char* wbase = (l) ? (unsigned char*)xf : ws; conv_job<2>(ka->in[5] + (size_t)(l) * DM * 5962, 5962, DM, ka->in[4] + (size_t)(l) * DM, WIN, NIN, DM, scr, gw, NGW, lane, coff); \
        conv_job<0>(ka->in[10] + (size_t)(l) * 384 * DM, DM, 384, nullptr, WUP, DM, 384, scr, gw, NGW, lane, coff, KUP); \
        conv_job<0>(ka->in[11] + (size_t)(l) * 320 * DM, DM, 320, nullptr, WUP + 384, DM, 384, scr, gw, NGW, lane, coff, KUP); \
        conv_job<0>(ka->in[12] + (size_t)(l) * 320 * DM, DM, 320, nullptr, WUP + 768, DM, 384, scr, gw, NGW, lane, coff, KUP); \
        conv_job<0>(ka->in[13] + (size_t)(l) * DM * DM, DM, DM, nullptr, WOUT, DM, DM, scr, gw, NGW, lane, coff); } while (0)

    PH_BEGIN
        int coff = 0;
        CONV_FFN(0, 0); CONV_MIX(0); CONV_FFN(0, 1); CONV_FFN(1, 0); CONV_MIX(1); CONV_FFN(1, 1);
        const float* x = ka->in[0];
        for (int m0 = gw * 4; m0 < MTOK; m0 += NGW * 4) {
            f32x4 v[4][4]; float s[4];
#pragma unroll
            for (int q = 0; q < 4; ++q) { const GAS f32x4* xr = (const GAS f32x4*)(x + (size_t)(m0 + q) * DM) + lane;
#pragma unroll
                for (int j = 0; j < 4; ++j) v[q][j] = xr[64 * j]; }
#pragma unroll
            for (int q = 0; q < 4; ++q) { GAS u32x2* o8 = (GAS u32x2*)(XB + (size_t)(m0 + q) * DM) + lane; s[q] = 0.f;
#pragma unroll
                for (int j = 0; j < 4; ++j) { const f32x4 t = v[q][j]; s[q] += (t[0] * t[0] + t[1] * t[1]) + (t[2] * t[2] + t[3] * t[3]); u32x2 w; w.x = pk2(t[0], t[1]); w.y = pk2(t[2], t[3]); o8[64 * j] = w; } }
#pragma unroll
            for (int q = 0; q < 4; ++q) { const float sm = wave_sum(s[q], lane); if (lane < 16) SSQ[(size_t)(m0 + q) * 16 + lane] = lane == 0 ? sm : 0.f; }
        }
    PH_END

#pragma unroll 1
    for (layer = 0; layer < DEPTH; ++layer) {
#pragma unroll 1
        for (f = 0; f < 2; ++f) {
            PH_BEGIN
                pg8::Gemm g{XB, f ? WGU2 : WGU1, MTOK, NGU, DM, 0}; pg8::StaticOrder S; S.init(MTOK, NGU, G, bx);
                LAS float* rsT = (LAS float*)(lds + RST_OFF);
                pg8::EpiSwiglu E{rsT, HFF, DFF};
                { const float* ssq_ = SSQ; auto pre = [&]() { pg8::rs_table_fill(rsT, ssq_, S, (int)TX_NOW()); };
                  pg8::gemm_phase<pg8::EpiSwiglu, pg8::StaticOrder, true, true>(lds + RING_OFF, g, S, E, (int)TX_NOW(), pre); }
            PH_END
            PH_BEGIN
                pg8::Gemm g{HFF, f ? WD2 : WD1, MTOK, DM, DFF, 0}; pg8::StaticOrder S; S.init(MTOK, DM, G, bx);
                pg8::EpiResid E{XB, SSQ, 0.5f};
                pg8::gemm_phase<pg8::EpiResid, pg8::StaticOrder, true, true>(lds + RING_OFF, g, S, E, (int)TX_NOW());
            PH_END
            if (f == 1) break;
            { const size_t rb = 0;
                PH_BEGIN
                    pg8::Gemm g{XB + rb * DM, WIN, MH, NIN, DM, 0}; pg8::StaticOrder S; S.init(MH, NIN, G, bx);
                    LAS float* rsT = (LAS float*)(lds + RST_OFF);
                    pg8::EpiWin E{rsT, P, PF, NIN};
                    { const float* ssq_ = SSQ + rb * 16; auto pre = [&]() { pg8::rs_table_fill(rsT, ssq_, S, (int)TX_NOW()); };
                      pg8::gemm_phase<pg8::EpiWin, pg8::StaticOrder, true, true>(lds + RING_OFF, g, S, E, (int)TX_NOW(), pre); }
                PH_END
            }
#pragma unroll 1
            for (hf = 0; hf < 2; ++hf) {
                const size_t rb = (size_t)hf * MH;
                PH_BEGIN
                    const float* gkv = ka->in[7] + Lr * 128; const float* wkv = ka->in[8] + (size_t)Lr * 128 * 128; const float* gik = ka->in[9] + Lr * 64; const float* bfor = ka->in[6] + Lr * NFOX;
                    LAS bf16* Tt = (LAS bf16*)(lds + wave * 12288);
                    LAS bf16* VCt = (LAS bf16*)(lds + VCT_OFF);
                    LAS unsigned* Wl = (LAS unsigned*)(lds + 98304);
                    { f32x2_t wv_[16];
#pragma unroll
                      for (int i = 0; i < 16; ++i) wv_[i] = *(const GAS f32x2_t*)(wkv + 2 * ((int)tx_ + 512 * i));
#pragma unroll
                      for (int i = 0; i < 16; ++i) Wl[(int)tx_ + 512 * i] = pk2(wv_[i][0], wv_[i][1]); }
                    __syncthreads();
                    for (int blk = bx; blk < MH / 64; blk += G) {
                        const GAS bf16* prow = (const GAS bf16*)P + (size_t)(blk * 64 + (lane >> 3)) * NIN + 8 * (lane & 7);
                        v4u wa[8];
                        { const GAS bf16* pa = prow + (wave < 6 ? C_VA + wave * 64 : C_VB + (wave - 6) * 64);
#pragma unroll
                          for (int i = 0; i < 8; ++i) wa[i] = *(const GAS v4u*)(pa + (size_t)(8 * i) * NIN); }
                        float pc0[8], pc1[8], pki[8], qc1[8], qc2[8], qi1[8], qi2[8], pfa[8];
                        {
                            bf16 r0[8], r1[8], r2[8], r3[8], r4[8], r5[8];
#pragma unroll
                            for (int j = 0; j < 8; ++j) { const int r = blk * 64 + wave * 8 + j; const int hq = lane >> 3, i8q = lane & 7;
                                const GAS bf16* pr = (const GAS bf16*)P + (size_t)r * NIN; const GAS float* pf = (const GAS float*)PF + (size_t)r * 256;
                                r0[j] = pr[C_CKV + lane]; r1[j] = pr[C_CKV + 64 + lane]; pki[j] = pf[F_KI + lane];
                                const GAS bf16* pq = pr + C_QC + (hq < 5 ? hq : 0) * 64; r2[j] = pq[i8q]; r3[j] = pq[i8q + 8];
                                const GAS bf16* pi = pr + C_QI + (hq < 4 ? hq : 0) * 64; r4[j] = pi[i8q]; r5[j] = pi[i8q + 8];
                                pfa[j] = pf[F_FA + (lane < NFOX ? lane : 0)]; }
                            asm volatile("" ::: "memory");
#pragma unroll
                            for (int j = 0; j < 8; ++j) { pc0[j] = bf2f(r0[j]); pc1[j] = bf2f(r1[j]); qc1[j] = bf2f(r2[j]); qc2[j] = bf2f(r3[j]); qi1[j] = bf2f(r4[j]); qi2[j] = bf2f(r5[j]); }
                        }
                        const float bfv = *(const GAS float*)(bfor + (lane < NFOX ? lane : 0));
                        LAS float* cn8 = (LAS float*)Tt;
                        { float ss[8];
#pragma unroll
                          for (int j = 0; j < 8; ++j) ss[j] = pc0[j] * pc0[j] + pc1[j] * pc1[j];
#pragma unroll
                          for (int o = 1; o < 64; o <<= 1)
#pragma unroll
                              for (int j = 0; j < 8; ++j) ss[j] += bperm_f(ss[j], lane ^ o);
                          const float g0 = gkv[lane], g1 = gkv[64 + lane];
#pragma unroll
                          for (int j = 0; j < 8; ++j) { const float rn = 1.0f / sqrtf(ss[j] * (1.0f / 128.0f) + EPS); cn8[j * 128 + lane] = pc0[j] * rn * g0; cn8[j * 128 + 64 + lane] = pc1[j] * rn * g1; } }
                        LDS_WAIT(); asm volatile("" ::: "memory");
                        float a0[8], a1[8];
#pragma unroll
                        for (int j = 0; j < 8; ++j) { a0[j] = 0.f; a1[j] = 0.f; }
#pragma unroll 2
                        for (int k = 0; k < 128; k += 4) {
                            unsigned w[4];
#pragma unroll
                            for (int e = 0; e < 4; ++e) w[e] = Wl[(k + e) * 64 + lane];
#pragma unroll
                            for (int j = 0; j < 8; ++j) { const f32x4 cn = *(const LAS f32x4*)(cn8 + j * 128 + k);
#pragma unroll
                                for (int e = 0; e < 4; ++e) { a0[j] = fmaf(cn[e], bflo(w[e]), a0[j]); a1[j] = fmaf(cn[e], bfhi(w[e]), a1[j]); } }
                        }
                        { float ss[8];
#pragma unroll
                          for (int j = 0; j < 8; ++j) ss[j] = pki[j] * pki[j];
#pragma unroll
                          for (int o = 1; o < 64; o <<= 1)
#pragma unroll
                              for (int j = 0; j < 8; ++j) ss[j] += bperm_f(ss[j], lane ^ o);
#pragma unroll
                          for (int j = 0; j < 8; ++j) pki[j] = pki[j] * (1.0f / sqrtf(ss[j] * (1.0f / 64.0f) + EPS)) * gik[lane]; }
#pragma unroll
                        for (int j = 0; j < 8; ++j) {
                            const int tl = wave * 8 + j, r = blk * 64 + tl; const int pos = r % SEQ; const int i8 = lane & 7;
                            float rc, rsn; rope_cs(pos, i8, rc, rsn);
                            float x0 = a0[j], x1v = a1[j];
                            {
                              const int j0 = (2 * lane) & 7, j1 = (2 * lane + 1) & 7;
                              const float c_0 = bperm_f(rc, j0), s_0 = bperm_f(rsn, j0), c_1 = bperm_f(rc, j1), s_1 = bperm_f(rsn, j1);
                              const float o0 = bperm_f(x0, lane ^ 4), o1 = bperm_f(x1v, lane ^ 4);
                              if (lane < 4) { x0 = x0 * c_0 - o0 * s_0; x1v = x1v * c_1 - o1 * s_1; } else if (lane < 8) { x0 = x0 * c_0 + o0 * s_0; x1v = x1v * c_1 + o1 * s_1; } }
                            const size_t kimg = (size_t)(r / SEQ) * SEQ * 64 + (size_t)((pos >> 5) * 4) * 512 + (pos & 31) * 8;
                            if (lane < 32) *(GAS unsigned*)(KC + kimg + (lane >> 3) * 512 + ((lane >> 2) & 1) * 256 + ((2 * lane) & 7)) = pk2(x0, x1v);
                            else *(LAS unsigned*)(VCt + tl * 64 + 2 * (lane - 32)) = pk2(x0, x1v);
                            { const int hh = lane >> 3;
                              if (hh < 5) { bf16* p = P + (size_t)r * NIN + C_QC + hh * 64; const float x1 = qc1[j], x2 = qc2[j]; p[i8] = (bf16)f2bf(x1 * rc - x2 * rsn); p[i8 + 8] = (bf16)f2bf(x2 * rc + x1 * rsn); }
                              if (hh < 4) { bf16* p = P + (size_t)r * NIN + C_QI + hh * 64; const float x1 = qi1[j], x2 = qi2[j]; p[i8] = (bf16)f2bf(x1 * rc - x2 * rsn); p[i8 + 8] = (bf16)f2bf(x2 * rc + x1 * rsn); } }
                            { float y = pki[j]; const float other = bperm_f(y, lane ^ 8); if (lane < 8) y = y * rc - other * rsn; else if (lane < 16) y = y * rc + other * rsn;
                              KI[kimg + (lane >> 4) * 512 + ((lane >> 3) & 1) * 256 + (lane & 7)] = (bf16)f2bf(y); }
                            if (lane < NFOX) { const float fv = pfa[j] + bfv;
                                CF[((size_t)(r / SEQ) * NFOX + lane) * SEQ + pos] = fminf(fv, 0.f) - __logf(1.0f + __expf(-fabsf(fv))); }
                            YB[(size_t)r * KUP + 320 + lane] = 0; YC[(size_t)r * KUP + 320 + lane] = 0;
                        }
                        LDS_WAIT(); asm volatile("" ::: "memory");
                        __syncthreads();
                        const int bl = (blk * 64) / SEQ, t0 = (blk * 64) % SEQ;
                        {
                            const int tok0 = lane >> 3, chl = lane & 7;
                            v4u wb[8];
#pragma unroll
                            for (int i = 0; i < 8; ++i) wb[i] = *(const LAS v4u*)(VCt + (tok0 + 8 * i) * 64 + 8 * chl);
                            if (wave < 3) { const GAS bf16* pb = prow + C_VB + (wave + 2) * 64;
#pragma unroll
                              for (int i = 0; i < 8; ++i) wb[i] = *(const GAS v4u*)(pb + (size_t)(8 * i) * NIN); }
#pragma unroll 1
                            for (int rnd = 0; rnd < 2; ++rnd) {
                                const int jt = rnd ? wave + 8 : wave;
                                if (jt < 12) {
#pragma unroll
                                for (int i = 0; i < 8; ++i) { const int tok = tok0 + 8 * i; const v4u w = wa[i];
                                    const int tp = (tok & ~12) | ((tok & 4) << 1) | ((tok & 8) >> 1);
                                    LAS bf16* d = Tt + (8 * chl) * 72 + ((((tp >> 3) ^ chl) << 3) | (tp & 7));
                                    d[0 * 72] = (bf16)(w.x & 0xffffu); d[1 * 72] = (bf16)(w.x >> 16); d[2 * 72] = (bf16)(w.y & 0xffffu); d[3 * 72] = (bf16)(w.y >> 16);
                                    d[4 * 72] = (bf16)(w.z & 0xffffu); d[5 * 72] = (bf16)(w.z >> 16); d[6 * 72] = (bf16)(w.w & 0xffffu); d[7 * 72] = (bf16)(w.w >> 16); }
                                LDS_WAIT(); asm volatile("" ::: "memory");
                                bf16* dst = jt < 6 ? VTA + ((size_t)(bl * NFOX + jt) * 64) * SEQ : jt < 11 ? VTB + ((size_t)(bl * NSB + (jt - 6)) * 64) * SEQ : VTC + ((size_t)bl * 64) * SEQ;
                                v4u o[8];
#pragma unroll
                                for (int i = 0; i < 8; ++i) o[i] = *(const LAS v4u*)(Tt + (tok0 + 8 * i) * 72 + 8 * (chl ^ i));
#pragma unroll
                                for (int i = 0; i < 8; ++i) { const int d = tok0 + 8 * i;
                                    *(GAS v4u*)(dst + ((size_t)(((t0 >> 5) + (chl >> 2)) * 2 + (d >> 5)) * 2 + ((chl & 3) >> 1)) * 512 + ((d & 31) + 32 * (chl & 1)) * 8) = o[i]; }
                                LDS_WAIT(); asm volatile("" ::: "memory");
                                }
#pragma unroll
                                for (int i = 0; i < 8; ++i) wa[i] = wb[i];
                            }
                        }
                        __syncthreads();
                    }
                PH_END
                PH_BEGIN
                    { const int vw = gw >> 3, w8 = gw & 7; const int nF = G < 192 ? G : 192, nS = G - nF;
                      for (int it = vw; it < HB * NFOX * 4; it += G) { const int q4 = it / (HB * NFOX), bh = it % (HB * NFOX);
                            LAS float* cfL = (LAS float*)(lds + RING_OFF);
                            __syncthreads();
                            {
                                const int ti = (int)tx_; f32x4 v = *(const GAS f32x4*)(CF + (size_t)bh * SEQ + 4 * ti);
                                v[1] += v[0]; v[2] += v[1]; v[3] += v[2];
                                float tot = v[3];
#pragma unroll
                                for (int o = 1; o < 64; o <<= 1) { const float n = bperm_f(tot, lane - o); if (lane >= o) tot += n; }
                                LAS float* wtot = cfL + SEQ;
                                if (lane == 63) wtot[wave] = tot;
                                __syncthreads();
                                float base = tot - v[3];
#pragma unroll
                                for (int w = 0; w < 8; ++w) base += w < wave ? wtot[w] : 0.f;
                                *(LAS f32x4*)(cfL + 4 * ti) = (v + base) * (-LOG2E);
                            }
                            __syncthreads();
#pragma unroll 1
                            for (int hl = 0; hl < 2; ++hl) fox_strip(P, KAI, cfL, VTA, YA, bh / NFOX, bh % NFOX, hl == 0 ? (7 - q4) * 8 + 7 - w8 : q4 * 8 + w8, lane); }
                      if (nS > 0) { if (vw >= nF) for (int E = vw - nF; E < HB * NSB * 8; E += nS) { const int Qg = 7 - E / (HB * NSB), bh = E % (HB * NSB); sb_strip(P, KBI, VTB, YB, bh / NSB, bh % NSB, Qg * 8 + 7 - w8, lane); } }
                      else for (int E = vw; E < HB * NSB * 8; E += G) { const int Qg = 7 - E / (HB * NSB), bh = E % (HB * NSB); sb_strip(P, KBI, VTB, YB, bh / NSB, bh % NSB, Qg * 8 + 7 - w8, lane); }
                    }
                    __syncthreads();
                    for (int rd = 0; rd * G < HB * 64; ++rd) { const int vw = gw >> 3; const int U = rd * G + ((rd & 1) ? G - 1 - vw : vw);
                        if (U < HB * 64) dsa_unit(P, PF, KI, KC, VTC, YC, U % HB, 63 - U / HB, wave, lane, lds + RING_OFF); }
                PH_END
                PH_BEGIN
                    pg8::SegOrder3 S; S.init(MH, DM, G, bx);
                    { pg8::Gemm g{YA, WUP, MH, DM, 384, KUP}; pg8::EpiGateR E{P + C_GATE, MGB}; pg8::gemm_phase<pg8::EpiGateR, pg8::SegOrder3, true, true>(lds + RING_OFF, g, S, E, (int)TX_NOW()); }
                PH_END
                PH_BEGIN
                    pg8::Gemm g{MGB, WOUT, MH, DM, DM, 0}; pg8::StaticOrder S; S.init(MH, DM, G, bx);
                    pg8::EpiResid E{XB + rb * DM, SSQ + rb * 16, 1.0f};
                    pg8::gemm_phase<pg8::EpiResid, pg8::StaticOrder, true, true>(lds + RING_OFF, g, S, E, (int)TX_NOW());
                    if (hf == 0) { const size_t rb1 = (size_t)MH;

                    pg8::Gemm g{XB + rb1 * DM, WIN, MH, NIN, DM, 0}; pg8::StaticOrder S; S.init(MH, NIN, G, bx);
                    LAS float* rsT = (LAS float*)(lds + RST_OFF);
                    pg8::EpiWin E{rsT, P, PF, NIN};
                    { const float* ssq_ = SSQ + rb1 * 16; auto pre = [&]() { pg8::rs_table_fill(rsT, ssq_, S, (int)TX_NOW()); };
                      pg8::gemm_phase<pg8::EpiWin, pg8::StaticOrder, true, true>(lds + RING_OFF, g, S, E, (int)TX_NOW(), pre); }
                                    }
                PH_END
            }
        }
    }
    PH_BEGIN
        const float* gf = ka->in[17];
        const GAS f32x4* gr = (const GAS f32x4*)gf + lane; f32x4 gv[4];
#pragma unroll
        for (int j = 0; j < 4; ++j) gv[j] = gr[64 * j];
        for (int m0 = gw * 4; m0 < MTOK; m0 += NGW * 4) {
            u32x2 w[4][4];
#pragma unroll
            for (int q = 0; q < 4; ++q) { const GAS u32x2* xr = (const GAS u32x2*)(XB + (size_t)(m0 + q) * DM) + lane;
#pragma unroll
                for (int j = 0; j < 4; ++j) w[q][j] = xr[64 * j]; }
#pragma unroll
            for (int q = 0; q < 4; ++q) { f32x4 v[4]; float s = 0.f;
#pragma unroll
                for (int j = 0; j < 4; ++j) { v[j][0] = bflo(w[q][j].x); v[j][1] = bfhi(w[q][j].x); v[j][2] = bflo(w[q][j].y); v[j][3] = bfhi(w[q][j].y); s += (v[j][0] * v[j][0] + v[j][1] * v[j][1]) + (v[j][2] * v[j][2] + v[j][3] * v[j][3]); }
                const float rs = 1.0f / sqrtf(wave_sum(s, lane) * (1.0f / DM) + EPS);
                GAS f32x4* orow = (GAS f32x4*)(xf + (size_t)(m0 + q) * DM) + lane;
#pragma unroll
                for (int j = 0; j < 4; ++j) orow[64 * j] = v[j] * rs * gv[j]; }
        }
    PH_END
#undef PH_BEGIN
#undef PH_END
}

#ifndef MK_N_LAUNCHES
#define MK_N_LAUNCHES 1
#endif
constexpr int N_PHASES = 1 + DEPTH * (2 + 1 + 2 * 4 + 2) + 1;
extern "C" void kernel_launch(void* const* d_in, const int* in_sizes, int n_in, void* d_out, int out_size, void* d_ws, size_t ws_size, hipStream_t stream) {
    static int grid = 0;
    if (grid == 0) {
        if (n_in != 18 || in_sizes[0] != MTOK * DM || out_size != MTOK * DM || ws_size < WS_END) { fprintf(stderr, "kernel_launch: unexpected shapes (n_in %d, in0 %d, out %d, ws %zu); nothing launched\n", n_in, n_in > 0 ? in_sizes[0] : -1, out_size, ws_size); grid = -1; return; }
        int dev = 0, cus = 0, per_cu = 0;
        if (hipGetDevice(&dev) != hipSuccess || hipDeviceGetAttribute(&cus, hipDeviceAttributeMultiprocessorCount, dev) != hipSuccess) { grid = -1; return; }
        if (hipFuncSetAttribute((const void*)mk_fwd, hipFuncAttributeMaxDynamicSharedMemorySize, LDS_BYTES) != hipSuccess) { fprintf(stderr, "kernel_launch: hipFuncSetAttribute failed\n"); grid = -1; return; }
        if (hipOccupancyMaxActiveBlocksPerMultiprocessor(&per_cu, (const void*)mk_fwd, NWAVES * 64, LDS_BYTES) != hipSuccess || per_cu < 1) fprintf(stderr, "kernel_launch: occupancy query reports %d workgroups per CU\n", per_cu);
        (void)hipGetLastError();
        grid = cus;
        if (grid > 256) grid = 256;
    }
    if (grid < 0) return;
    if (hipMemsetAsync((char*)d_ws + WS_CTL, 0, CTL_ZERO_BYTES, stream) != hipSuccess) return;
    Args a{};
    for (int i = 0; i < 18; ++i) a.in[i] = (const float*)d_in[i];
    a.out = (float*)d_out; a.ws = (unsigned char*)d_ws; a.pad = 0;
    const int nl = MK_N_LAUNCHES;
    for (int li = 0; li < nl; ++li) {
        a.ph_lo = (int)((long)N_PHASES * li / nl); a.ph_hi = (int)((long)N_PHASES * (li + 1) / nl); a.li = li;
        hipLaunchKernelGGL(mk_fwd, dim3(grid), dim3(NWAVES * 64), LDS_BYTES, stream, a);
        const hipError_t le = hipPeekAtLastError();
        if (le != hipSuccess) { fprintf(stderr, "kernel_launch: launch %d failed: %s\n", li, hipGetErrorName(le)); break; }
    }
}
```

```cpp
#include <hip/hip_runtime.h>
#include <cstdio>
#include <cstdint>
#include <cmath>
namespace pg8 {
#define PG8_LAS __attribute__((address_space(3)))
typedef unsigned short bf16_t;
typedef short bf16x8 __attribute__((ext_vector_type(8)));
typedef float f32x4 __attribute__((ext_vector_type(4)));
typedef unsigned u32x4 __attribute__((ext_vector_type(4)));
constexpr int BM = 256, BK = 64, HALF = 128, HTB = HALF * BK * 2  , STAGE_BYTES = 8 * HTB, NXCD = 8, WGM = 8;

__host__ __device__ __forceinline__ int lds_byte(int r, int c) { const int st = (r >> 4) * 2 + (c >> 5), rr = r & 15, cc = c & 31, ob = rr * 64 + cc * 2; return st * 1024 + (ob ^ (((ob >> 9) & 1) << 5)); }
__host__ __device__ __forceinline__ void stage_rc(int b, int& R, int& C) { const int st = b / 1024, sb = b % 1024, swz = sb ^ (((sb >> 9) & 1) << 5); R = (st >> 1) * 16 + swz / 64; C = (st & 1) * 32 + (swz % 64) / 2; }
__host__ __device__ __forceinline__ int perm32(int rho) { const int n = rho >> 4, i = rho & 15; return 8 * (i >> 2) + 4 * n + (i & 3); }

struct Unit { int pm, pn, ks, ui; };
struct Gemm { const bf16_t* A; const bf16_t* Bt; int M, N, K, ld; };

struct StaticOrder {
    int nM, nN, nwg, G, c;
    __host__ __device__ void init(int M, int N, int G_, int c_) { nM = M / BM; nN = N / BM; nwg = nM * nN; G = G_; c = c_; }
    __host__ __device__ bool next(int i, Unit& u) const {
        const long L = (long)i * G + c; if (L >= nwg) return false;
        int wgid = (int)L; { const int q = nwg / NXCD, r = nwg % NXCD, xcd = wgid % NXCD, off = wgid / NXCD; wgid = (xcd < r ? xcd * (q + 1) : r * (q + 1) + (xcd - r) * q) + off; }
        const int nig = WGM * nN, gid = wgid / nig, fm = gid * WGM, gsz = (nM - fm) < WGM ? (nM - fm) : WGM;
        u.pm = fm + ((wgid % nig) % gsz); u.pn = (wgid % nig) / gsz; u.ks = 0; u.ui = i; return true;
    }
    __device__ __forceinline__ void a_ready(const Unit&) const {}
    __device__ __forceinline__ void done(const Unit&) const {}
};

__device__ __forceinline__ unsigned cvt_pk_bf16(float lo, float hi) { unsigned r; asm volatile("v_cvt_pk_bf16_f32 %0, %1, %2" : "=v"(r) : "v"(lo), "v"(hi)); return r; }
typedef float f32x2 __attribute__((ext_vector_type(2)));

#define PG8_GAS __attribute__((address_space(1)))
__device__ __forceinline__ float row_rs(const float* ssq, int row) {
    const f32x4* p = (const f32x4*)(ssq + (size_t)row * 16);
    const f32x4 a = p[0], b = p[1], c = p[2], d = p[3];
    const float s = (((a[0] + a[1]) + (a[2] + a[3])) + ((b[0] + b[1]) + (b[2] + b[3]))) + (((c[0] + c[1]) + (c[2] + c[3])) + ((d[0] + d[1]) + (d[2] + d[3])));
    return 1.0f / sqrtf(s * (1.0f / 1024.0f) + 1e-6f);
}
__device__ __forceinline__ float sigmoid_f(float v) { return __builtin_amdgcn_rcpf(1.0f + __expf(-v)); }
__device__ __forceinline__ float bf_lo(unsigned w) { return __uint_as_float(w << 16); }
__device__ __forceinline__ float bf_hi(unsigned w) { return __uint_as_float(w & 0xffff0000u); }

template <class Sched> __device__ __forceinline__ void rs_table_fill(PG8_LAS float* rsT, const float* ssq, const Sched& S, int tid) {
    Unit u; const int row = tid >> 1, hf = tid & 1;
    f32x4 a[12], b[12]; int n = 0;
#pragma unroll
    for (int i = 0; i < 12; ++i) { if (S.next(i, u)) { const PG8_GAS f32x4* p = (const PG8_GAS f32x4*)(ssq + (size_t)(u.pm * BM + row) * 16 + 8 * hf); a[i] = p[0]; b[i] = p[1]; n = i + 1; } else { a[i] = f32x4{}; b[i] = f32x4{}; } }
#pragma unroll
    for (int i = 0; i < 12; ++i) {
        float s = ((a[i][0] + a[i][1]) + (a[i][2] + a[i][3])) + ((b[i][0] + b[i][1]) + (b[i][2] + b[i][3]));
        s += __int_as_float(__builtin_amdgcn_ds_bpermute(((tid & 63) ^ 1) << 2, __float_as_int(s)));
        if (hf == 0 && i < n) rsT[i * BM + row] = 1.0f / sqrtf(s * (1.0f / 1024.0f) + 1e-6f);
    }
    __syncthreads();
}
#define PIN8(a) asm volatile("" : "+v"((a)[0]), "+v"((a)[1]), "+v"((a)[2]), "+v"((a)[3]), "+v"((a)[4]), "+v"((a)[5]), "+v"((a)[6]), "+v"((a)[7]))
#define PIN4X2(a) asm volatile("" : "+v"((a)[0]), "+v"((a)[1]), "+v"((a)[2]), "+v"((a)[3]))
struct EpiSwiglu {
    static constexpr bool PERM = true, AFTER_DRAIN = false, CARRY = false;
    const PG8_LAS float* rsT; bf16_t* H; int ldh;
    __device__ __forceinline__ void operator()(const f32x4 (&acc)[2][2][4][2], const Unit& u, int wr, int wc, int fr, int fq) const {
        const int row0 = u.pm * BM + wr * 64 + fr, col0 = u.pn * HALF + wc * 32 + 8 * fq;
#pragma unroll
        for (int ai = 0; ai < 2; ++ai)
#pragma unroll
            for (int m = 0; m < 4; ++m) {
                const int row = row0 + ai * HALF + m * 16; const float r = rsT[u.ui * BM + wr * 64 + fr + ai * HALF + m * 16];
                const float rn = r * -1.4426950408889634f, rq = r * r;
                f32x2 g[4], p[4], t[4];
#pragma unroll
                for (int n = 0; n < 2; ++n) { const f32x4 G4 = acc[ai][0][m][n], U4 = acc[ai][1][m][n];
                    g[2 * n] = f32x2{G4[0], G4[1]}; g[2 * n + 1] = f32x2{G4[2], G4[3]}; p[2 * n] = f32x2{U4[0], U4[1]}; p[2 * n + 1] = f32x2{U4[2], U4[3]}; }
#pragma unroll
                for (int i = 0; i < 4; ++i) { t[i] = g[i] * rn; p[i] = g[i] * p[i]; }
                PIN4X2(t);
#pragma unroll
                for (int i = 0; i < 4; ++i) { t[i][0] = __builtin_amdgcn_exp2f(t[i][0]); t[i][1] = __builtin_amdgcn_exp2f(t[i][1]); }
                PIN4X2(t);
#pragma unroll
                for (int i = 0; i < 4; ++i) { t[i] = t[i] + 1.0f; p[i] = p[i] * rq; }
                PIN4X2(t);
#pragma unroll
                for (int i = 0; i < 4; ++i) { t[i][0] = __builtin_amdgcn_rcpf(t[i][0]); t[i][1] = __builtin_amdgcn_rcpf(t[i][1]); }
                PIN4X2(t);
#pragma unroll
                for (int i = 0; i < 4; ++i) t[i] = t[i] * p[i];
                u32x4 w; w.x = cvt_pk_bf16(t[0][0], t[0][1]); w.y = cvt_pk_bf16(t[1][0], t[1][1]); w.z = cvt_pk_bf16(t[2][0], t[2][1]); w.w = cvt_pk_bf16(t[3][0], t[3][1]);
                *(PG8_GAS u32x4*)(H + (size_t)row * ldh + col0) = w;
            }
    }
};
struct EpiResid {
    static constexpr bool PERM = true, AFTER_DRAIN = false, CARRY = false;
    bf16_t* xb; float* ssq; float alpha;
    __device__ __forceinline__ void operator()(const f32x4 (&acc)[2][2][4][2], const Unit& u, int wr, int wc, int fr, int fq) const {
        const int row0 = u.pm * BM + wr * 64 + fr, col0 = u.pn * BM + wc * 32 + 8 * fq;
#pragma unroll
        for (int ai = 0; ai < 2; ++ai)
        {
            u32x4 xov[4][2];
#pragma unroll
            for (int m = 0; m < 4; ++m)
#pragma unroll
                for (int bj = 0; bj < 2; ++bj) xov[m][bj] = *(const PG8_GAS u32x4*)(xb + (size_t)(row0 + ai * HALF + m * 16) * 1024 + col0 + bj * HALF);
#pragma unroll
            for (int m = 0; m < 4; ++m) {
                const int row = row0 + ai * HALF + m * 16; float sq = 0.f;
#pragma unroll
                for (int bj = 0; bj < 2; ++bj) {
                    const u32x4 xo = xov[m][bj];
                    f32x4 x0, x1; x0[0] = bf_lo(xo.x); x0[1] = bf_hi(xo.x); x0[2] = bf_lo(xo.y); x0[3] = bf_hi(xo.y); x1[0] = bf_lo(xo.z); x1[1] = bf_hi(xo.z); x1[2] = bf_lo(xo.w); x1[3] = bf_hi(xo.w);
                    x0 += acc[ai][bj][m][0] * alpha; x1 += acc[ai][bj][m][1] * alpha;
                    u32x4 w; w.x = cvt_pk_bf16(x0[0], x0[1]); w.y = cvt_pk_bf16(x0[2], x0[3]); w.z = cvt_pk_bf16(x1[0], x1[1]); w.w = cvt_pk_bf16(x1[2], x1[3]);
                    *(PG8_GAS u32x4*)(xb + (size_t)row * 1024 + col0 + bj * HALF) = w;
                    sq += ((x0[0] * x0[0] + x0[1] * x0[1]) + (x0[2] * x0[2] + x0[3] * x0[3])) + ((x1[0] * x1[0] + x1[1] * x1[1]) + (x1[2] * x1[2] + x1[3] * x1[3]));
                }
                { const int ln_ = fq * 16 + fr;
                  sq += __int_as_float(__builtin_amdgcn_ds_bpermute((ln_ ^ 16) << 2, __float_as_int(sq))); sq += __int_as_float(__builtin_amdgcn_ds_bpermute((ln_ ^ 32) << 2, __float_as_int(sq))); }
                if (fq == 0) *(PG8_GAS float*)(ssq + (size_t)row * 16 + u.pn * 4 + wc) = sq;
            }
        }
    }
};
struct EpiWin {
    static constexpr bool PERM = true, AFTER_DRAIN = false, CARRY = false;
    static constexpr int KA0 = 384, NHA = 6, KB0 = 1472, NHB = 5, SEQL = 2048; static constexpr long KAI_OFF = (364L - 120L) << 20, KBI_OFF = (376L - 120L) << 20;
    const PG8_LAS float* rsT; bf16_t* P; float* Pf; int ldp;
    __device__ __forceinline__ void operator()(const f32x4 (&acc)[2][2][4][2], const Unit& u, int wr, int wc, int fr, int fq) const {
        const int row0 = u.pm * BM + wr * 64 + fr, cin = wc * 32 + 8 * fq;
#pragma unroll
        for (int ai = 0; ai < 2; ++ai)
#pragma unroll
            for (int m = 0; m < 4; ++m) {
                const int row = row0 + ai * HALF + m * 16; const float r = rsT[u.ui * BM + wr * 64 + fr + ai * HALF + m * 16];
                if (u.pn == 11) {
#pragma unroll
                    for (int bj = 0; bj < 2; ++bj) { const f32x4 v0 = acc[ai][bj][m][0] * r, v1 = acc[ai][bj][m][1] * r;
                        PG8_GAS float* o = (PG8_GAS float*)(Pf + (size_t)row * 256 + cin + bj * HALF); *(PG8_GAS f32x4*)o = v0; *(PG8_GAS f32x4*)(o + 4) = v1; }
                } else if (u.pn >= 12) {
                    const float rn = r * -1.4426950408889634f;
                    f32x2 t[8];
#pragma unroll
                    for (int bj = 0; bj < 2; ++bj)
#pragma unroll
                        for (int n = 0; n < 2; ++n) { const f32x4 A4 = acc[ai][bj][m][n]; t[4 * bj + 2 * n] = f32x2{A4[0], A4[1]} * rn; t[4 * bj + 2 * n + 1] = f32x2{A4[2], A4[3]} * rn; }
                    PIN4X2(t); PIN4X2(t + 4);
#pragma unroll
                    for (int i = 0; i < 8; ++i) { t[i][0] = __builtin_amdgcn_exp2f(t[i][0]); t[i][1] = __builtin_amdgcn_exp2f(t[i][1]); }
                    PIN4X2(t); PIN4X2(t + 4);
#pragma unroll
                    for (int i = 0; i < 8; ++i) t[i] = t[i] + 1.0f;
                    PIN4X2(t); PIN4X2(t + 4);
#pragma unroll
                    for (int i = 0; i < 8; ++i) { t[i][0] = __builtin_amdgcn_rcpf(t[i][0]); t[i][1] = __builtin_amdgcn_rcpf(t[i][1]); }
#pragma unroll
                    for (int bj = 0; bj < 2; ++bj) { u32x4 w; w.x = cvt_pk_bf16(t[4 * bj][0], t[4 * bj][1]); w.y = cvt_pk_bf16(t[4 * bj + 1][0], t[4 * bj + 1][1]); w.z = cvt_pk_bf16(t[4 * bj + 2][0], t[4 * bj + 2][1]); w.w = cvt_pk_bf16(t[4 * bj + 3][0], t[4 * bj + 3][1]);
                        *(PG8_GAS u32x4*)(P + (size_t)row * ldp + u.pn * BM + cin + bj * HALF) = w; }
                } else {
#pragma unroll
                    for (int bj = 0; bj < 2; ++bj) { const f32x4 v0 = acc[ai][bj][m][0] * r, v1 = acc[ai][bj][m][1] * r;
                        u32x4 w; w.x = cvt_pk_bf16(v0[0], v0[1]); w.y = cvt_pk_bf16(v0[2], v0[3]); w.z = cvt_pk_bf16(v1[0], v1[1]); w.w = cvt_pk_bf16(v1[2], v1[3]);
                        const int gb = u.pn * BM + wc * 32 + bj * HALF;
                        const bool isKa = gb >= KA0 && gb < KA0 + 64 * NHA, isKb = gb >= KB0 && gb < KB0 + 64 * NHB;
                        if (isKa || isKb) {
                            const int rel = gb - (isKa ? KA0 : KB0), head = rel >> 6, c = ((rel & 63) >> 3) + fq, bt = row / SEQL, pos = row % SEQL;
                            bf16_t* img = (bf16_t*)((char*)P + (isKa ? KAI_OFF : KBI_OFF)) + (size_t)(bt * (isKa ? NHA : NHB) + head) * 64 * SEQL;
                            *(PG8_GAS u32x4*)(img + ((size_t)((pos >> 5) * 4 + (c >> 1)) * 64 + (pos & 31) + 32 * (c & 1)) * 8) = w;
                        } else *(PG8_GAS u32x4*)(P + (size_t)row * ldp + gb + 8 * fq) = w; }
                }
            }
    }
};
template <int MODE> struct EpiGate {
    static constexpr bool PERM = true, AFTER_DRAIN = false, CARRY = false;
    const bf16_t* G; int ldg; bf16_t* part; bf16_t* mgb;
    __device__ __forceinline__ void operator()(const f32x4 (&acc)[2][2][4][2], const Unit& u, int wr, int wc, int fr, int fq) const {
        const int row0 = u.pm * BM + wr * 64 + fr, col0 = u.pn * BM + wc * 32 + 8 * fq;
#pragma unroll
        for (int ai = 0; ai < 2; ++ai)
        {
            u32x4 gwv[4][2], pwv[4][2];
#pragma unroll
            for (int m = 0; m < 4; ++m)
#pragma unroll
                for (int bj = 0; bj < 2; ++bj) { const int row = row0 + ai * HALF + m * 16, col = col0 + bj * HALF;
                    gwv[m][bj] = *(const PG8_GAS u32x4*)(G + (size_t)row * ldg + col);
                    if (MODE >= 1) pwv[m][bj] = *(const PG8_GAS u32x4*)(part + (size_t)row * 1024 + col); }
#pragma unroll
            for (int m = 0; m < 4; ++m) {
                const int row = row0 + ai * HALF + m * 16;
#pragma unroll
                for (int bj = 0; bj < 2; ++bj) {
                    const int col = col0 + bj * HALF;
                    const u32x4 gw = gwv[m][bj];
                    f32x4 v0 = acc[ai][bj][m][0], v1 = acc[ai][bj][m][1];
                    v0[0] *= bf_lo(gw.x); v0[1] *= bf_hi(gw.x); v0[2] *= bf_lo(gw.y); v0[3] *= bf_hi(gw.y);
                    v1[0] *= bf_lo(gw.z); v1[1] *= bf_hi(gw.z); v1[2] *= bf_lo(gw.w); v1[3] *= bf_hi(gw.w);
                    if (MODE >= 1) { const u32x4 pw = pwv[m][bj];
                        v0[0] += bf_lo(pw.x); v0[1] += bf_hi(pw.x); v0[2] += bf_lo(pw.y); v0[3] += bf_hi(pw.y); v1[0] += bf_lo(pw.z); v1[1] += bf_hi(pw.z); v1[2] += bf_lo(pw.w); v1[3] += bf_hi(pw.w); }
                    u32x4 w; w.x = cvt_pk_bf16(v0[0], v0[1]); w.y = cvt_pk_bf16(v0[2], v0[3]); w.z = cvt_pk_bf16(v1[0], v1[1]); w.w = cvt_pk_bf16(v1[2], v1[3]);
                    *(PG8_GAS u32x4*)((MODE <= 1 ? part : mgb) + (size_t)row * 1024 + col) = w;
                }
            }
        }
    }
};

struct SegOrder3 : StaticOrder {
    __host__ __device__ bool next(int i, Unit& u) const { const bool ok = StaticOrder::next(i / 3, u); u.ks = i % 3; u.ui = i; return ok; }
};
struct EpiGateU {
    static constexpr bool PERM = true, AFTER_DRAIN = false, CARRY = false;
    const bf16_t* G; bf16_t* mgb; static constexpr int ldg = 6144;
    __device__ __forceinline__ void operator()(const f32x4 (&acc)[2][2][4][2], const Unit& u, int wr, int wc, int fr, int fq) const {
        const int row0 = u.pm * BM + wr * 64 + fr, col0 = u.pn * BM + wc * 32 + 8 * fq;
        const bf16_t* Gs = G + u.ks * 1024; const unsigned keep = u.ks ? 0xffffffffu : 0u;
#pragma unroll
        for (int ai = 0; ai < 2; ++ai)
        {
            u32x4 gwv[4][2], pwv[4][2];
#pragma unroll
            for (int m = 0; m < 4; ++m)
#pragma unroll
                for (int bj = 0; bj < 2; ++bj) { const int row = row0 + ai * HALF + m * 16, col = col0 + bj * HALF;
                    gwv[m][bj] = *(const PG8_GAS u32x4*)(Gs + (size_t)row * ldg + col);
                    pwv[m][bj] = *(const PG8_GAS u32x4*)(mgb + (size_t)row * 1024 + col); }
#pragma unroll
            for (int m = 0; m < 4; ++m) {
                const int row = row0 + ai * HALF + m * 16;
#pragma unroll
                for (int bj = 0; bj < 2; ++bj) {
                    const int col = col0 + bj * HALF;
                    const u32x4 gw = gwv[m][bj]; u32x4 pw = pwv[m][bj]; pw.x &= keep; pw.y &= keep; pw.z &= keep; pw.w &= keep;
                    f32x4 v0 = acc[ai][bj][m][0], v1 = acc[ai][bj][m][1];
                    v0[0] = fmaf(v0[0], bf_lo(gw.x), bf_lo(pw.x)); v0[1] = fmaf(v0[1], bf_hi(gw.x), bf_hi(pw.x)); v0[2] = fmaf(v0[2], bf_lo(gw.y), bf_lo(pw.y)); v0[3] = fmaf(v0[3], bf_hi(gw.y), bf_hi(pw.y));
                    v1[0] = fmaf(v1[0], bf_lo(gw.z), bf_lo(pw.z)); v1[1] = fmaf(v1[1], bf_hi(gw.z), bf_hi(pw.z)); v1[2] = fmaf(v1[2], bf_lo(gw.w), bf_lo(pw.w)); v1[3] = fmaf(v1[3], bf_hi(gw.w), bf_hi(pw.w));
                    u32x4 w; w.x = cvt_pk_bf16(v0[0], v0[1]); w.y = cvt_pk_bf16(v0[2], v0[3]); w.z = cvt_pk_bf16(v1[0], v1[1]); w.w = cvt_pk_bf16(v1[2], v1[3]);
                    *(PG8_GAS u32x4*)(mgb + (size_t)row * 1024 + col) = w;
                }
            }
        }
    }
};

struct EpiGateR {
    static constexpr bool PERM = true, AFTER_DRAIN = false, CARRY = true;
    const bf16_t* G; bf16_t* mgb; static constexpr int ldg = 6144;
    __device__ __forceinline__ void operator()(const f32x4 (&acc)[2][2][4][2], const Unit& u, int wr, int wc, int fr, int fq) const {
        if (u.ks != 2) return;
        const int row0 = u.pm * BM + wr * 64 + fr, col0 = u.pn * BM + wc * 32 + 8 * fq;
        const bf16_t* Gs = G + 2 * 1024;
#pragma unroll
        for (int ai = 0; ai < 2; ++ai)
        {
            u32x4 gwv[4][2];
#pragma unroll
            for (int m = 0; m < 4; ++m)
#pragma unroll
                for (int bj = 0; bj < 2; ++bj) gwv[m][bj] = *(const PG8_GAS u32x4*)(Gs + (size_t)(row0 + ai * HALF + m * 16) * ldg + col0 + bj * HALF);
#pragma unroll
            for (int m = 0; m < 4; ++m)
#pragma unroll
                for (int bj = 0; bj < 2; ++bj) {
                    const u32x4 gw = gwv[m][bj]; f32x4 v0 = acc[ai][bj][m][0], v1 = acc[ai][bj][m][1];
                    v0[0] *= bf_lo(gw.x); v0[1] *= bf_hi(gw.x); v0[2] *= bf_lo(gw.y); v0[3] *= bf_hi(gw.y); v1[0] *= bf_lo(gw.z); v1[1] *= bf_hi(gw.z); v1[2] *= bf_lo(gw.w); v1[3] *= bf_hi(gw.w);
                    u32x4 w; w.x = cvt_pk_bf16(v0[0], v0[1]); w.y = cvt_pk_bf16(v0[2], v0[3]); w.z = cvt_pk_bf16(v1[0], v1[1]); w.w = cvt_pk_bf16(v1[2], v1[3]);
                    *(PG8_GAS u32x4*)(mgb + (size_t)(row0 + ai * HALF + m * 16) * 1024 + col0 + bj * HALF) = w;
                }
        }
    }
    __device__ __forceinline__ void carry(f32x4 (&acc)[2][2][4][2], const Unit& u, int wr, int wc, int fr, int fq) const {
        const int row0 = u.pm * BM + wr * 64 + fr, col0 = u.pn * BM + wc * 32 + 8 * fq;
        const int kn = u.ks < 2 ? u.ks + 1 : 2; const float z = u.ks < 2 ? 1.0f : 0.0f;
        const bf16_t* Ga = G + u.ks * 1024; const bf16_t* Gb = G + kn * 1024;
#pragma unroll
        for (int ai = 0; ai < 2; ++ai)
#pragma unroll
        for (int mh = 0; mh < 2; ++mh)
        {
            u32x4 ga[2][2], gb[2][2];
#pragma unroll
            for (int m2 = 0; m2 < 2; ++m2)
#pragma unroll
                for (int bj = 0; bj < 2; ++bj) { const size_t o_ = (size_t)(row0 + ai * HALF + (2 * mh + m2) * 16) * ldg + col0 + bj * HALF; ga[m2][bj] = *(const PG8_GAS u32x4*)(Ga + o_); gb[m2][bj] = *(const PG8_GAS u32x4*)(Gb + o_); }
#pragma unroll
            for (int m2 = 0; m2 < 2; ++m2)
#pragma unroll
                for (int bj = 0; bj < 2; ++bj) { const int m = 2 * mh + m2; const u32x4 a_ = ga[m2][bj], b_ = gb[m2][bj];
                    float fa[8] = {bf_lo(a_.x), bf_hi(a_.x), bf_lo(a_.y), bf_hi(a_.y), bf_lo(a_.z), bf_hi(a_.z), bf_lo(a_.w), bf_hi(a_.w)};
                    float fb[8] = {bf_lo(b_.x), bf_hi(b_.x), bf_lo(b_.y), bf_hi(b_.y), bf_lo(b_.z), bf_hi(b_.z), bf_lo(b_.w), bf_hi(b_.w)};
#pragma unroll
                    for (int e_ = 0; e_ < 8; ++e_) fb[e_] = __builtin_amdgcn_rcpf(fb[e_]);
#pragma unroll
                    for (int e_ = 0; e_ < 8; ++e_) fa[e_] = fa[e_] * fb[e_] * z;
#pragma unroll
                    for (int n_ = 0; n_ < 2; ++n_) { f32x4 v_ = acc[ai][bj][m][n_];
                        asm volatile("v_mul_f32 %0, %0, %4\n\tv_mul_f32 %1, %1, %5\n\tv_mul_f32 %2, %2, %6\n\tv_mul_f32 %3, %3, %7" : "+v"(v_[0]), "+v"(v_[1]), "+v"(v_[2]), "+v"(v_[3]) : "v"(fa[4 * n_ + 0]), "v"(fa[4 * n_ + 1]), "v"(fa[4 * n_ + 2]), "v"(fa[4 * n_ + 3]));
                        acc[ai][bj][m][n_] = v_; } }
            asm volatile("" ::: "memory");
        }
    }
};

struct NoPre { __device__ __forceinline__ void operator()() const {} };
template <class Epi, class Sched, bool ALIGN_EPI = false, bool SP2 = false, class Pre = NoPre>
__device__ __forceinline__ void gemm_phase(PG8_LAS unsigned char* lds, const Gemm g, const Sched& S, const Epi& E, int tid_in, const Pre& pre = Pre()) {
    int tid_ = tid_in; asm volatile("" : "+v"(tid_));
    const int tid = tid_, wid = __builtin_amdgcn_readfirstlane(tid >> 6), lane = tid & 63, wr = wid >> 2, wc = wid & 3, fr = lane & 15, fq = lane >> 4;
    const int K = g.K, nt = K / BK, ld = g.ld ? g.ld : g.K;
    unsigned voffA[2], voffB[2];
#pragma unroll
    for (int i = 0; i < 2; ++i) { int R, C; stage_rc(tid * 16 + i * 8192, R, C); const int Rb = Epi::PERM ? ((R & ~31) + perm32(R & 31)) : R;
        voffA[i] = (unsigned)(R * ld + C) * 2u; voffB[i] = (unsigned)(Rb * ld + C) * 2u; }
    const size_t kstep = (size_t)(BK * 2);
    const size_t hstep = (size_t)HALF * ld * 2;
    const size_t tstep = 2 * hstep;
    const unsigned ldsw = (unsigned)wid * 1024u;
    const int aoff = lds_byte(wr * 64 + fr, fq * 8), boff = lds_byte(wc * 32 + fr, fq * 8);
#define PG8_SA(b, h) (((b) * 2 + (h)) * HTB)
#define PG8_SB(b, h) ((4 + (b) * 2 + (h)) * HTB)
#define PG8_STAGE(bufoff, gbase, voff) do { _Pragma("unroll") for (int _i = 0; _i < 2; ++_i) \
        __builtin_amdgcn_global_load_lds((const unsigned*)((const char*)(gbase) + (voff)[_i]), (PG8_LAS unsigned*)(lds + (bufoff) + ldsw + _i * 8192), 16, 0, 0); } while (0)
#define PG8_LDA(dst, b, h) do { _Pragma("unroll") for (int m = 0; m < 4; ++m) _Pragma("unroll") for (int k = 0; k < 2; ++k) dst[m][k] = *(const PG8_LAS bf16x8*)(lds + PG8_SA(b, h) + aoff + m * 2048 + k * 1024); } while (0)
#define PG8_LDB(dst, b, h) do { _Pragma("unroll") for (int n = 0; n < 2; ++n) _Pragma("unroll") for (int k = 0; k < 2; ++k) dst[n][k] = *(const PG8_LAS bf16x8*)(lds + PG8_SB(b, h) + boff + n * 2048 + k * 1024); } while (0)
#define PG8_MMA(ai, bj, At, Bt) do { __builtin_amdgcn_s_setprio(1); _Pragma("unroll") for (int m = 0; m < 4; ++m) _Pragma("unroll") for (int n = 0; n < 2; ++n) _Pragma("unroll") for (int k = 0; k < 2; ++k) \
        acc[ai][bj][m][n] = __builtin_amdgcn_mfma_f32_16x16x32_bf16(Bt[n][k], At[m][k], acc[ai][bj][m][n], 0, 0, 0); __builtin_amdgcn_s_setprio(0); } while (0)
#define PG8_WAIT_V(n) asm volatile("s_waitcnt vmcnt(" #n ")" ::: "memory")
#define PG8_WAIT_L(n) asm volatile("s_waitcnt lgkmcnt(" #n ")" ::: "memory")
#define PG8_BAR __builtin_amdgcn_s_barrier()
#define PG8_SCHED __builtin_amdgcn_sched_barrier(0)
    Unit cur, nxt; int ui = 0;
    if (!S.next(0, cur)) return;
#define PG8_UNI(u_) do { (u_).pm = __builtin_amdgcn_readfirstlane((u_).pm); (u_).pn = __builtin_amdgcn_readfirstlane((u_).pn); (u_).ks = __builtin_amdgcn_readfirstlane((u_).ks); } while (0)
    PG8_UNI(cur);
    f32x4 acc[2][2][4][2];
#pragma unroll
    for (int a = 0; a < 2; ++a)
#pragma unroll
        for (int b = 0; b < 2; ++b)
#pragma unroll
            for (int m = 0; m < 4; ++m)
#pragma unroll
                for (int n = 0; n < 2; ++n) acc[a][b][m][n] = (f32x4){0.f, 0.f, 0.f, 0.f};
    bf16x8 At[4][2], B0[2][2], B1[2][2];
    const char* cA = (const char*)g.A + (size_t)cur.pm * tstep + (size_t)cur.ks * K * 2; const char* cB = (const char*)g.Bt + (size_t)cur.pn * tstep + (size_t)cur.ks * K * 2;
    S.a_ready(cur);
    if constexpr (SP2) {
        PG8_STAGE(PG8_SB(0, 0), cB, voffB); PG8_STAGE(PG8_SB(0, 1), cB + hstep, voffB); PG8_STAGE(PG8_SA(0, 0), cA, voffA); PG8_STAGE(PG8_SA(0, 1), cA + hstep, voffA);
        pre();
        if (wr == 1) PG8_BAR;
        PG8_WAIT_V(2); PG8_BAR;
        PG8_STAGE(PG8_SB(1, 0), cB + kstep, voffB); PG8_STAGE(PG8_SA(1, 0), cA + kstep, voffA); PG8_STAGE(PG8_SB(1, 1), cB + hstep + kstep, voffB);
        PG8_WAIT_V(6); PG8_BAR;
    } else {
        PG8_STAGE(PG8_SB(0, 0), cB, voffB); PG8_STAGE(PG8_SA(0, 0), cA, voffA); PG8_STAGE(PG8_SB(0, 1), cB + hstep, voffB); PG8_STAGE(PG8_SA(0, 1), cA + hstep, voffA);
        if (wr == 1) PG8_BAR;
        PG8_WAIT_V(4); PG8_BAR;
        PG8_STAGE(PG8_SB(1, 0), cB + kstep, voffB); PG8_STAGE(PG8_SA(1, 0), cA + kstep, voffA); PG8_STAGE(PG8_SB(1, 1), cB + hstep + kstep, voffB);
        PG8_WAIT_V(6); PG8_BAR;
    }
    for (;;) {
        const bool has_next = S.next(ui + 1, nxt); PG8_UNI(nxt);
        const char* nA = has_next ? (const char*)g.A + (size_t)nxt.pm * tstep + (size_t)nxt.ks * K * 2 : cA; const char* nB = has_next ? (const char*)g.Bt + (size_t)nxt.pn * tstep + (size_t)nxt.ks * K * 2 : cB;
        for (int t = 0; t < nt; t += 2) {
            const bool last = (t == nt - 2);
            const char* a1 = cA + (size_t)(t + 1) * kstep;
            const char* a2 = last ? nA : cA + (size_t)(t + 2) * kstep; const char* b2 = last ? nB : cB + (size_t)(t + 2) * kstep;
            const char* a3 = a2 + kstep; const char* b3 = b2 + kstep;
            if (last && has_next) S.a_ready(nxt);
            if constexpr (SP2) {
            PG8_LDB(B0, 0, 0); PG8_LDB(B1, 0, 1); PG8_SCHED; PG8_LDA(At, 0, 0); PG8_STAGE(PG8_SA(1, 1), a1 + hstep, voffA);
            PG8_WAIT_V(8); PG8_WAIT_L(0); PG8_BAR; PG8_MMA(0, 0, At, B0); PG8_MMA(0, 1, At, B1); PG8_BAR; PG8_SCHED;
            PG8_LDA(At, 0, 1); PG8_STAGE(PG8_SB(0, 0), b2, voffB); PG8_STAGE(PG8_SB(0, 1), b2 + hstep, voffB); PG8_STAGE(PG8_SA(0, 0), a2, voffA);
            PG8_WAIT_V(8); PG8_WAIT_L(0); PG8_BAR; PG8_MMA(1, 0, At, B0); PG8_MMA(1, 1, At, B1); PG8_BAR; PG8_SCHED;
            PG8_LDB(B0, 1, 0); PG8_LDB(B1, 1, 1); PG8_SCHED; PG8_LDA(At, 1, 0); PG8_STAGE(PG8_SA(0, 1), a2 + hstep, voffA);
            PG8_WAIT_V(8); PG8_WAIT_L(0); PG8_BAR; PG8_MMA(0, 0, At, B0); PG8_MMA(0, 1, At, B1); PG8_BAR; PG8_SCHED;
            PG8_LDA(At, 1, 1); PG8_STAGE(PG8_SB(1, 0), b3, voffB); PG8_STAGE(PG8_SB(1, 1), b3 + hstep, voffB); PG8_STAGE(PG8_SA(1, 0), a3, voffA);
            PG8_WAIT_V(8); PG8_WAIT_L(0); PG8_BAR; PG8_MMA(1, 0, At, B0); PG8_MMA(1, 1, At, B1); PG8_BAR; PG8_SCHED;
            } else {
            PG8_LDB(B0, 0, 0); PG8_SCHED; PG8_LDA(At, 0, 0); PG8_STAGE(PG8_SA(1, 1), a1 + hstep, voffA);
            PG8_WAIT_L(8); PG8_BAR; PG8_WAIT_L(0); PG8_MMA(0, 0, At, B0); PG8_BAR; PG8_SCHED;
            PG8_LDB(B1, 0, 1); PG8_STAGE(PG8_SB(0, 0), b2, voffB);
            PG8_BAR; PG8_WAIT_L(0); PG8_MMA(0, 1, At, B1); PG8_BAR;
            PG8_LDA(At, 0, 1); PG8_STAGE(PG8_SA(0, 0), a2, voffA);
            PG8_BAR; PG8_WAIT_L(0); PG8_MMA(1, 0, At, B0); PG8_BAR; PG8_SCHED;
            PG8_STAGE(PG8_SB(0, 1), b2 + hstep, voffB);
            PG8_WAIT_V(6); PG8_BAR; PG8_MMA(1, 1, At, B1); PG8_BAR;
            PG8_LDB(B0, 1, 0); PG8_SCHED; PG8_LDA(At, 1, 0); PG8_STAGE(PG8_SA(0, 1), a2 + hstep, voffA);
            PG8_WAIT_L(8); PG8_BAR; PG8_WAIT_L(0); PG8_MMA(0, 0, At, B0); PG8_BAR; PG8_SCHED;
            PG8_LDB(B1, 1, 1); PG8_STAGE(PG8_SB(1, 0), b3, voffB);
            PG8_BAR; PG8_WAIT_L(0); PG8_MMA(0, 1, At, B1); PG8_BAR;
            PG8_LDA(At, 1, 1); PG8_STAGE(PG8_SA(1, 0), a3, voffA);
            PG8_BAR; PG8_WAIT_L(0); PG8_MMA(1, 0, At, B0); PG8_BAR; PG8_SCHED;
            PG8_STAGE(PG8_SB(1, 1), b3 + hstep, voffB);
            PG8_WAIT_V(6); PG8_BAR; PG8_MMA(1, 1, At, B1); PG8_BAR;
            }
        }
        if constexpr (ALIGN_EPI) { if (wr == 0) PG8_BAR; }
        if constexpr (!Epi::AFTER_DRAIN) { unsigned ln_e; asm volatile("v_mbcnt_lo_u32_b32 %0, -1, 0\n\tv_mbcnt_hi_u32_b32 %0, -1, %0" : "=v"(ln_e)); const int fr_e = (int)(ln_e & 15u), fq_e = (int)(ln_e >> 4);
            E(acc, cur, wr, wc, fr_e, fq_e);
#ifdef PG8_EPI_TWICE
            if constexpr (Epi::TWICE_OK) { asm volatile("" ::: "memory"); E(acc, cur, wr, wc, fr, fq); }
#endif
            S.done(cur); }
        if (!has_next) break;
        if constexpr (Epi::CARRY) {
            unsigned ln_c; asm volatile("v_mbcnt_lo_u32_b32 %0, -1, 0\n\tv_mbcnt_hi_u32_b32 %0, -1, %0" : "=v"(ln_c)); E.carry(acc, cur, wr, wc, (int)(ln_c & 15u), (int)(ln_c >> 4));
        } else {
#pragma unroll
        for (int a = 0; a < 2; ++a)
#pragma unroll
            for (int b = 0; b < 2; ++b)
#pragma unroll
                for (int m = 0; m < 4; ++m)
#pragma unroll
                    for (int n = 0; n < 2; ++n) acc[a][b][m][n] = (f32x4){0.f, 0.f, 0.f, 0.f};
        }
        cur = nxt; cA = nA; cB = nB; ++ui;
        if constexpr (ALIGN_EPI) { if (wr == 1) PG8_BAR; }
    }
    PG8_WAIT_V(0);
    if constexpr (!ALIGN_EPI) { if (wr == 0) PG8_BAR; }
    PG8_BAR;
    if constexpr (Epi::AFTER_DRAIN) { E.fused(acc, cur, wr, wc, fr, fq, lds, wid, lane); S.done(cur); }
#undef PG8_SA
#undef PG8_SB
#undef PG8_STAGE
#undef PG8_LDA
#undef PG8_LDB
#undef PG8_MMA
#undef PG8_WAIT_V
#undef PG8_WAIT_L
#undef PG8_BAR
#undef PG8_SCHED
}
}


constexpr int NWAVES = 8;
constexpr int DM = 1024, BATCH = 16, SEQ = 2048, MTOK = BATCH * SEQ, HB = 8, MH = HB * SEQ, DFF = 2816, NGU = 2 * DFF, NIN = 6144, DEPTH = 2, KUP = 1152  ;
constexpr int NFOX = 6, NSB = 5, NDSA = 5;
constexpr int C_QA = 0, C_KA = 384, C_VA = 768, C_QB = 1152, C_KB = 1472, C_VB = 1792, C_QC = 2112, C_CKV = 2432, C_QI = 2560, C_GATE = 3072;
constexpr int F_KI = 0, F_FA = 64, F_WI = 70;
constexpr float EPS = 1e-6f;

constexpr size_t MiB = 1u << 20;
constexpr size_t WS_CTL = 0, CTL_ZERO_BYTES = 1 * MiB;
constexpr size_t WS_WGU1 = 2 * MiB, WS_WD1 = 13 * MiB, WS_WIN = 19 * MiB, WS_WUP = 31 * MiB, WS_WOUT = 34 * MiB, WS_WGU2 = 36 * MiB, WS_WD2 = 47 * MiB;
constexpr size_t WS_XB = 54 * MiB;
constexpr size_t WS_SSQ = 118 * MiB;
constexpr size_t WS_P = 120 * MiB;
constexpr size_t WS_HFF = 120 * MiB;
constexpr size_t WS_PF = 312 * MiB;
constexpr size_t WS_Y = 328 * MiB;
constexpr size_t WS_KAI = 364 * MiB, WS_KBI = 376 * MiB;
constexpr size_t WS_MGB = 428 * MiB;
constexpr size_t WS_KC = 460 * MiB, WS_VC = 462 * MiB, WS_KI = 464 * MiB;
constexpr size_t WS_CF = 466 * MiB;
constexpr size_t WS_VTA = 468 * MiB, WS_VTB = 481 * MiB, WS_VTC = 492 * MiB;
constexpr size_t WS_END = 494 * MiB;
constexpr size_t WS_SINK = 960 * 1024;
constexpr int CW_BAR = 4096;
constexpr int MAX_LAUNCHES = 60;

constexpr int RING_OFF = 0, RING_BYTES = 131072;
constexpr int LDSCTL_OFF = RING_BYTES, MISC_OFF = LDSCTL_OFF + 320;
constexpr int VCT_OFF = 132096;
constexpr int RST_OFF = 132096;
constexpr int LDS_BYTES = 147456;

#define GAS __attribute__((address_space(1)))
#define LAS __attribute__((address_space(3)))
typedef unsigned short bf16;
typedef unsigned v4u __attribute__((ext_vector_type(4)));
typedef float f32x4 __attribute__((ext_vector_type(4)));
typedef short bf16x8 __attribute__((ext_vector_type(8)));
typedef GAS unsigned gu32;
typedef GAS unsigned long long gu64;
#define RLX_AGENT __ATOMIC_RELAXED, __HIP_MEMORY_SCOPE_AGENT
#define LDS_WAIT() asm volatile("s_waitcnt lgkmcnt(0)" ::: "memory")
#define VM_WAIT() asm volatile("s_waitcnt vmcnt(0)" ::: "memory")
__device__ __forceinline__ unsigned long long rt() { return __builtin_amdgcn_s_memrealtime(); }
__device__ __forceinline__ unsigned f2bf(float f) { unsigned u = __builtin_bit_cast(unsigned, f); return (u + 0x7fffu + ((u >> 16) & 1u)) >> 16; }
__device__ __forceinline__ unsigned pk2(float lo, float hi) { return f2bf(lo) | (f2bf(hi) << 16); }

#define XB_TMO      128
#define XB_XCNT(j)  (256  + 64 * (j))
#define XB_XSUB(j)  (1280 + 64 * (j))
#define XB_XGEN(j)  (2304 + 64 * (j))
#define XB_TOP      3328
#define XB_TOPGEN   3392
#define XCD_BAR_WORDS 3456
#define XB_SPIN_CAP (1u << 18)

__device__ __forceinline__ unsigned xb_ld(unsigned* p)              { return __hip_atomic_load(p, __ATOMIC_RELAXED, __HIP_MEMORY_SCOPE_AGENT); }
__device__ __forceinline__ unsigned xb_add(unsigned* p, unsigned v) { return __hip_atomic_fetch_add(p, v, __ATOMIC_RELAXED, __HIP_MEMORY_SCOPE_AGENT); }
__device__ __forceinline__ unsigned xb_xcc_id() { return (unsigned)__builtin_amdgcn_s_getreg((3 << 11) | 20) & 0xFu; }
#define XB_SPIN(cond, bar) do { unsigned _sp = 0; while (cond) { __builtin_amdgcn_s_sleep(1); \
    if ((++_sp & 255u) == 0u) { if (xb_ld(&(bar)[XB_TMO])) break; if (_sp > XB_SPIN_CAP) { atomicAdd(&(bar)[XB_TMO], 1u); break; } } } } while (0)

struct XcdBarrier {
    unsigned* bar; unsigned x;
    volatile LAS unsigned* st;
};

__device__ __forceinline__ XcdBarrier xcd_barrier_post(unsigned* bar, volatile LAS unsigned* st, bool leader_thread  ) {
    XcdBarrier b; b.bar = bar; b.x = xb_xcc_id(); b.st = st;
    if (leader_thread) (void)xb_add(&bar[XB_XCNT(b.x)], 1u);
    return b;
}
__device__ __forceinline__ void xcd_barrier_complete(unsigned* bar, unsigned x, unsigned& nloc, unsigned& nx) {
    const unsigned G = gridDim.x * gridDim.y * gridDim.z;
    unsigned sum, cnt, mine, sp = 0u;
    for (;;) {
        sum = 0u; cnt = 0u; mine = 0u;
#pragma unroll
        for (unsigned j = 0; j < 16; ++j) { const unsigned c = xb_ld(&bar[XB_XCNT(j)]); sum += c; cnt += (c > 0u) ? 1u : 0u; mine = (j == x) ? c : mine; }
        if (sum == G) break;
        __builtin_amdgcn_s_sleep(1);
        if ((++sp & 255u) == 0u) { if (xb_ld(&bar[XB_TMO])) break; if (sp > XB_SPIN_CAP) { atomicAdd(&bar[XB_TMO], 1u); break; } }
    }
    nloc = mine > 0u ? mine : 1u; nx = cnt > 0u ? cnt : 1u;
}

__device__ __forceinline__ void xcd_barrier(const XcdBarrier& b, bool leader_thread  ) {
    asm volatile("s_waitcnt vmcnt(0)" ::: "memory");
    __syncthreads();
    if (leader_thread) {
        unsigned* bar = b.bar; unsigned bx_ = b.x; asm volatile("" : "+s"(bar), "+s"(bx_));
        __builtin_amdgcn_s_waitcnt(0);
        unsigned nloc = b.st[0], nx = b.st[1];
        if (nloc == 0u) { xcd_barrier_complete(bar, bx_, nloc, nx); b.st[0] = nloc; b.st[1] = nx; }
        const unsigned old = xb_add(&bar[XB_XSUB(bx_)], 1u);
        const unsigned gen = old / nloc;
        if (old + 1u == (gen + 1u) * nloc) {
            __builtin_amdgcn_fence(__ATOMIC_RELEASE, "agent");
            asm volatile("s_waitcnt vmcnt(0)" ::: "memory");
            const unsigned og = xb_add(&bar[XB_TOP], 1u);
            const unsigned tg = og / nx;
            if (og + 1u == (tg + 1u) * nx) xb_add(&bar[XB_TOPGEN], 1u);
            else XB_SPIN(xb_ld(&bar[XB_TOPGEN]) == tg, bar);
            __builtin_amdgcn_fence(__ATOMIC_ACQUIRE, "agent");
            xb_add(&bar[XB_XGEN(bx_)], 1u);
            asm volatile("s_waitcnt vmcnt(0)" ::: "memory");
        } else {
            XB_SPIN(xb_ld(&bar[XB_XGEN(bx_)]) == gen, bar);
            __builtin_amdgcn_fence(__ATOMIC_ACQUIRE, "agent");
            asm volatile("s_waitcnt vmcnt(0)" ::: "memory");
        }
    }
    __syncthreads();
}


typedef unsigned u32x2 __attribute__((ext_vector_type(2)));
__device__ __forceinline__ float bflo(unsigned w) { return __uint_as_float(w << 16); }
__device__ __forceinline__ float bfhi(unsigned w) { return __uint_as_float(w & 0xffff0000u); }
__device__ __forceinline__ float bf2f(bf16 v) { return __uint_as_float((unsigned)v << 16); }
__device__ __forceinline__ float bperm_f(float v, int srclane) { return __int_as_float(__builtin_amdgcn_ds_bpermute(srclane << 2, __float_as_int(v))); }
__device__ __forceinline__ unsigned bperm_u(unsigned v, int srclane) { return (unsigned)__builtin_amdgcn_ds_bpermute(srclane << 2, (int)v); }
__device__ __forceinline__ float wave_sum(float v, int lane) {
#pragma unroll
    for (int o = 1; o < 64; o <<= 1) v += bperm_f(v, lane ^ o);
    return v;
}
__device__ __forceinline__ float xhalf_max(float v) { auto rr = __builtin_amdgcn_permlane32_swap(__float_as_uint(v), __float_as_uint(v), false, false); return fmaxf(__uint_as_float(rr[0]), __uint_as_float(rr[1])); }
__device__ __forceinline__ float xhalf_sum(float v) { auto rr = __builtin_amdgcn_permlane32_swap(__float_as_uint(v), __float_as_uint(v), false, false); return __uint_as_float(rr[0]) + __uint_as_float(rr[1]); }
__device__ __forceinline__ unsigned xhalf_sum_u(unsigned v) { auto rr = __builtin_amdgcn_permlane32_swap(v, v, false, false); return rr[0] + rr[1]; }
__device__ __forceinline__ float xhalf_other(float v, int hh) { auto rr = __builtin_amdgcn_permlane32_swap(__float_as_uint(v), __float_as_uint(v), false, false); return __uint_as_float(hh ? rr[0] : rr[1]); }
__device__ __forceinline__ v4u pack8_dpp(float v) {
    const float vn = __int_as_float(__builtin_amdgcn_update_dpp(0, __float_as_int(v), 0x101, 0xf, 0xf, true));
    const unsigned u = pk2(v, vn), u2 = (unsigned)__builtin_amdgcn_update_dpp(0, (int)u, 0x102, 0xf, 0xf, true);
    v4u w; w.x = u; w.y = u2; w.z = (unsigned)__builtin_amdgcn_update_dpp(0, (int)u, 0x104, 0xf, 0xf, true); w.w = (unsigned)__builtin_amdgcn_update_dpp(0, (int)u2, 0x104, 0xf, 0xf, true);
    return w;
}
__device__ __forceinline__ float wave_sum_dpp(float v) {
    int x = __float_as_int(v);
    v += __int_as_float(__builtin_amdgcn_update_dpp(0, x, 0xB1, 0xf, 0xf, true)); x = __float_as_int(v);
    v += __int_as_float(__builtin_amdgcn_update_dpp(0, x, 0x4E, 0xf, 0xf, true)); x = __float_as_int(v);
    v += __int_as_float(__builtin_amdgcn_update_dpp(0, x, 0x141, 0xf, 0xf, true)); x = __float_as_int(v);
    v += __int_as_float(__builtin_amdgcn_update_dpp(0, x, 0x140, 0xf, 0xf, true)); x = __float_as_int(v);
    v += __int_as_float(__builtin_amdgcn_update_dpp(0, x, 0x142, 0xa, 0xf, false)); x = __float_as_int(v);
    v += __int_as_float(__builtin_amdgcn_update_dpp(0, x, 0x143, 0xc, 0xf, false));
    return __int_as_float(__builtin_amdgcn_readlane(__float_as_int(v), 63));
}
__device__ __forceinline__ void rope_cs(int pos, int i, float& c, float& s) {
    const float cf = i == 0 ? 0.15915494309189535f : i == 1 ? 0.03086376340470123f : i == 2 ? 0.005985185712713705f : i == 3 ? 0.001160663641240061f
                   : i == 4 ? 0.00022507907903927653f : i == 5 ? 4.364795279280289e-05f : i == 6 ? 8.464330808241401e-06f : 1.6414262627950345e-06f;
    const float hi = __uint_as_float(__float_as_uint(cf) & 0xfffff000u), lo = cf - hi;
    const float p = (float)pos; const float a = p * hi; float r = a - floorf(a); r += p * lo;
    s = __builtin_amdgcn_sinf(r); c = __builtin_amdgcn_cosf(r);
}

template <int MODE> __device__ __forceinline__ int colmap(int n) {
    if (MODE == 0) return n;
    if (MODE == 1) { const int t = n >> 8, r = n & 255; return r < 128 ? t * 128 + r : DFF + t * 128 + (r - 128); }
    if (n < 1152) return n;
    if (n < 2880) return n + 6;
    if (n < 2886) return n - 2880 + 1152;
    if (n < 2890) return n;
    if (n < 3072) return -1;
    return n - 182;
}
template <int MODE> __device__ __forceinline__ float colscale(int n) {
    if (MODE != 2) return 1.0f;
    if (n < 384 || (n >= 2112 && n < 2432)) return 0.125f * 1.4426950408889634f;
    if (n >= 1152 && n < 1472) return 0.125f;
    return 1.0f;
}
template <int MODE> __device__ __forceinline__ void conv_job(const float* W, int Nsrc, int Ksrc, const float* gain, bf16* WT, int Ndst, int Kdst, LAS float* scr, int gw, int ngw, int lane, int& coff, int ldd = 0) {
    if (ldd == 0) ldd = Kdst;
    const int nblk = Ndst / 32, nitems = (Kdst / 64) * nblk;
    int it0 = gw - coff; if (it0 < 0) it0 += ngw;
    coff = (coff + nitems) % ngw;
    for (int it = it0; it < nitems; it += ngw) {
        const int kb = it / nblk, nb = it % nblk, k0 = 64 * kb, n0 = 32 * nb;
        const int sc = colmap<MODE>(n0 + (lane & 31));
        float wv_[32];
#pragma unroll
        for (int i = 0; i < 32; ++i) { const int k = k0 + 2 * i + (lane >> 5); wv_[i] = (sc >= 0 && k < Ksrc) ? W[(size_t)k * Nsrc + sc] : 0.f; }
        if (gain) {
#pragma unroll
            for (int i = 0; i < 32; ++i) { const int k = k0 + 2 * i + (lane >> 5); wv_[i] *= k < Ksrc ? gain[k] : 0.f; } }
        if (MODE == 2) { const float cs = colscale<MODE>(n0 + (lane & 31));
#pragma unroll
            for (int i = 0; i < 32; ++i) wv_[i] *= cs; }
#pragma unroll
        for (int i = 0; i < 32; ++i) scr[(2 * i + (lane >> 5)) * 33 + (lane & 31)] = wv_[i];
        LDS_WAIT(); asm volatile("" ::: "memory");
        const int c = lane & 7;
#pragma unroll
        for (int j = 0; j < 4; ++j) { const int n = (lane >> 3) + 8 * j; const LAS float* s = scr + (8 * c) * 33 + n;
            v4u o; o.x = pk2(s[0 * 33], s[1 * 33]); o.y = pk2(s[2 * 33], s[3 * 33]); o.z = pk2(s[4 * 33], s[5 * 33]); o.w = pk2(s[6 * 33], s[7 * 33]);
            *(GAS v4u*)(WT + (size_t)(n0 + n) * ldd + k0 + 8 * c) = o; }
        LDS_WAIT(); asm volatile("" ::: "memory");
    }
}


typedef short bf16x8 __attribute__((ext_vector_type(8)));
typedef float f32x16 __attribute__((ext_vector_type(16)));
typedef float f32x2_t __attribute__((ext_vector_type(2))); typedef __bf16 bf16x2_t __attribute__((ext_vector_type(2)));
__device__ __forceinline__ unsigned cvtpk(float lo, float hi) { f32x2_t v = {lo, hi}; bf16x2_t b = __builtin_convertvector(v, bf16x2_t); return __builtin_bit_cast(unsigned, b); }
#define MFMA32(a, b, c) __builtin_amdgcn_mfma_f32_32x32x16_bf16((a), (b), (c), 0, 0, 0)
__device__ __forceinline__ int crow(int i, int hh) { return (i & 3) + 8 * (i >> 2) + 4 * hh; }
__device__ __forceinline__ bf16x8 ldg16(const bf16* p) { return *(const GAS bf16x8*)p; }
__device__ __forceinline__ bf16x8 pack8(const f32x16& x, int s) {
    v4u p; p.x = cvtpk(x[8 * s + 0], x[8 * s + 1]); p.y = cvtpk(x[8 * s + 2], x[8 * s + 3]); p.z = cvtpk(x[8 * s + 4], x[8 * s + 5]); p.w = cvtpk(x[8 * s + 6], x[8 * s + 7]);
    return __builtin_bit_cast(bf16x8, p);
}
__device__ __forceinline__ void store_ot(bf16* yrow, const f32x16 (&o)[2], float scale, int hh) {
#pragma unroll
    for (int dt = 0; dt < 2; ++dt)
#pragma unroll
        for (int gp = 0; gp < 2; ++gp) {
            unsigned a0 = cvtpk(o[dt][8 * gp + 0] * scale, o[dt][8 * gp + 1] * scale), a1 = cvtpk(o[dt][8 * gp + 2] * scale, o[dt][8 * gp + 3] * scale);
            unsigned b0 = cvtpk(o[dt][8 * gp + 4] * scale, o[dt][8 * gp + 5] * scale), b1 = cvtpk(o[dt][8 * gp + 6] * scale, o[dt][8 * gp + 7] * scale);
            auto r0 = __builtin_amdgcn_permlane32_swap(a0, b0, false, false); auto r1 = __builtin_amdgcn_permlane32_swap(a1, b1, false, false);
            v4u w; w.x = r0[0]; w.y = r1[0]; w.z = r0[1]; w.w = r1[1];
            *(GAS v4u*)(yrow + 32 * dt + 16 * gp + 8 * hh) = w; }
}
constexpr float LOG2E = 1.4426950408889634f, LN2 = 0.6931471805599453f;

#define FOX_LOAD(KF, VF, kt_) do { _Pragma("unroll") for (int s_ = 0; s_ < 4; ++s_) KF[s_] = ldg16(kb + (size_t)2048 * (kt_) + 512 * s_); \
    _Pragma("unroll") for (int d_ = 0; d_ < 2; ++d_) _Pragma("unroll") for (int s_ = 0; s_ < 2; ++s_) VF[d_][s_] = ldg16(vb + (size_t)2048 * (kt_) + 512 * (2 * d_ + s_)); } while (0)
#define FOX_REF 24.0f
#define FOX_STEP(KF, VF, NKF, NVF, kt_) do { \
    { const int kn_ = (kt_) + 2 <= qs ? (kt_) + 2 : qs; FOX_LOAD(NKF, NVF, kn_); } \
    f32x4 cf_[4]; _Pragma("unroll") for (int g_ = 0; g_ < 4; ++g_) cf_[g_] = *(const LAS f32x4*)(cfL + 32 * (kt_) + 8 * g_ + 4 * hh); \
    f32x16 sacc; _Pragma("unroll") for (int i = 0; i < 16; ++i) sacc[i] = cf_[i >> 2][i & 3] - rt;        \
    _Pragma("unroll") for (int s_ = 0; s_ < 4; ++s_) sacc = MFMA32(KF[s_], qf[s_], sacc); \
    if ((kt_) == qs) { _Pragma("unroll") for (int i = 0; i < 16; ++i) { float p = __builtin_amdgcn_exp2f(sacc[i]); if (crow(i, hh) > r) p = 0.f; sacc[i] = p; l += p; } } \
    else { _Pragma("unroll") for (int i = 0; i < 16; ++i) { const float p = __builtin_amdgcn_exp2f(sacc[i]); sacc[i] = p; l += p; } } \
    const bf16x8 p0 = pack8(sacc, 0), p1 = pack8(sacc, 1); \
    _Pragma("unroll") for (int d_ = 0; d_ < 2; ++d_) { o[d_] = MFMA32(VF[d_][0], p0, o[d_]); o[d_] = MFMA32(VF[d_][1], p1, o[d_]); } } while (0)
__device__ __forceinline__ void fox_strip(const bf16* P, const bf16* KAI, const LAS float* cfL, const bf16* VTA, bf16* YA, int b, int h, int qs, int lane) {
    const int r = lane & 31, hh = lane >> 5;
    const size_t rowq = (size_t)b * SEQ + qs * 32 + r;
    bf16x8 qf[4];
#pragma unroll
    for (int s = 0; s < 4; ++s) qf[s] = ldg16(P + rowq * NIN + C_QA + h * 64 + 16 * s + 8 * hh);
    const float rt = cfL[qs * 32 + r] + FOX_REF;
    const bf16* kb = KAI + (size_t)(b * NFOX + h) * 64 * SEQ + 8 * lane;
    const bf16* vb = VTA + (size_t)(b * NFOX + h) * 64 * SEQ + 8 * lane;
    f32x16 o[2]; o[0] = f32x16{}; o[1] = f32x16{};
    float l = 0.f;
    bf16x8 kA[4], vA[2][2], kB[4], vB[2][2], kC[4], vC[2][2];
    FOX_LOAD(kA, vA, 0); { const int k1 = qs >= 1 ? 1 : 0; FOX_LOAD(kB, vB, k1); }
    for (int kt = 0; kt <= qs; kt += 3) {
        FOX_STEP(kA, vA, kC, vC, kt);
        if (kt + 1 > qs) break;
        FOX_STEP(kB, vB, kA, vA, kt + 1);
        if (kt + 2 > qs) break;
        FOX_STEP(kC, vC, kB, vB, kt + 2);
    }
    l = xhalf_sum(l);
    store_ot(YA + rowq * KUP + h * 64, o, 1.0f / l, hh);
}

__device__ __forceinline__ void sb_strip(const bf16* P, const bf16* KBI, const bf16* VTB, bf16* YB, int b, int h, int qs, int lane) {
    const int r = lane & 31, hh = lane >> 5;
    const size_t rowq = (size_t)b * SEQ + qs * 32 + r;
    bf16x8 qf[4];
#pragma unroll
    for (int s = 0; s < 4; ++s) qf[s] = ldg16(P + rowq * NIN + C_QB + h * 64 + 16 * s + 8 * hh);
    const bf16* kb = KBI + (size_t)(b * NSB + h) * 64 * SEQ + 8 * lane;
    const bf16* vb = VTB + (size_t)(b * NSB + h) * 64 * SEQ + 8 * lane;
    f32x16 o[2]; o[0] = f32x16{}; o[1] = f32x16{};
    float R = 0.f;
    bf16x8 kf[4], vf[2][2];
#pragma unroll
    for (int s = 0; s < 4; ++s) kf[s] = ldg16(kb + (size_t)2048 * qs + 512 * s);
#pragma unroll
    for (int dt = 0; dt < 2; ++dt)
#pragma unroll
        for (int s = 0; s < 2; ++s) vf[dt][s] = ldg16(vb + (size_t)2048 * qs + 512 * (2 * dt + s));
    asm volatile("" ::: "memory");
    for (int kt = qs; kt >= 0; --kt) {
        bf16x8 nk[4], nv[2][2];
        const int kn = kt > 0 ? kt - 1 : 0;
#pragma unroll
        for (int s = 0; s < 4; ++s) nk[s] = ldg16(kb + (size_t)2048 * kn + 512 * s);
#pragma unroll
        for (int dt = 0; dt < 2; ++dt)
#pragma unroll
            for (int s = 0; s < 2; ++s) nv[dt][s] = ldg16(vb + (size_t)2048 * kn + 512 * (2 * dt + s));
        asm volatile("" ::: "memory");
        f32x16 z = f32x16{};
#pragma unroll
        for (int s = 0; s < 4; ++s) z = MFMA32(kf[s], qf[s], z);
        f32x16 sp;
#pragma unroll
        for (int i = 0; i < 16; ++i) { const float zz = z[i]; const float e = __builtin_amdgcn_exp2f(-fabsf(zz) * LOG2E); float s_ = fmaxf(zz, 0.f) + LN2 * __builtin_amdgcn_logf(1.0f + e);
            const bool valid = (kt < qs) || (crow(i, hh) < r); sp[i] = valid ? s_ : 0.f; z[i] = valid ? zz - s_ : -INFINITY; }
        float tg[4], tp[4];
#pragma unroll
        for (int g = 0; g < 4; ++g) { tg[g] = (sp[4 * g] + sp[4 * g + 1]) + (sp[4 * g + 2] + sp[4 * g + 3]); tp[g] = xhalf_other(tg[g], hh); }
        float above = R;
#pragma unroll
        for (int g = 3; g >= 0; --g) {
            const float ab = above + (hh == 0 ? tp[g] : 0.f);
            const float w3 = ab, w2 = w3 + sp[4 * g + 3], w1 = w2 + sp[4 * g + 2], w0 = w1 + sp[4 * g + 1];
            z[4 * g + 3] = __builtin_amdgcn_exp2f((z[4 * g + 3] - w3) * LOG2E); z[4 * g + 2] = __builtin_amdgcn_exp2f((z[4 * g + 2] - w2) * LOG2E);
            z[4 * g + 1] = __builtin_amdgcn_exp2f((z[4 * g + 1] - w1) * LOG2E); z[4 * g + 0] = __builtin_amdgcn_exp2f((z[4 * g + 0] - w0) * LOG2E);
            above += tg[g] + tp[g];
        }
        R = above;
        const bf16x8 p0 = pack8(z, 0), p1 = pack8(z, 1);
#pragma unroll
        for (int dt = 0; dt < 2; ++dt) { o[dt] = MFMA32(vf[dt][0], p0, o[dt]); o[dt] = MFMA32(vf[dt][1], p1, o[dt]); }
        if (__all(R > 104.0f)) break;
#pragma unroll
        for (int s = 0; s < 4; ++s) kf[s] = nk[s];
#pragma unroll
        for (int dt = 0; dt < 2; ++dt)
#pragma unroll
            for (int s = 0; s < 2; ++s) vf[dt][s] = nv[dt][s];
    }
    store_ot(YB + rowq * KUP + h * 64, o, 1.0f, hh);
}

template <int NH> __device__ __forceinline__ void dsa_attend(f32x16 (&o)[NH][2], float (&m)[NH], float (&l)[NH], const bf16* kcb, const bf16* vtb, const LAS unsigned char* qcl, int hbase,
                                                              const unsigned (&selm)[4], int ntiles, int wave) {
    const float SC = 0.125f * LOG2E;
#pragma unroll
    for (int h = 0; h < NH; ++h) { o[h][0] = f32x16{}; o[h][1] = f32x16{}; m[h] = 0.f; l[h] = 0.f; }
#define DSA_LOADKV(KF, VF, j_) do { _Pragma("unroll") for (int s_ = 0; s_ < 4; ++s_) KF[s_] = ldg16(kcb + (size_t)2048 * (j_) + 512 * s_); \
    _Pragma("unroll") for (int d_ = 0; d_ < 2; ++d_) _Pragma("unroll") for (int s_ = 0; s_ < 2; ++s_) VF[d_][s_] = ldg16(vtb + (size_t)2048 * (j_) + 512 * (2 * d_ + s_)); } while (0)
    bf16x8 kc[4], vt[2][2];
    if (wave < ntiles) DSA_LOADKV(kc, vt, wave);
    asm volatile("" ::: "memory");
    __builtin_amdgcn_s_waitcnt(0x0F70);
#pragma unroll 1
    for (int sl = 0; sl < 8; ++sl) {
        const int j = sl * 8 + wave;
        if (j < ntiles) {
            const int jn = j + 8 < ntiles ? j + 8 : j;
            const unsigned sw = sl < 2 ? selm[0] : sl < 4 ? selm[1] : sl < 6 ? selm[2] : selm[3];
            const unsigned bits = sw >> ((sl & 1) * 16);
            f32x16 minit;
#pragma unroll
            for (int i = 0; i < 16; ++i) minit[i] = ((bits >> i) & 1u) ? -FOX_REF : -INFINITY;
            f32x16 sa[NH];
#pragma unroll
            for (int h = 0; h < NH; ++h) { sa[h] = minit;
#pragma unroll
                for (int s = 0; s < 4; ++s) sa[h] = MFMA32(kc[s], *(const LAS bf16x8*)(qcl + ((hbase + h) * 64 + 16 * s) * 2), sa[h]); }
            asm volatile("" ::: "memory");
#pragma unroll
            for (int s_ = 0; s_ < 4; ++s_) kc[s_] = ldg16(kcb + (size_t)2048 * jn + 512 * s_);
            asm volatile("" ::: "memory");
#pragma unroll
            for (int i = 0; i < 16; ++i)
#pragma unroll
                for (int h = 0; h < NH; ++h) { const float p = __builtin_amdgcn_exp2f(sa[h][i]); sa[h][i] = p; l[h] += p; }
#pragma unroll
            for (int h = 0; h < NH; ++h) { const bf16x8 p0 = pack8(sa[h], 0), p1 = pack8(sa[h], 1);
#pragma unroll
                for (int dt = 0; dt < 2; ++dt) { o[h][dt] = MFMA32(vt[dt][0], p0, o[h][dt]); o[h][dt] = MFMA32(vt[dt][1], p1, o[h][dt]); } }
            asm volatile("" ::: "memory");
#pragma unroll
            for (int d_ = 0; d_ < 2; ++d_)
#pragma unroll
                for (int s_ = 0; s_ < 2; ++s_) vt[d_][s_] = ldg16(vtb + (size_t)2048 * jn + 512 * (2 * d_ + s_));
            asm volatile("" ::: "memory");
        }
    }
#undef DSA_LOADKV
#pragma unroll
    for (int h = 0; h < NH; ++h) l[h] = xhalf_sum(l[h]);
}
__device__ __forceinline__ void dsa_combine(const f32x16 (&o)[2], float m, float l, LAS float* Ml, LAS float* Ob, bf16* yq, int h5, int wave, int lane) {
    const int r = lane & 31, hh = lane >> 5;
    if (lane < 32) { Ml[(wave * 2 + 0) * 32 + r] = m; Ml[(wave * 2 + 1) * 32 + r] = l; }
#pragma unroll
    for (int dt = 0; dt < 2; ++dt)
#pragma unroll
        for (int i = 0; i < 16; ++i) Ob[(wave * 64 + 32 * dt + crow(i, hh)) * 32 + r] = o[dt][i];
    __syncthreads();
    {
        float ls = 0.f, acc4[4] = {0.f, 0.f, 0.f, 0.f};
#pragma unroll
        for (int w = 0; w < 8; ++w) { ls += Ml[(w * 2 + 1) * 32 + r];
#pragma unroll
            for (int e = 0; e < 4; ++e) acc4[e] += Ob[(w * 64 + 8 * wave + 4 * hh + e) * 32 + r]; }
        const float il = 1.0f / ls;
        u32x2 wv; wv.x = cvtpk(acc4[0] * il, acc4[1] * il); wv.y = cvtpk(acc4[2] * il, acc4[3] * il);
        *(GAS u32x2*)(yq + h5 * 64 + 8 * wave + 4 * hh) = wv;
    }
    __syncthreads();
}
__device__ __forceinline__ unsigned wg_sum32(unsigned c, LAS unsigned* cnt, int& seq, int wave, int r, int lane) {
    c = xhalf_sum_u(c);
    const int buf = seq & 1; ++seq;
    if (lane < 32) cnt[(buf * 8 + wave) * 32 + r] = c;
    __syncthreads();
    unsigned t = 0;
#pragma unroll
    for (int w = 0; w < 8; ++w) t += cnt[(buf * 8 + w) * 32 + r];
    return t;
}
__device__ __forceinline__ void dsa_unit(const bf16* P, const float* Pf, const bf16* KI, const bf16* KC, const bf16* VTC, bf16* YC, int b, int g, int wave, int lane, LAS unsigned char* lds) {
    asm volatile("" : "+v"(lane), "+s"(wave));
    const int r = lane & 31, hh = lane >> 5;
    const int N = 64 * (g / 2 + 1), ntiles = N / 32;
    const size_t rowq = (size_t)b * SEQ + 32 * g + r;
    LAS unsigned* cnt = (LAS unsigned*)lds; LAS float* Ml = (LAS float*)(lds + 2048); LAS float* Ob = (LAS float*)(lds + 4096);
    LAS unsigned char* QiL = lds + 69632;
    LAS unsigned char* QcL = lds + 86528;
    int seq = 0;
    {
        const int t = wave * 64 + lane;
        v4u qs_[5];
#pragma unroll
        for (int i = 0; i < 2; ++i) { const int c = t + 512 * i, row = c >> 5, ch = c & 31; qs_[i] = *(const GAS v4u*)(P + ((size_t)b * SEQ + 32 * g + row) * NIN + C_QI + 8 * ch); }
#pragma unroll
        for (int i = 0; i < 3; ++i) { const int c = t + 512 * i < 32 * 40 ? t + 512 * i : 0; const int row = c / 40, ch = c % 40; qs_[2 + i] = *(const GAS v4u*)(P + ((size_t)b * SEQ + 32 * g + row) * NIN + C_QC + 8 * ch); }
#pragma unroll
        for (int i = 0; i < 2; ++i) { const int c = t + 512 * i, row = c >> 5, ch = c & 31; *(LAS v4u*)(QiL + row * 528 + ch * 16) = qs_[i]; }
#pragma unroll
        for (int i = 0; i < 3; ++i) { const int c = t + 512 * i; if (c < 32 * 40) { const int row = c / 40, ch = c % 40; *(LAS v4u*)(QcL + row * 656 + ch * 16) = qs_[2 + i]; } }
    }
    const float w0 = Pf[rowq * 256 + F_WI + 0], w1 = Pf[rowq * 256 + F_WI + 1], w2 = Pf[rowq * 256 + F_WI + 2], w3 = Pf[rowq * 256 + F_WI + 3];
    __syncthreads();
    unsigned key[8][16];
    const bf16* kib = KI + (size_t)b * SEQ * 64 + 8 * lane;
    bf16x8 kf[4];
    if (wave < ntiles) {
#pragma unroll
        for (int s = 0; s < 4; ++s) kf[s] = ldg16(kib + (size_t)2048 * wave + 512 * s); }
    asm volatile("" ::: "memory");
    __builtin_amdgcn_s_waitcnt(0x0F70);
#pragma unroll
    for (int sl = 0; sl < 8; ++sl) {
        const int j = sl * 8 + wave;
        if (j < ntiles) {
            bf16x8 kn[4];
            { const int jn = j + 8 < ntiles ? j + 8 : j;
#pragma unroll
              for (int s = 0; s < 4; ++s) kn[s] = ldg16(kib + (size_t)2048 * jn + 512 * s); }
            asm volatile("" ::: "memory");
            float sc[16];
#pragma unroll
            for (int hp = 0; hp < 2; ++hp) {
                f32x16 accA = f32x16{}, accB = f32x16{};
#pragma unroll
                for (int s = 0; s < 4; ++s) { accA = MFMA32(kf[s], *(const LAS bf16x8*)(QiL + r * 528 + ((2 * hp) * 64 + 16 * s + 8 * hh) * 2), accA);
                                              accB = MFMA32(kf[s], *(const LAS bf16x8*)(QiL + r * 528 + ((2 * hp + 1) * 64 + 16 * s + 8 * hh) * 2), accB); }
                const float wA = hp == 0 ? w0 : w2, wB = hp == 0 ? w1 : w3;
#pragma unroll
                for (int i = 0; i < 16; ++i) { const float t = hp == 0 ? wA * fmaxf(accA[i], 0.f) : fmaf(wA, fmaxf(accA[i], 0.f), sc[i]); sc[i] = fmaf(wB, fmaxf(accB[i], 0.f), t); }
            }
#pragma unroll
            for (int i = 0; i < 16; ++i) { const unsigned ub = __float_as_uint(sc[i] + 0.0f); key[sl][i] = (ub & 0x80000000u) ? ~ub : (ub | 0x80000000u); }
#pragma unroll
            for (int s = 0; s < 4; ++s) kf[s] = kn[s];
        } else {
#pragma unroll
            for (int i = 0; i < 16; ++i) key[sl][i] = 0u;
        }
    }
#ifndef DSA_REP_ATT
#define DSA_REP_ATT 1
#endif
    unsigned T = 0u; bool tie = false;
    if (N > 256) {
        LAS unsigned* hist = (LAS unsigned*)(lds + 4096);
        LAS unsigned* res = (LAS unsigned*)lds;
        const int tw = wave * 64 + lane;
        if (tw < 32) res[32 + tw] = 256u;
        bool done = false; unsigned need = 256u, ceq = 0u;
#pragma unroll 1
        for (int sh = 24; sh >= 0; sh -= 8) {
            for (int i = tw; i < 32 * 257; i += 512) hist[i] = 0u;
            __syncthreads();
            if (!done) {
                LAS unsigned* hq = hist + r * 257;
#pragma unroll
                for (int sl = 0; sl < 8; ++sl) if (sl * 8 + wave < ntiles) {
#pragma unroll
                    for (int i = 0; i < 16; ++i) { const unsigned k = key[sl][i];
                        if (sh == 24 || (k >> ((sh + 8) & 31)) == (T >> ((sh + 8) & 31))) { __hip_atomic_fetch_add(hq + ((k >> sh) & 255u), 1u, __ATOMIC_RELAXED, __HIP_MEMORY_SCOPE_WORKGROUP);
#ifdef PROBE_AT2
                            __hip_atomic_fetch_add(hq + 9216 + ((k >> sh) & 255u), 1u, __ATOMIC_RELAXED, __HIP_MEMORY_SCOPE_WORKGROUP);
#endif
                        } } }
            }
            __syncthreads();
#pragma unroll
            for (int qi = 0; qi < 4; ++qi) {
                const int q = 4 * wave + qi; const LAS unsigned* hq = hist + q * 257 + 4 * lane;
                const unsigned h0 = hq[0], h1 = hq[1], h2 = hq[2], h3 = hq[3], sl_ = (h0 + h1) + (h2 + h3);
                unsigned v = sl_;
#pragma unroll
                for (int o = 1; o < 64; o <<= 1) { const unsigned n = bperm_u(v, lane + o); if (lane + o < 64) v += n; }
                const unsigned E = v - sl_, nd = res[32 + q];
                if (E < nd && nd <= E + sl_) {
                    unsigned cum = E, dg, hb;
                    if (cum + h3 >= nd) { dg = 3; hb = h3; } else { cum += h3; if (cum + h2 >= nd) { dg = 2; hb = h2; } else { cum += h2; if (cum + h1 >= nd) { dg = 1; hb = h1; } else { cum += h1; dg = 0; hb = h0; } } }
                    res[q] = (4u * lane + dg) | ((cum + hb == nd) ? 256u : 0u); res[32 + q] = nd - cum; res[64 + q] = hb;
                }
            }
            __syncthreads();
            if (!done) { const unsigned rr = res[r]; T |= (rr & 255u) << sh; need = res[32 + r]; ceq = res[64 + r]; done = (rr & 256u) != 0u; }
            if (!__any(!done)) break;
        }
        tie = !done && ceq > need;
    }
    unsigned selm[4], tm[4];
#pragma unroll
    for (int q = 0; q < 4; ++q) { selm[q] = 0u; tm[q] = 0u; }
#pragma unroll
    for (int sl = 0; sl < 8; ++sl)
#pragma unroll
        for (int i = 0; i < 16; ++i) { selm[sl >> 1] |= (key[sl][i] > T ? 1u : 0u) << ((sl & 1) * 16 + i); tm[sl >> 1] |= (key[sl][i] == T ? 1u : 0u) << ((sl & 1) * 16 + i); }
    int J = 4095;
    if (N > 256 && __any(tie)) {
        LAS unsigned* res = (LAS unsigned*)lds;
        LAS unsigned* cntL = (LAS unsigned*)(lds + 4096);
#pragma unroll
        for (int sl = 0; sl < 8; ++sl) { const unsigned c = xhalf_sum_u((unsigned)__builtin_popcount((tm[sl >> 1] >> ((sl & 1) * 16)) & 0xffffu)); if (hh == 0) cntL[r * 64 + sl * 8 + wave] = c; }
        __syncthreads();
#pragma unroll
        for (int qi = 0; qi < 4; ++qi) {
            const int q = 4 * wave + qi; const unsigned c = cntL[q * 64 + lane]; unsigned v = c;
#pragma unroll
            for (int o = 1; o < 64; o <<= 1) { const unsigned n = bperm_u(v, lane - o); if (lane >= o) v += n; }
            const unsigned nd = res[32 + q], ex = v - c;
            if (ex < nd && nd <= v) res[96 + q] = (unsigned)lane | ((nd - ex) << 8);
        }
        __syncthreads();
        const unsigned rj = res[96 + r]; const int Jt = (int)(rj & 255u), nn = (int)(rj >> 8);
        { const int st = Jt >> 3; const unsigned wsel = st < 2 ? tm[0] : st < 4 ? tm[1] : st < 6 ? tm[2] : tm[3]; const unsigned m16 = (wsel >> ((st & 1) * 16)) & 0xffffu;
          const unsigned mo = xhalf_sum_u(m16) - m16;
          const unsigned m0 = hh ? mo : m16, m1 = hh ? m16 : mo;
          unsigned rm = 0u;
#pragma unroll
          for (int g4 = 0; g4 < 4; ++g4) rm |= (((m0 >> (4 * g4)) & 15u) << (8 * g4)) | (((m1 >> (4 * g4)) & 15u) << (8 * g4 + 4));
          int p = 0;
#pragma unroll
          for (int bs = 16; bs >= 1; bs >>= 1) { if (__builtin_popcount(rm & ((1u << (p + bs)) - 1u)) < nn) p += bs; }
          if (tie && wave == (Jt & 7) && hh == 0) res[128 + r] = (unsigned)(32 * Jt + p); }
        __syncthreads();
        if (tie) J = (int)res[128 + r];
    }
    {
        const int Jt = J >> 5, Jr = J & 31; unsigned rm16 = 0u;
#pragma unroll
        for (int g4 = 0; g4 < 4; ++g4) { int n = Jr - 8 * g4 - 4 * hh + 1; n = n < 0 ? 0 : n > 4 ? 4 : n; rm16 |= ((1u << n) - 1u) << (4 * g4); }
#pragma unroll
        for (int sl = 0; sl < 8; ++sl) { const int j = sl * 8 + wave; const unsigned lm = j < Jt ? 0xffffu : j > Jt ? 0u : rm16; selm[sl >> 1] |= tm[sl >> 1] & (lm << ((sl & 1) * 16)); }
    }
    const bf16* kcb = KC + (size_t)b * SEQ * 64 + 8 * lane;
    const bf16* vtb = VTC + (size_t)b * 64 * SEQ + 8 * lane;
    const LAS unsigned char* qcl = QcL + r * 656 + 16 * hh;
    bf16* yq = YC + rowq * KUP;
    { f32x16 o[3][2]; float m[3], l[3]; dsa_attend<3>(o, m, l, kcb, vtb, qcl, 0, selm, ntiles, wave);
      dsa_combine(o[0], m[0], l[0], Ml, Ob, yq, 0, wave, lane); dsa_combine(o[1], m[1], l[1], Ml, Ob, yq, 1, wave, lane); dsa_combine(o[2], m[2], l[2], Ml, Ob, yq, 2, wave, lane); }
    { f32x16 o[2][2]; float m[2], l[2]; dsa_attend<2>(o, m, l, kcb, vtb, qcl, 3, selm, ntiles, wave);
      dsa_combine(o[0], m[0], l[0], Ml, Ob, yq, 3, wave, lane); dsa_combine(o[1], m[1], l[1], Ml, Ob, yq, 4, wave, lane); }
}


struct Args { const float* in[18]; float* out; unsigned char* ws; int ph_lo, ph_hi, li, pad; };

static_assert(pg8::EpiWin::KA0 == C_KA && pg8::EpiWin::KB0 == C_KB && pg8::EpiWin::NHA == NFOX && pg8::EpiWin::NHB == NSB && pg8::EpiWin::SEQL == SEQ && pg8::EpiWin::KAI_OFF == (long)(WS_KAI - WS_P) && pg8::EpiWin::KBI_OFF == (long)(WS_KBI - WS_P), "EpiWin's copy of the layout constants");
__global__ void __launch_bounds__(NWAVES * 64, 2) mk_fwd(Args args) {
    extern __shared__ __attribute__((aligned(16))) unsigned char lds_raw[];
    LAS unsigned char* lds = (LAS unsigned char*)lds_raw;
    volatile LAS unsigned* MISC = (volatile LAS unsigned*)(lds + MISC_OFF);
    const int tid = threadIdx.x, lane0 = tid & 63, wave0 = __builtin_amdgcn_readfirstlane(tid >> 6);
    const int G0 = gridDim.x; const int bx0 = blockIdx.x; const int vcu = (G0 % 8 == 0) ? (bx0 % 8) * (G0 / 8) + bx0 / 8 : bx0;
    const int gw0 = vcu * NWAVES + wave0;
    unsigned char* ws0 = args.ws;
    gu32* ctl = (gu32*)(ws0 + WS_CTL);
    for (int u = tid; u < (LDS_BYTES - LDSCTL_OFF) / 4; u += NWAVES * 64) ((LAS unsigned*)(lds + LDSCTL_OFF))[u] = 0u;
    __syncthreads();
    XcdBarrier bar = xcd_barrier_post((unsigned*)(ctl + CW_BAR) + args.li * XCD_BAR_WORDS, MISC + 8, tid == 0);
    typedef const Args __attribute__((address_space(4)))* kargs_t;
    const kargs_t ka0 = (kargs_t)__builtin_amdgcn_kernarg_segment_ptr();
    const int lo = args.ph_lo, hi = args.ph_hi;
    int layer = 0, f = 0, hf = 0;
#define TX_NOW() ({ unsigned t_; asm volatile("v_mbcnt_lo_u32_b32 %0, -1, 0\n\tv_mbcnt_hi_u32_b32 %0, -1, %0" : "=v"(t_)); t_ | ((unsigned)wave0 << 6); })
    int ph = 0;
#define PH_BEGIN if (ph >= lo && ph < hi) { unsigned char* ws = ws0; kargs_t ka = ka0; unsigned tx_; asm volatile("v_mbcnt_lo_u32_b32 %0, -1, 0\n\tv_mbcnt_hi_u32_b32 %0, -1, %0" : "=v"(tx_)); tx_ |= (unsigned)wave0 << 6; int gw = gw0, G = G0, bx = bx0, Lr = layer; asm volatile("" : "+s"(ws), "+s"(ka), "+v"(tx_), "+s"(gw), "+s"(G), "+s"(bx), "+s"(Lr)); const int lane = (int)(tx_ & 63u), wave = __builtin_amdgcn_readfirstlane((int)(tx_ >> 6)); float* xf = ka->out; unsigned char* wbase = Lr ? (unsigned char*)xf : ws; const int NGW = G * NWAVES;
#define PH_END   if (ph + 1 < hi) xcd_barrier(bar, TX_NOW() == 0u); } ++ph;

#define WGU1 ((bf16*)(wbase + WS_WGU1))
#define WD1 ((bf16*)(wbase + WS_WD1))
#define WIN ((bf16*)(wbase + WS_WIN))
#define WUP ((bf16*)(wbase + WS_WUP))
#define WOUT ((bf16*)(wbase + WS_WOUT))
#define WGU2 ((bf16*)(wbase + WS_WGU2))
#define WD2 ((bf16*)(wbase + WS_WD2))
#define XB ((bf16*)(ws + WS_XB))
#define SSQ ((float*)(ws + WS_SSQ))
#define P ((bf16*)(ws + WS_P))
#define HFF ((bf16*)(ws + WS_HFF))
#define PF ((float*)(ws + WS_PF))
#define YA ((bf16*)(ws + WS_Y))
#define YB ((bf16*)(ws + WS_Y) + 384)
#define YC ((bf16*)(ws + WS_Y) + 768)
#define MGB ((bf16*)(ws + WS_MGB))
#define KAI ((bf16*)(ws + WS_KAI))
#define KBI ((bf16*)(ws + WS_KBI))
#define KC ((bf16*)(ws + WS_KC))
#define KI ((bf16*)(ws + WS_KI))
#define CF ((float*)(ws + WS_CF))
#define VTA ((bf16*)(ws + WS_VTA))
#define VTB ((bf16*)(ws + WS_VTB))
#define VTC ((bf16*)(ws + WS_VTC))
#define XF (xf)
#define scr ((LAS float*)(lds + RING_OFF + wave * 16384))
#define CONV_FFN(l, which) do { unsigned char* wbase = (l) ? (unsigned char*)xf : ws; const float* gg = ka->in[(which) ? 14 : 1] + (size_t)(l) * DM; const float* wgu = ka->in[(which) ? 15 : 2] + (size_t)(l) * DM * NGU; const float* wd = ka->in[(which) ? 16 : 3] + (size_t)(l) * DFF * DM; \
        conv_job<1>(wgu, NGU, DM, gg, (which) ? WGU2 : WGU1, NGU, DM, scr, gw, NGW, lane, coff); conv_job<0>(wd, DM, DFF, nullptr, (which) ? WD2 : WD1, DM, DFF, scr, gw, NGW, lane, coff); } while (0)
#define CONV_MIX(l) do { unsigned char* wbase = (l) ? (unsigned char*)xf : ws; conv_job<2>(ka->in[5] + (size_t)(l) * DM * 5962, 5962, DM, ka->in[4] + (size_t)(l) * DM, WIN, NIN, DM, scr, gw, NGW, lane, coff); \
        conv_job<0>(ka->in[10] + (size_t)(l) * 384 * DM, DM, 384, nullptr, WUP, DM, 384, scr, gw, NGW, lane, coff, KUP); \
        conv_job<0>(ka->in[11] + (size_t)(l) * 320 * DM, DM, 320, nullptr, WUP + 384, DM, 384, scr, gw, NGW, lane, coff, KUP); \
        conv_job<0>(ka->in[12] + (size_t)(l) * 320 * DM, DM, 320, nullptr, WUP + 768, DM, 384, scr, gw, NGW, lane, coff, KUP); \
        conv_job<0>(ka->in[13] + (size_t)(l) * DM * DM, DM, DM, nullptr, WOUT, DM, DM, scr, gw, NGW, lane, coff); } while (0)

    PH_BEGIN
        int coff = 0;
        CONV_FFN(0, 0); CONV_MIX(0); CONV_FFN(0, 1); CONV_FFN(1, 0); CONV_MIX(1); CONV_FFN(1, 1);
        const float* x = ka->in[0];
        for (int m0 = gw * 4; m0 < MTOK; m0 += NGW * 4) {
            f32x4 v[4][4]; float s[4];
#pragma unroll
            for (int q = 0; q < 4; ++q) { const GAS f32x4* xr = (const GAS f32x4*)(x + (size_t)(m0 + q) * DM) + lane;
#pragma unroll
                for (int j = 0; j < 4; ++j) v[q][j] = xr[64 * j]; }
#pragma unroll
            for (int q = 0; q < 4; ++q) { GAS u32x2* o8 = (GAS u32x2*)(XB + (size_t)(m0 + q) * DM) + lane; s[q] = 0.f;
#pragma unroll
                for (int j = 0; j < 4; ++j) { const f32x4 t = v[q][j]; s[q] += (t[0] * t[0] + t[1] * t[1]) + (t[2] * t[2] + t[3] * t[3]); u32x2 w; w.x = pk2(t[0], t[1]); w.y = pk2(t[2], t[3]); o8[64 * j] = w; } }
#pragma unroll
            for (int q = 0; q < 4; ++q) { const float sm = wave_sum(s[q], lane); if (lane < 16) SSQ[(size_t)(m0 + q) * 16 + lane] = lane == 0 ? sm : 0.f; }
        }
    PH_END

#pragma unroll 1
    for (layer = 0; layer < DEPTH; ++layer) {
#pragma unroll 1
        for (f = 0; f < 2; ++f) {
            PH_BEGIN
                pg8::Gemm g{XB, f ? WGU2 : WGU1, MTOK, NGU, DM, 0}; pg8::StaticOrder S; S.init(MTOK, NGU, G, bx);
                LAS float* rsT = (LAS float*)(lds + RST_OFF);
                pg8::EpiSwiglu E{rsT, HFF, DFF};
                { const float* ssq_ = SSQ; auto pre = [&]() { pg8::rs_table_fill(rsT, ssq_, S, (int)TX_NOW()); };
                  pg8::gemm_phase<pg8::EpiSwiglu, pg8::StaticOrder, true, true>(lds + RING_OFF, g, S, E, (int)TX_NOW(), pre); }
            PH_END
            PH_BEGIN
                pg8::Gemm g{HFF, f ? WD2 : WD1, MTOK, DM, DFF, 0}; pg8::StaticOrder S; S.init(MTOK, DM, G, bx);
                pg8::EpiResid E{XB, SSQ, 0.5f};
                pg8::gemm_phase<pg8::EpiResid, pg8::StaticOrder, true, true>(lds + RING_OFF, g, S, E, (int)TX_NOW());
            PH_END
            if (f == 1) break;
            { const size_t rb = 0;
                PH_BEGIN
                    pg8::Gemm g{XB + rb * DM, WIN, MH, NIN, DM, 0}; pg8::StaticOrder S; S.init(MH, NIN, G, bx);
                    LAS float* rsT = (LAS float*)(lds + RST_OFF);
                    pg8::EpiWin E{rsT, P, PF, NIN};
                    { const float* ssq_ = SSQ + rb * 16; auto pre = [&]() { pg8::rs_table_fill(rsT, ssq_, S, (int)TX_NOW()); };
                      pg8::gemm_phase<pg8::EpiWin, pg8::StaticOrder, true, true>(lds + RING_OFF, g, S, E, (int)TX_NOW(), pre); }
                PH_END
            }
#pragma unroll 1
            for (hf = 0; hf < 2; ++hf) {
                const size_t rb = (size_t)hf * MH;
                PH_BEGIN
                    const float* gkv = ka->in[7] + Lr * 128; const float* wkv = ka->in[8] + (size_t)Lr * 128 * 128; const float* gik = ka->in[9] + Lr * 64; const float* bfor = ka->in[6] + Lr * NFOX;
                    LAS bf16* Tt = (LAS bf16*)(lds + wave * 12288);
                    LAS bf16* VCt = (LAS bf16*)(lds + VCT_OFF);
                    LAS unsigned* Wl = (LAS unsigned*)(lds + 98304);
                    { f32x2_t wv_[16];
#pragma unroll
                      for (int i = 0; i < 16; ++i) wv_[i] = *(const GAS f32x2_t*)(wkv + 2 * ((int)tx_ + 512 * i));
#pragma unroll
                      for (int i = 0; i < 16; ++i) Wl[(int)tx_ + 512 * i] = pk2(wv_[i][0], wv_[i][1]); }
                    __syncthreads();
                    for (int blk = bx; blk < MH / 64; blk += G) {
                        const GAS bf16* prow = (const GAS bf16*)P + (size_t)(blk * 64 + (lane >> 3)) * NIN + 8 * (lane & 7);
                        v4u wa[8];
                        { const GAS bf16* pa = prow + (wave < 6 ? C_VA + wave * 64 : C_VB + (wave - 6) * 64);
#pragma unroll
                          for (int i = 0; i < 8; ++i) wa[i] = *(const GAS v4u*)(pa + (size_t)(8 * i) * NIN); }
                        float pc0[8], pc1[8], pki[8], qc1[8], qc2[8], qi1[8], qi2[8], pfa[8];
                        {   bf16 r0[8], r1[8], r2[8], r3[8], r4[8], r5[8];
#pragma unroll
                            for (int j = 0; j < 8; ++j) { const int r = blk * 64 + wave * 8 + j; const int hq = lane >> 3, i8q = lane & 7;
                                const GAS bf16* pr = (const GAS bf16*)P + (size_t)r * NIN; const GAS float* pf = (const GAS float*)PF + (size_t)r * 256;
                                r0[j] = pr[C_CKV + lane]; r1[j] = pr[C_CKV + 64 + lane]; pki[j] = pf[F_KI + lane];
                                const GAS bf16* pq = pr + C_QC + (hq < 5 ? hq : 0) * 64; r2[j] = pq[i8q]; r3[j] = pq[i8q + 8];
                                const GAS bf16* pi = pr + C_QI + (hq < 4 ? hq : 0) * 64; r4[j] = pi[i8q]; r5[j] = pi[i8q + 8];
                                pfa[j] = pf[F_FA + (lane < NFOX ? lane : 0)]; }
                            asm volatile("" ::: "memory");
#pragma unroll
                            for (int j = 0; j < 8; ++j) { pc0[j] = bf2f(r0[j]); pc1[j] = bf2f(r1[j]); qc1[j] = bf2f(r2[j]); qc2[j] = bf2f(r3[j]); qi1[j] = bf2f(r4[j]); qi2[j] = bf2f(r5[j]); }
                        }
                        const float bfv = *(const GAS float*)(bfor + (lane < NFOX ? lane : 0));
                        LAS float* cn8 = (LAS float*)Tt;
                        { float ss[8];
#pragma unroll
                          for (int j = 0; j < 8; ++j) ss[j] = pc0[j] * pc0[j] + pc1[j] * pc1[j];
#pragma unroll
                          for (int j = 0; j < 8; ++j) ss[j] = wave_sum_dpp(ss[j]);
                          const float g0 = gkv[lane], g1 = gkv[64 + lane];
#pragma unroll
                          for (int j = 0; j < 8; ++j) { const float rn = 1.0f / sqrtf(ss[j] * (1.0f / 128.0f) + EPS); cn8[j * 128 + lane] = pc0[j] * rn * g0; cn8[j * 128 + 64 + lane] = pc1[j] * rn * g1; } }
                        LDS_WAIT(); asm volatile("" ::: "memory");
                        float a0[8], a1[8];
#pragma unroll
                        for (int j = 0; j < 8; ++j) { a0[j] = 0.f; a1[j] = 0.f; }
#pragma unroll 2
                        for (int k = 0; k < 128; k += 4) {
                            unsigned w[4];
#pragma unroll
                            for (int e = 0; e < 4; ++e) w[e] = Wl[(k + e) * 64 + lane];
#pragma unroll
                            for (int j = 0; j < 8; ++j) { const f32x4 cn = *(const LAS f32x4*)(cn8 + j * 128 + k);
#pragma unroll
                                for (int e = 0; e < 4; ++e) { a0[j] = fmaf(cn[e], bflo(w[e]), a0[j]); a1[j] = fmaf(cn[e], bfhi(w[e]), a1[j]); } }
                        }
                        { float ss[8];
#pragma unroll
                          for (int j = 0; j < 8; ++j) ss[j] = pki[j] * pki[j];
#pragma unroll
                          for (int o = 1; o < 64; o <<= 1)
#pragma unroll
                              for (int j = 0; j < 8; ++j) ss[j] += bperm_f(ss[j], lane ^ o);
#pragma unroll
                          for (int j = 0; j < 8; ++j) pki[j] = pki[j] * (1.0f / sqrtf(ss[j] * (1.0f / 64.0f) + EPS)) * gik[lane]; }
#pragma unroll
                        for (int j = 0; j < 8; ++j) {
                            const int tl = wave * 8 + j, r = blk * 64 + tl; const int pos = r % SEQ; const int i8 = lane & 7;
                            float rc, rsn; rope_cs(pos, i8, rc, rsn);
                            float x0 = a0[j], x1v = a1[j];
                            {
                              const int j0 = (2 * lane) & 7, j1 = (2 * lane + 1) & 7;
                              const float c_0 = bperm_f(rc, j0), s_0 = bperm_f(rsn, j0), c_1 = bperm_f(rc, j1), s_1 = bperm_f(rsn, j1);
                              const float o0 = bperm_f(x0, lane ^ 4), o1 = bperm_f(x1v, lane ^ 4);
                              if (lane < 4) { x0 = x0 * c_0 - o0 * s_0; x1v = x1v * c_1 - o1 * s_1; } else if (lane < 8) { x0 = x0 * c_0 + o0 * s_0; x1v = x1v * c_1 + o1 * s_1; } }
                            const size_t kimg = (size_t)(r / SEQ) * SEQ * 64 + (size_t)((pos >> 5) * 4) * 512 + (pos & 31) * 8;
                            if (lane < 32) *(GAS unsigned*)(KC + kimg + (lane >> 3) * 512 + ((lane >> 2) & 1) * 256 + ((2 * lane) & 7)) = pk2(x0, x1v);
                            else *(LAS unsigned*)(VCt + tl * 64 + 2 * (lane - 32)) = pk2(x0, x1v);
                            { const int hh = lane >> 3;
                              bf16* pc = P + (size_t)r * NIN + C_QC + hh * 64; bf16* pi = P + (size_t)r * NIN + C_QI + hh * 64; const bool sc_ = i8 == 0 && hh < 5, si_ = i8 == 0 && hh < 4;
                              { const v4u w_ = pack8_dpp(qc1[j] * rc - qc2[j] * rsn); if (sc_) *(GAS v4u*)pc = w_; }
                              { const v4u w_ = pack8_dpp(qc2[j] * rc + qc1[j] * rsn); if (sc_) *(GAS v4u*)(pc + 8) = w_; }
                              { const v4u w_ = pack8_dpp(qi1[j] * rc - qi2[j] * rsn); if (si_) *(GAS v4u*)pi = w_; }
                              { const v4u w_ = pack8_dpp(qi2[j] * rc + qi1[j] * rsn); if (si_) *(GAS v4u*)(pi + 8) = w_; } }
                            { float y = pki[j]; const float other = bperm_f(y, lane ^ 8); if (lane < 8) y = y * rc - other * rsn; else if (lane < 16) y = y * rc + other * rsn;
                              const v4u yw = pack8_dpp(y); if (i8 == 0) *(GAS v4u*)(KI + kimg + (lane >> 4) * 512 + ((lane >> 3) & 1) * 256) = yw; }
                            if (lane < NFOX) { const float fv = pfa[j] + bfv;
                                CF[((size_t)(r / SEQ) * NFOX + lane) * SEQ + pos] = fminf(fv, 0.f) - __logf(1.0f + __expf(-fabsf(fv))); }
                            if (lane < 16) *(GAS v4u*)((lane < 8 ? YB : YC) + (size_t)r * KUP + 320 + 8 * (lane & 7)) = v4u{0u, 0u, 0u, 0u};
                        }
                        LDS_WAIT(); asm volatile("" ::: "memory");
                        __syncthreads();
                        const int bl = (blk * 64) / SEQ, t0 = (blk * 64) % SEQ;
                        {
                            const int tok0 = lane >> 3, chl = lane & 7;
                            v4u wb[8];
#pragma unroll
                            for (int i = 0; i < 8; ++i) wb[i] = *(const LAS v4u*)(VCt + (tok0 + 8 * i) * 64 + 8 * chl);
                            if (wave < 3) { const GAS bf16* pb = prow + C_VB + (wave + 2) * 64;
#pragma unroll
                              for (int i = 0; i < 8; ++i) wb[i] = *(const GAS v4u*)(pb + (size_t)(8 * i) * NIN); }
#pragma unroll 1
                            for (int rnd = 0; rnd < 2; ++rnd) {
                                const int jt = rnd ? wave + 8 : wave;
                                if (jt < 12) {
#pragma unroll
                                for (int i = 0; i < 8; ++i) { const int tok = tok0 + 8 * i; const v4u w = wa[i];
                                    const int tp = (tok & ~12) | ((tok & 4) << 1) | ((tok & 8) >> 1);
                                    LAS bf16* d = Tt + (8 * chl) * 72 + ((((tp >> 3) ^ chl) << 3) | (tp & 7));
                                    d[0 * 72] = (bf16)(w.x & 0xffffu); d[1 * 72] = (bf16)(w.x >> 16); d[2 * 72] = (bf16)(w.y & 0xffffu); d[3 * 72] = (bf16)(w.y >> 16);
                                    d[4 * 72] = (bf16)(w.z & 0xffffu); d[5 * 72] = (bf16)(w.z >> 16); d[6 * 72] = (bf16)(w.w & 0xffffu); d[7 * 72] = (bf16)(w.w >> 16); }
                                LDS_WAIT(); asm volatile("" ::: "memory");
                                bf16* dst = jt < 6 ? VTA + ((size_t)(bl * NFOX + jt) * 64) * SEQ : jt < 11 ? VTB + ((size_t)(bl * NSB + (jt - 6)) * 64) * SEQ : VTC + ((size_t)bl * 64) * SEQ;
                                v4u o[8];
#pragma unroll
                                for (int i = 0; i < 8; ++i) o[i] = *(const LAS v4u*)(Tt + (tok0 + 8 * i) * 72 + 8 * (chl ^ i));
#pragma unroll
                                for (int i = 0; i < 8; ++i) { const int d = tok0 + 8 * i;
                                    *(GAS v4u*)(dst + ((size_t)(((t0 >> 5) + (chl >> 2)) * 2 + (d >> 5)) * 2 + ((chl & 3) >> 1)) * 512 + ((d & 31) + 32 * (chl & 1)) * 8) = o[i]; }
                                LDS_WAIT(); asm volatile("" ::: "memory");
                                }
#pragma unroll
                                for (int i = 0; i < 8; ++i) wa[i] = wb[i];
                            }
                        }
                        __syncthreads();
                    }
                PH_END
                PH_BEGIN
                    { const int vw = gw >> 3, w8 = gw & 7; const int nF = G < 192 ? G : 192, nS = G - nF;
                      for (int it = vw; it < HB * NFOX * 4; it += G) { const int q4 = it / (HB * NFOX), bh = it % (HB * NFOX);
                            LAS float* cfL = (LAS float*)(lds + RING_OFF);
                            __syncthreads();
                            {
                                const int ti = (int)tx_; f32x4 v = *(const GAS f32x4*)(CF + (size_t)bh * SEQ + 4 * ti);
                                v[1] += v[0]; v[2] += v[1]; v[3] += v[2];
                                float tot = v[3];
#pragma unroll
                                for (int o = 1; o < 64; o <<= 1) { const float n = bperm_f(tot, lane - o); if (lane >= o) tot += n; }
                                LAS float* wtot = cfL + SEQ;
                                if (lane == 63) wtot[wave] = tot;
                                __syncthreads();
                                float base = tot - v[3];
#pragma unroll
                                for (int w = 0; w < 8; ++w) base += w < wave ? wtot[w] : 0.f;
                                *(LAS f32x4*)(cfL + 4 * ti) = (v + base) * (-LOG2E);
                            }
                            __syncthreads();
#pragma unroll 1
                            for (int hl = 0; hl < 2; ++hl) fox_strip(P, KAI, cfL, VTA, YA, bh / NFOX, bh % NFOX, hl == 0 ? (7 - q4) * 8 + 7 - w8 : q4 * 8 + w8, lane); }
                      if (nS > 0) { if (vw >= nF) for (int E = vw - nF; E < HB * NSB * 8; E += nS) { const int Qg = 7 - E / (HB * NSB), bh = E % (HB * NSB); sb_strip(P, KBI, VTB, YB, bh / NSB, bh % NSB, Qg * 8 + 7 - w8, lane); } }
                      else for (int E = vw; E < HB * NSB * 8; E += G) { const int Qg = 7 - E / (HB * NSB), bh = E % (HB * NSB); sb_strip(P, KBI, VTB, YB, bh / NSB, bh % NSB, Qg * 8 + 7 - w8, lane); }
                    }
                    __syncthreads();
                    for (int rd = 0; rd * G < HB * 64; ++rd) { const int vw = gw >> 3; const int U = rd * G + ((rd & 1) ? G - 1 - vw : vw);
                        if (U < HB * 64) dsa_unit(P, PF, KI, KC, VTC, YC, U % HB, 63 - U / HB, wave, (int)(TX_NOW() & 63u), lds + RING_OFF); }
                PH_END
                PH_BEGIN
                    pg8::SegOrder3 S; S.init(MH, DM, G, bx);
                    { pg8::Gemm g{YA, WUP, MH, DM, 384, KUP}; pg8::EpiGateR E{P + C_GATE, MGB}; pg8::gemm_phase<pg8::EpiGateR, pg8::SegOrder3, true, true>(lds + RING_OFF, g, S, E, (int)TX_NOW()); }
                PH_END
                PH_BEGIN
                    pg8::Gemm g{MGB, WOUT, MH, DM, DM, 0}; pg8::StaticOrder S; S.init(MH, DM, G, bx);
                    pg8::EpiResid E{XB + rb * DM, SSQ + rb * 16, 1.0f};
                    pg8::gemm_phase<pg8::EpiResid, pg8::StaticOrder, true, true>(lds + RING_OFF, g, S, E, (int)TX_NOW());
                    if (hf == 0) { const size_t rb1 = (size_t)MH;

                    pg8::Gemm g{XB + rb1 * DM, WIN, MH, NIN, DM, 0}; pg8::StaticOrder S; S.init(MH, NIN, G, bx);
                    LAS float* rsT = (LAS float*)(lds + RST_OFF);
                    pg8::EpiWin E{rsT, P, PF, NIN};
                    { const float* ssq_ = SSQ + rb1 * 16; auto pre = [&]() { pg8::rs_table_fill(rsT, ssq_, S, (int)TX_NOW()); };
                      pg8::gemm_phase<pg8::EpiWin, pg8::StaticOrder, true, true>(lds + RING_OFF, g, S, E, (int)TX_NOW(), pre); }
                                    }
                PH_END
            }
        }
    }
    PH_BEGIN
        const float* gf = ka->in[17];
        const GAS f32x4* gr = (const GAS f32x4*)gf + lane; f32x4 gv[4];
#pragma unroll
        for (int j = 0; j < 4; ++j) gv[j] = gr[64 * j];
        for (int m0 = gw * 4; m0 < MTOK; m0 += NGW * 4) {
            u32x2 w[4][4];
#pragma unroll
            for (int q = 0; q < 4; ++q) { const GAS u32x2* xr = (const GAS u32x2*)(XB + (size_t)(m0 + q) * DM) + lane;
#pragma unroll
                for (int j = 0; j < 4; ++j) w[q][j] = xr[64 * j]; }
#pragma unroll
            for (int q = 0; q < 4; ++q) { f32x4 v[4]; float s = 0.f;
#pragma unroll
                for (int j = 0; j < 4; ++j) { v[j][0] = bflo(w[q][j].x); v[j][1] = bfhi(w[q][j].x); v[j][2] = bflo(w[q][j].y); v[j][3] = bfhi(w[q][j].y); s += (v[j][0] * v[j][0] + v[j][1] * v[j][1]) + (v[j][2] * v[j][2] + v[j][3] * v[j][3]); }
                const float rs = 1.0f / sqrtf(wave_sum(s, lane) * (1.0f / DM) + EPS);
                GAS f32x4* orow = (GAS f32x4*)(xf + (size_t)(m0 + q) * DM) + lane;
#pragma unroll
                for (int j = 0; j < 4; ++j) orow[64 * j] = v[j] * rs * gv[j]; }
        }
    PH_END
#undef PH_BEGIN
#undef PH_END
}

#ifndef MK_N_LAUNCHES
#define MK_N_LAUNCHES 1
#endif
constexpr int N_PHASES = 1 + DEPTH * (2 + 1 + 2 * 4 + 2) + 1;
extern "C" void kernel_launch(void* const* d_in, const int* in_sizes, int n_in, void* d_out, int out_size, void* d_ws, size_t ws_size, hipStream_t stream) {
    static int grid = 0;
    if (grid == 0) {
        if (n_in != 18 || in_sizes[0] != MTOK * DM || out_size != MTOK * DM || ws_size < WS_END) { fprintf(stderr, "kernel_launch: unexpected shapes (n_in %d, in0 %d, out %d, ws %zu); nothing launched\n", n_in, n_in > 0 ? in_sizes[0] : -1, out_size, ws_size); grid = -1; return; }
        int dev = 0, cus = 0, per_cu = 0;
        if (hipGetDevice(&dev) != hipSuccess || hipDeviceGetAttribute(&cus, hipDeviceAttributeMultiprocessorCount, dev) != hipSuccess) { grid = -1; return; }
        if (hipFuncSetAttribute((const void*)mk_fwd, hipFuncAttributeMaxDynamicSharedMemorySize, LDS_BYTES) != hipSuccess) { fprintf(stderr, "kernel_launch: hipFuncSetAttribute failed\n"); grid = -1; return; }
        if (hipOccupancyMaxActiveBlocksPerMultiprocessor(&per_cu, (const void*)mk_fwd, NWAVES * 64, LDS_BYTES) != hipSuccess || per_cu < 1) fprintf(stderr, "kernel_launch: occupancy query reports %d workgroups per CU\n", per_cu);
        (void)hipGetLastError();
        grid = cus;
        if (grid > 256) grid = 256;
    }
    if (grid < 0) return;
    if (hipMemsetAsync((char*)d_ws + WS_CTL, 0, CTL_ZERO_BYTES, stream) != hipSuccess) return;
    Args a{};
    for (int i = 0; i < 18; ++i) a.in[i] = (const float*)d_in[i];
    a.out = (float*)d_out; a.ws = (unsigned char*)d_ws; a.pad = 0;
    const int nl = MK_N_LAUNCHES;
    for (int li = 0; li < nl; ++li) {
        a.ph_lo = (int)((long)N_PHASES * li / nl); a.ph_hi = (int)((long)N_PHASES * (li + 1) / nl); a.li = li;
        hipLaunchKernelGGL(mk_fwd, dim3(grid), dim3(NWAVES * 64), LDS_BYTES, stream, a);
        const hipError_t le = hipPeekAtLastError();
        if (le != hipSuccess) { fprintf(stderr, "kernel_launch: launch %d failed: %s\n", li, hipGetErrorName(le)); break; }
    }
}
```

```cpp
#include <hip/hip_runtime.h>
#include <cstdio>
#include <cstdint>
#include <cmath>
namespace pg8 {
#define PG8_LAS __attribute__((address_space(3)))
typedef unsigned short bf16_t;
typedef short bf16x8 __attribute__((ext_vector_type(8)));
typedef float f32x4 __attribute__((ext_vector_type(4)));
typedef unsigned u32x4 __attribute__((ext_vector_type(4)));
constexpr int BM = 256, BK = 64, HALF = 128, HTB = HALF * BK * 2  , STAGE_BYTES = 8 * HTB, NXCD = 8, WGM = 8;

__host__ __device__ __forceinline__ int lds_byte(int r, int c) { const int st = (r >> 4) * 2 + (c >> 5), rr = r & 15, cc = c & 31, ob = rr * 64 + cc * 2; return st * 1024 + (ob ^ (((ob >> 9) & 1) << 5)); }
__host__ __device__ __forceinline__ void stage_rc(int b, int& R, int& C) { const int st = b / 1024, sb = b % 1024, swz = sb ^ (((sb >> 9) & 1) << 5); R = (st >> 1) * 16 + swz / 64; C = (st & 1) * 32 + (swz % 64) / 2; }
__host__ __device__ __forceinline__ int perm32(int rho) { const int n = rho >> 4, i = rho & 15; return 8 * (i >> 2) + 4 * n + (i & 3); }

struct Unit { int pm, pn, ks, ui; };
struct Gemm { const bf16_t* A; const bf16_t* Bt; int M, N, K, ld; };

struct StaticOrder {
    int nM, nN, nwg, G, c;
    __host__ __device__ void init(int M, int N, int G_, int c_) { nM = M / BM; nN = N / BM; nwg = nM * nN; G = G_; c = c_; }
    __host__ __device__ bool next(int i, Unit& u) const {
        const long L = (long)i * G + c; if (L >= nwg) return false;
        int wgid = (int)L; { const int q = nwg / NXCD, r = nwg % NXCD, xcd = wgid % NXCD, off = wgid / NXCD; wgid = (xcd < r ? xcd * (q + 1) : r * (q + 1) + (xcd - r) * q) + off; }
        const int nig = WGM * nN, gid = wgid / nig, fm = gid * WGM, gsz = (nM - fm) < WGM ? (nM - fm) : WGM;
        u.pm = fm + ((wgid % nig) % gsz); u.pn = (wgid % nig) / gsz; u.ks = 0; u.ui = i; return true;
    }
    __device__ __forceinline__ void a_ready(const Unit&) const {}
    __device__ __forceinline__ void done(const Unit&) const {}
};

__device__ __forceinline__ unsigned cvt_pk_bf16(float lo, float hi) { unsigned r; asm volatile("v_cvt_pk_bf16_f32 %0, %1, %2" : "=v"(r) : "v"(lo), "v"(hi)); return r; }
typedef float f32x2 __attribute__((ext_vector_type(2)));

#define PG8_GAS __attribute__((address_space(1)))
__device__ __forceinline__ float row_rs(const float* ssq, int row) {
    const f32x4* p = (const f32x4*)(ssq + (size_t)row * 16);
    const f32x4 a = p[0], b = p[1], c = p[2], d = p[3];
    const float s = (((a[0] + a[1]) + (a[2] + a[3])) + ((b[0] + b[1]) + (b[2] + b[3]))) + (((c[0] + c[1]) + (c[2] + c[3])) + ((d[0] + d[1]) + (d[2] + d[3])));
    return 1.0f / sqrtf(s * (1.0f / 1024.0f) + 1e-6f);
}
__device__ __forceinline__ float sigmoid_f(float v) { return __builtin_amdgcn_rcpf(1.0f + __expf(-v)); }
__device__ __forceinline__ float bf_lo(unsigned w) { return __uint_as_float(w << 16); }
__device__ __forceinline__ float bf_hi(unsigned w) { return __uint_as_float(w & 0xffff0000u); }

template <class Sched> __device__ __forceinline__ void rs_table_fill(PG8_LAS float* rsT, const float* ssq, const Sched& S, int tid) {
    Unit u; const int row = tid >> 1, hf = tid & 1;
    f32x4 a[12], b[12]; int n = 0;
#pragma unroll
    for (int i = 0; i < 12; ++i) { if (S.next(i, u)) { const PG8_GAS f32x4* p = (const PG8_GAS f32x4*)(ssq + (size_t)(u.pm * BM + row) * 16 + 8 * hf); a[i] = p[0]; b[i] = p[1]; n = i + 1; } else { a[i] = f32x4{}; b[i] = f32x4{}; } }
#pragma unroll
    for (int i = 0; i < 12; ++i) {
        float s = ((a[i][0] + a[i][1]) + (a[i][2] + a[i][3])) + ((b[i][0] + b[i][1]) + (b[i][2] + b[i][3]));
        s += __int_as_float(__builtin_amdgcn_ds_bpermute(((tid & 63) ^ 1) << 2, __float_as_int(s)));
        if (hf == 0 && i < n) rsT[i * BM + row] = 1.0f / sqrtf(s * (1.0f / 1024.0f) + 1e-6f);
    }
    __syncthreads();
}
#define PIN8(a) asm volatile("" : "+v"((a)[0]), "+v"((a)[1]), "+v"((a)[2]), "+v"((a)[3]), "+v"((a)[4]), "+v"((a)[5]), "+v"((a)[6]), "+v"((a)[7]))
#define PIN4X2(a) asm volatile("" : "+v"((a)[0]), "+v"((a)[1]), "+v"((a)[2]), "+v"((a)[3]))
struct EpiSwiglu {
    static constexpr bool PERM = true, AFTER_DRAIN = false, CARRY = false;
    const PG8_LAS float* rsT; bf16_t* H; int ldh;
    __device__ __forceinline__ void operator()(const f32x4 (&acc)[2][2][4][2], const Unit& u, int wr, int wc, int fr, int fq) const {
        const int row0 = u.pm * BM + wr * 64 + fr, col0 = u.pn * HALF + wc * 32 + 8 * fq;
#pragma unroll
        for (int ai = 0; ai < 2; ++ai)
#pragma unroll
            for (int m = 0; m < 4; ++m) {
                const int row = row0 + ai * HALF + m * 16; const float r = rsT[u.ui * BM + wr * 64 + fr + ai * HALF + m * 16];
                const float rn = r * -1.4426950408889634f, rq = r * r;
                f32x2 g[4], p[4], t[4];
#pragma unroll
                for (int n = 0; n < 2; ++n) { const f32x4 G4 = acc[ai][0][m][n], U4 = acc[ai][1][m][n];
                    g[2 * n] = f32x2{G4[0], G4[1]}; g[2 * n + 1] = f32x2{G4[2], G4[3]}; p[2 * n] = f32x2{U4[0], U4[1]}; p[2 * n + 1] = f32x2{U4[2], U4[3]}; }
#pragma unroll
                for (int i = 0; i < 4; ++i) { t[i] = g[i] * rn; p[i] = g[i] * p[i]; }
                PIN4X2(t);
#pragma unroll
                for (int i = 0; i < 4; ++i) { t[i][0] = __builtin_amdgcn_exp2f(t[i][0]); t[i][1] = __builtin_amdgcn_exp2f(t[i][1]); }
                PIN4X2(t);
#pragma unroll
                for (int i = 0; i < 4; ++i) { t[i] = t[i] + 1.0f; p[i] = p[i] * rq; }
                PIN4X2(t);
#pragma unroll
                for (int i = 0; i < 4; ++i) { t[i][0] = __builtin_amdgcn_rcpf(t[i][0]); t[i][1] = __builtin_amdgcn_rcpf(t[i][1]); }
                PIN4X2(t);
#pragma unroll
                for (int i = 0; i < 4; ++i) t[i] = t[i] * p[i];
                u32x4 w; w.x = cvt_pk_bf16(t[0][0], t[0][1]); w.y = cvt_pk_bf16(t[1][0], t[1][1]); w.z = cvt_pk_bf16(t[2][0], t[2][1]); w.w = cvt_pk_bf16(t[3][0], t[3][1]);
                *(PG8_GAS u32x4*)(H + (size_t)row * ldh + col0) = w;
            }
    }
};
struct EpiResid {
    static constexpr bool PERM = true, AFTER_DRAIN = false, CARRY = false;
    bf16_t* xb; float* ssq; float alpha;
    __device__ __forceinline__ void operator()(const f32x4 (&acc)[2][2][4][2], const Unit& u, int wr, int wc, int fr, int fq) const {
        const int row0 = u.pm * BM + wr * 64 + fr, col0 = u.pn * BM + wc * 32 + 8 * fq;
#pragma unroll
        for (int ai = 0; ai < 2; ++ai)
        {
            u32x4 xov[4][2];
#pragma unroll
            for (int m = 0; m < 4; ++m)
#pragma unroll
                for (int bj = 0; bj < 2; ++bj) xov[m][bj] = *(const PG8_GAS u32x4*)(xb + (size_t)(row0 + ai * HALF + m * 16) * 1024 + col0 + bj * HALF);
#pragma unroll
            for (int m = 0; m < 4; ++m) {
                const int row = row0 + ai * HALF + m * 16; float sq = 0.f;
#pragma unroll
                for (int bj = 0; bj < 2; ++bj) {
                    const u32x4 xo = xov[m][bj];
                    f32x4 x0, x1; x0[0] = bf_lo(xo.x); x0[1] = bf_hi(xo.x); x0[2] = bf_lo(xo.y); x0[3] = bf_hi(xo.y); x1[0] = bf_lo(xo.z); x1[1] = bf_hi(xo.z); x1[2] = bf_lo(xo.w); x1[3] = bf_hi(xo.w);
                    x0 += acc[ai][bj][m][0] * alpha; x1 += acc[ai][bj][m][1] * alpha;
                    u32x4 w; w.x = cvt_pk_bf16(x0[0], x0[1]); w.y = cvt_pk_bf16(x0[2], x0[3]); w.z = cvt_pk_bf16(x1[0], x1[1]); w.w = cvt_pk_bf16(x1[2], x1[3]);
                    *(PG8_GAS u32x4*)(xb + (size_t)row * 1024 + col0 + bj * HALF) = w;
                    sq += ((x0[0] * x0[0] + x0[1] * x0[1]) + (x0[2] * x0[2] + x0[3] * x0[3])) + ((x1[0] * x1[0] + x1[1] * x1[1]) + (x1[2] * x1[2] + x1[3] * x1[3]));
                }
                { const int ln_ = fq * 16 + fr;
                  sq += __int_as_float(__builtin_amdgcn_ds_bpermute((ln_ ^ 16) << 2, __float_as_int(sq))); sq += __int_as_float(__builtin_amdgcn_ds_bpermute((ln_ ^ 32) << 2, __float_as_int(sq))); }
                if (fq == 0) *(PG8_GAS float*)(ssq + (size_t)row * 16 + u.pn * 4 + wc) = sq;
            }
        }
    }
};
struct EpiWin {
    static constexpr bool PERM = true, AFTER_DRAIN = false, CARRY = false;
    static constexpr int KA0 = 384, NHA = 6, KB0 = 1472, NHB = 5, SEQL = 2048; static constexpr long KAI_OFF = (364L - 120L) << 20, KBI_OFF = (376L - 120L) << 20, GI_OFF = (216L - 120L) << 20;
    const PG8_LAS float* rsT; bf16_t* P; float* Pf; int ldp;
    __device__ __forceinline__ void operator()(const f32x4 (&acc)[2][2][4][2], const Unit& u, int wr, int wc, int fr, int fq) const {
        const int row0 = u.pm * BM + wr * 64 + fr, cin = wc * 32 + 8 * fq;
#pragma unroll
        for (int ai = 0; ai < 2; ++ai)
#pragma unroll
            for (int m = 0; m < 4; ++m) {
                const int row = row0 + ai * HALF + m * 16; const float r = rsT[u.ui * BM + wr * 64 + fr + ai * HALF + m * 16];
                if (u.pn == 11) {
#pragma unroll
                    for (int bj = 0; bj < 2; ++bj) { const f32x4 v0 = acc[ai][bj][m][0] * r, v1 = acc[ai][bj][m][1] * r;
                        PG8_GAS float* o = (PG8_GAS float*)(Pf + (size_t)row * 256 + cin + bj * HALF); *(PG8_GAS f32x4*)o = v0; *(PG8_GAS f32x4*)(o + 4) = v1; }
                } else if (u.pn >= 12) {
                    const float rn = r * -1.4426950408889634f;
                    f32x2 t[8];
#pragma unroll
                    for (int bj = 0; bj < 2; ++bj)
#pragma unroll
                        for (int n = 0; n < 2; ++n) { const f32x4 A4 = acc[ai][bj][m][n]; t[4 * bj + 2 * n] = f32x2{A4[0], A4[1]} * rn; t[4 * bj + 2 * n + 1] = f32x2{A4[2], A4[3]} * rn; }
                    PIN4X2(t); PIN4X2(t + 4);
#pragma unroll
                    for (int i = 0; i < 8; ++i) { t[i][0] = __builtin_amdgcn_exp2f(t[i][0]); t[i][1] = __builtin_amdgcn_exp2f(t[i][1]); }
                    PIN4X2(t); PIN4X2(t + 4);
#pragma unroll
                    for (int i = 0; i < 8; ++i) t[i] = t[i] + 1.0f;
                    PIN4X2(t); PIN4X2(t + 4);
#pragma unroll
                    for (int i = 0; i < 8; ++i) { t[i][0] = __builtin_amdgcn_rcpf(t[i][0]); t[i][1] = __builtin_amdgcn_rcpf(t[i][1]); }
#pragma unroll
                    for (int bj = 0; bj < 2; ++bj) { u32x4 w; w.x = cvt_pk_bf16(t[4 * bj][0], t[4 * bj][1]); w.y = cvt_pk_bf16(t[4 * bj + 1][0], t[4 * bj + 1][1]); w.z = cvt_pk_bf16(t[4 * bj + 2][0], t[4 * bj + 2][1]); w.w = cvt_pk_bf16(t[4 * bj + 3][0], t[4 * bj + 3][1]);
                        bf16_t* gi = (bf16_t*)((char*)P + GI_OFF) + ((size_t)(((u.pn - 12) >> 2) * 64 + u.pm) * 4 + ((u.pn - 12) & 3)) * 65536;
                        *(PG8_GAS u32x4*)(gi + (wr * 4 + wc) * 8192 + ((ai * 4 + m) * 2 + bj) * 512 + (fr + 16 * fq) * 8) = w; }
                } else {
#pragma unroll
                    for (int bj = 0; bj < 2; ++bj) { const f32x4 v0 = acc[ai][bj][m][0] * r, v1 = acc[ai][bj][m][1] * r;
                        u32x4 w; w.x = cvt_pk_bf16(v0[0], v0[1]); w.y = cvt_pk_bf16(v0[2], v0[3]); w.z = cvt_pk_bf16(v1[0], v1[1]); w.w = cvt_pk_bf16(v1[2], v1[3]);
                        const int gb = u.pn * BM + wc * 32 + bj * HALF;
                        const bool isKa = gb >= KA0 && gb < KA0 + 64 * NHA, isKb = gb >= KB0 && gb < KB0 + 64 * NHB;
                        if (isKa || isKb) {
                            const int rel = gb - (isKa ? KA0 : KB0), head = rel >> 6, c = ((rel & 63) >> 3) + fq, bt = row / SEQL, pos = row % SEQL;
                            bf16_t* img = (bf16_t*)((char*)P + (isKa ? KAI_OFF : KBI_OFF)) + (size_t)(bt * (isKa ? NHA : NHB) + head) * 64 * SEQL;
                            *(PG8_GAS u32x4*)(img + ((size_t)((pos >> 5) * 4 + (c >> 1)) * 64 + (pos & 31) + 32 * (c & 1)) * 8) = w;
                        } else *(PG8_GAS u32x4*)(P + (size_t)row * ldp + gb + 8 * fq) = w; }
                }
            }
    }
};
template <int MODE> struct EpiGate {
    static constexpr bool PERM = true, AFTER_DRAIN = false, CARRY = false;
    const bf16_t* G; int ldg; bf16_t* part; bf16_t* mgb;
    __device__ __forceinline__ void operator()(const f32x4 (&acc)[2][2][4][2], const Unit& u, int wr, int wc, int fr, int fq) const {
        const int row0 = u.pm * BM + wr * 64 + fr, col0 = u.pn * BM + wc * 32 + 8 * fq;
#pragma unroll
        for (int ai = 0; ai < 2; ++ai)
        {
            u32x4 gwv[4][2], pwv[4][2];
#pragma unroll
            for (int m = 0; m < 4; ++m)
#pragma unroll
                for (int bj = 0; bj < 2; ++bj) { const int row = row0 + ai * HALF + m * 16, col = col0 + bj * HALF;
                    gwv[m][bj] = *(const PG8_GAS u32x4*)(G + (size_t)row * ldg + col);
                    if (MODE >= 1) pwv[m][bj] = *(const PG8_GAS u32x4*)(part + (size_t)row * 1024 + col); }
#pragma unroll
            for (int m = 0; m < 4; ++m) {
                const int row = row0 + ai * HALF + m * 16;
#pragma unroll
                for (int bj = 0; bj < 2; ++bj) {
                    const int col = col0 + bj * HALF;
                    const u32x4 gw = gwv[m][bj];
                    f32x4 v0 = acc[ai][bj][m][0], v1 = acc[ai][bj][m][1];
                    v0[0] *= bf_lo(gw.x); v0[1] *= bf_hi(gw.x); v0[2] *= bf_lo(gw.y); v0[3] *= bf_hi(gw.y);
                    v1[0] *= bf_lo(gw.z); v1[1] *= bf_hi(gw.z); v1[2] *= bf_lo(gw.w); v1[3] *= bf_hi(gw.w);
                    if (MODE >= 1) { const u32x4 pw = pwv[m][bj];
                        v0[0] += bf_lo(pw.x); v0[1] += bf_hi(pw.x); v0[2] += bf_lo(pw.y); v0[3] += bf_hi(pw.y); v1[0] += bf_lo(pw.z); v1[1] += bf_hi(pw.z); v1[2] += bf_lo(pw.w); v1[3] += bf_hi(pw.w); }
                    u32x4 w; w.x = cvt_pk_bf16(v0[0], v0[1]); w.y = cvt_pk_bf16(v0[2], v0[3]); w.z = cvt_pk_bf16(v1[0], v1[1]); w.w = cvt_pk_bf16(v1[2], v1[3]);
                    *(PG8_GAS u32x4*)((MODE <= 1 ? part : mgb) + (size_t)row * 1024 + col) = w;
                }
            }
        }
    }
};

struct SegOrder3 : StaticOrder {
    __host__ __device__ bool next(int i, Unit& u) const { const bool ok = StaticOrder::next(i / 3, u); u.ks = i % 3; u.ui = i; return ok; }
};
struct EpiGateU {
    static constexpr bool PERM = true, AFTER_DRAIN = false, CARRY = false;
    const bf16_t* G; bf16_t* mgb; static constexpr int ldg = 6144;
    __device__ __forceinline__ void operator()(const f32x4 (&acc)[2][2][4][2], const Unit& u, int wr, int wc, int fr, int fq) const {
        const int row0 = u.pm * BM + wr * 64 + fr, col0 = u.pn * BM + wc * 32 + 8 * fq;
        const bf16_t* Gs = G + u.ks * 1024; const unsigned keep = u.ks ? 0xffffffffu : 0u;
#pragma unroll
        for (int ai = 0; ai < 2; ++ai)
        {
            u32x4 gwv[4][2], pwv[4][2];
#pragma unroll
            for (int m = 0; m < 4; ++m)
#pragma unroll
                for (int bj = 0; bj < 2; ++bj) { const int row = row0 + ai * HALF + m * 16, col = col0 + bj * HALF;
                    gwv[m][bj] = *(const PG8_GAS u32x4*)(Gs + (size_t)row * ldg + col);
                    pwv[m][bj] = *(const PG8_GAS u32x4*)(mgb + (size_t)row * 1024 + col); }
#pragma unroll
            for (int m = 0; m < 4; ++m) {
                const int row = row0 + ai * HALF + m * 16;
#pragma unroll
                for (int bj = 0; bj < 2; ++bj) {
                    const int col = col0 + bj * HALF;
                    const u32x4 gw = gwv[m][bj]; u32x4 pw = pwv[m][bj]; pw.x &= keep; pw.y &= keep; pw.z &= keep; pw.w &= keep;
                    f32x4 v0 = acc[ai][bj][m][0], v1 = acc[ai][bj][m][1];
                    v0[0] = fmaf(v0[0], bf_lo(gw.x), bf_lo(pw.x)); v0[1] = fmaf(v0[1], bf_hi(gw.x), bf_hi(pw.x)); v0[2] = fmaf(v0[2], bf_lo(gw.y), bf_lo(pw.y)); v0[3] = fmaf(v0[3], bf_hi(gw.y), bf_hi(pw.y));
                    v1[0] = fmaf(v1[0], bf_lo(gw.z), bf_lo(pw.z)); v1[1] = fmaf(v1[1], bf_hi(gw.z), bf_hi(pw.z)); v1[2] = fmaf(v1[2], bf_lo(gw.w), bf_lo(pw.w)); v1[3] = fmaf(v1[3], bf_hi(gw.w), bf_hi(pw.w));
                    u32x4 w; w.x = cvt_pk_bf16(v0[0], v0[1]); w.y = cvt_pk_bf16(v0[2], v0[3]); w.z = cvt_pk_bf16(v1[0], v1[1]); w.w = cvt_pk_bf16(v1[2], v1[3]);
                    *(PG8_GAS u32x4*)(mgb + (size_t)row * 1024 + col) = w;
                }
            }
        }
    }
};

struct EpiGateR {
    static constexpr bool PERM = true, AFTER_DRAIN = false, CARRY = true;
    const bf16_t* G; bf16_t* mgb; static constexpr int ldg = 6144;
    __device__ __forceinline__ void operator()(const f32x4 (&acc)[2][2][4][2], const Unit& u, int wr, int wc, int fr, int fq) const {
        if (u.ks != 2) return;
        const int row0 = u.pm * BM + wr * 64 + fr, col0 = u.pn * BM + wc * 32 + 8 * fq;
        const bf16_t* Gs = G + ((size_t)(2 * 64 + u.pm) * 4 + u.pn) * 65536 + (wr * 4 + wc) * 8192 + (fr + 16 * fq) * 8;
#pragma unroll
        for (int ai = 0; ai < 2; ++ai)
        {
            u32x4 gwv[4][2];
#pragma unroll
            for (int m = 0; m < 4; ++m)
#pragma unroll
                for (int bj = 0; bj < 2; ++bj) gwv[m][bj] = *(const PG8_GAS u32x4*)(Gs + ((ai * 4 + m) * 2 + bj) * 512);
#pragma unroll
            for (int m = 0; m < 4; ++m)
#pragma unroll
                for (int bj = 0; bj < 2; ++bj) {
                    const u32x4 gw = gwv[m][bj]; f32x4 v0 = acc[ai][bj][m][0], v1 = acc[ai][bj][m][1];
                    v0[0] *= bf_lo(gw.x); v0[1] *= bf_hi(gw.x); v0[2] *= bf_lo(gw.y); v0[3] *= bf_hi(gw.y); v1[0] *= bf_lo(gw.z); v1[1] *= bf_hi(gw.z); v1[2] *= bf_lo(gw.w); v1[3] *= bf_hi(gw.w);
                    u32x4 w; w.x = cvt_pk_bf16(v0[0], v0[1]); w.y = cvt_pk_bf16(v0[2], v0[3]); w.z = cvt_pk_bf16(v1[0], v1[1]); w.w = cvt_pk_bf16(v1[2], v1[3]);
                    *(PG8_GAS u32x4*)(mgb + (size_t)(row0 + ai * HALF + m * 16) * 1024 + col0 + bj * HALF) = w;
                }
        }
    }
    __device__ __forceinline__ void carry(f32x4 (&acc)[2][2][4][2], const Unit& u, int wr, int wc, int fr, int fq) const {
        const int row0 = u.pm * BM + wr * 64 + fr, col0 = u.pn * BM + wc * 32 + 8 * fq;
        const int kn = u.ks < 2 ? u.ks + 1 : 2; const float z = u.ks < 2 ? 1.0f : 0.0f;
        const size_t wofs = (size_t)(wr * 4 + wc) * 8192 + (fr + 16 * fq) * 8;
        const bf16_t* Ga = G + ((size_t)(u.ks * 64 + u.pm) * 4 + u.pn) * 65536 + wofs; const bf16_t* Gb = G + ((size_t)(kn * 64 + u.pm) * 4 + u.pn) * 65536 + wofs;
#pragma unroll
        for (int ai = 0; ai < 2; ++ai)
#pragma unroll
        for (int mh = 0; mh < 2; ++mh)
        {
            u32x4 ga[2][2], gb[2][2];
#pragma unroll
            for (int m2 = 0; m2 < 2; ++m2)
#pragma unroll
                for (int bj = 0; bj < 2; ++bj) { const int o_ = ((ai * 4 + 2 * mh + m2) * 2 + bj) * 512; ga[m2][bj] = *(const PG8_GAS u32x4*)(Ga + o_); gb[m2][bj] = *(const PG8_GAS u32x4*)(Gb + o_); }
#pragma unroll
            for (int m2 = 0; m2 < 2; ++m2)
#pragma unroll
                for (int bj = 0; bj < 2; ++bj) { const int m = 2 * mh + m2; const u32x4 a_ = ga[m2][bj], b_ = gb[m2][bj];
                    float fa[8] = {bf_lo(a_.x), bf_hi(a_.x), bf_lo(a_.y), bf_hi(a_.y), bf_lo(a_.z), bf_hi(a_.z), bf_lo(a_.w), bf_hi(a_.w)};
                    float fb[8] = {bf_lo(b_.x), bf_hi(b_.x), bf_lo(b_.y), bf_hi(b_.y), bf_lo(b_.z), bf_hi(b_.z), bf_lo(b_.w), bf_hi(b_.w)};
#pragma unroll
                    for (int e_ = 0; e_ < 8; ++e_) fb[e_] = __builtin_amdgcn_rcpf(fb[e_]);
#pragma unroll
                    for (int e_ = 0; e_ < 8; ++e_) fa[e_] = fa[e_] * fb[e_] * z;
#pragma unroll
                    for (int n_ = 0; n_ < 2; ++n_) { f32x4 v_ = acc[ai][bj][m][n_];
                        asm volatile("v_mul_f32 %0, %0, %4\n\tv_mul_f32 %1, %1, %5\n\tv_mul_f32 %2, %2, %6\n\tv_mul_f32 %3, %3, %7" : "+v"(v_[0]), "+v"(v_[1]), "+v"(v_[2]), "+v"(v_[3]) : "v"(fa[4 * n_ + 0]), "v"(fa[4 * n_ + 1]), "v"(fa[4 * n_ + 2]), "v"(fa[4 * n_ + 3]));
                        acc[ai][bj][m][n_] = v_; } }
            asm volatile("" ::: "memory");
        }
    }
};

struct NoPre { __device__ __forceinline__ void operator()() const {} };
template <class Epi, class Sched, bool ALIGN_EPI = false, bool SP2 = false, class Pre = NoPre>
__device__ __forceinline__ void gemm_phase(PG8_LAS unsigned char* lds, const Gemm g, const Sched& S, const Epi& E, int tid_in, const Pre& pre = Pre()) {
    int tid_ = tid_in; asm volatile("" : "+v"(tid_));
    const int tid = tid_, wid = __builtin_amdgcn_readfirstlane(tid >> 6), lane = tid & 63, wr = wid >> 2, wc = wid & 3, fr = lane & 15, fq = lane >> 4;
    const int K = g.K, nt = K / BK, ld = g.ld ? g.ld : g.K;
    unsigned voffA[2], voffB[2];
#pragma unroll
    for (int i = 0; i < 2; ++i) { int R, C; stage_rc(tid * 16 + i * 8192, R, C); const int Rb = Epi::PERM ? ((R & ~31) + perm32(R & 31)) : R;
        voffA[i] = (unsigned)(R * ld + C) * 2u; voffB[i] = (unsigned)(Rb * ld + C) * 2u; }
    const size_t kstep = (size_t)(BK * 2);
    const size_t hstep = (size_t)HALF * ld * 2;
    const size_t tstep = 2 * hstep;
    const unsigned ldsw = (unsigned)wid * 1024u;
    const int aoff = lds_byte(wr * 64 + fr, fq * 8), boff = lds_byte(wc * 32 + fr, fq * 8);
#define PG8_SA(b, h) (((b) * 2 + (h)) * HTB)
#define PG8_SB(b, h) ((4 + (b) * 2 + (h)) * HTB)
#define PG8_STAGE(bufoff, gbase, voff) do { _Pragma("unroll") for (int _i = 0; _i < 2; ++_i) \
        __builtin_amdgcn_global_load_lds((const unsigned*)((const char*)(gbase) + (voff)[_i]), (PG8_LAS unsigned*)(lds + (bufoff) + ldsw + _i * 8192), 16, 0, 0); } while (0)
#define PG8_LDA(dst, b, h) do { _Pragma("unroll") for (int m = 0; m < 4; ++m) _Pragma("unroll") for (int k = 0; k < 2; ++k) dst[m][k] = *(const PG8_LAS bf16x8*)(lds + PG8_SA(b, h) + aoff + m * 2048 + k * 1024); } while (0)
#define PG8_LDB(dst, b, h) do { _Pragma("unroll") for (int n = 0; n < 2; ++n) _Pragma("unroll") for (int k = 0; k < 2; ++k) dst[n][k] = *(const PG8_LAS bf16x8*)(lds + PG8_SB(b, h) + boff + n * 2048 + k * 1024); } while (0)
#define PG8_MMA(ai, bj, At, Bt) do { __builtin_amdgcn_s_setprio(1); _Pragma("unroll") for (int m = 0; m < 4; ++m) _Pragma("unroll") for (int n = 0; n < 2; ++n) _Pragma("unroll") for (int k = 0; k < 2; ++k) \
        acc[ai][bj][m][n] = __builtin_amdgcn_mfma_f32_16x16x32_bf16(Bt[n][k], At[m][k], acc[ai][bj][m][n], 0, 0, 0); __builtin_amdgcn_s_setprio(0); } while (0)
#define PG8_WAIT_V(n) asm volatile("s_waitcnt vmcnt(" #n ")" ::: "memory")
#define PG8_WAIT_L(n) asm volatile("s_waitcnt lgkmcnt(" #n ")" ::: "memory")
#define PG8_BAR __builtin_amdgcn_s_barrier()
#define PG8_SCHED __builtin_amdgcn_sched_barrier(0)
    Unit cur, nxt; int ui = 0;
    if (!S.next(0, cur)) return;
#define PG8_UNI(u_) do { (u_).pm = __builtin_amdgcn_readfirstlane((u_).pm); (u_).pn = __builtin_amdgcn_readfirstlane((u_).pn); (u_).ks = __builtin_amdgcn_readfirstlane((u_).ks); } while (0)
    PG8_UNI(cur);
    f32x4 acc[2][2][4][2];
#pragma unroll
    for (int a = 0; a < 2; ++a)
#pragma unroll
        for (int b = 0; b < 2; ++b)
#pragma unroll
            for (int m = 0; m < 4; ++m)
#pragma unroll
                for (int n = 0; n < 2; ++n) acc[a][b][m][n] = (f32x4){0.f, 0.f, 0.f, 0.f};
    bf16x8 At[4][2], B0[2][2], B1[2][2];
    const char* cA = (const char*)g.A + (size_t)cur.pm * tstep + (size_t)cur.ks * K * 2; const char* cB = (const char*)g.Bt + (size_t)cur.pn * tstep + (size_t)cur.ks * K * 2;
    S.a_ready(cur);
    if constexpr (SP2) {
        PG8_STAGE(PG8_SB(0, 0), cB, voffB); PG8_STAGE(PG8_SB(0, 1), cB + hstep, voffB); PG8_STAGE(PG8_SA(0, 0), cA, voffA); PG8_STAGE(PG8_SA(0, 1), cA + hstep, voffA);
        pre();
        if (wr == 1) PG8_BAR;
        PG8_WAIT_V(2); PG8_BAR;
        PG8_STAGE(PG8_SB(1, 0), cB + kstep, voffB); PG8_STAGE(PG8_SA(1, 0), cA + kstep, voffA); PG8_STAGE(PG8_SB(1, 1), cB + hstep + kstep, voffB);
        PG8_WAIT_V(6); PG8_BAR;
    } else {
        PG8_STAGE(PG8_SB(0, 0), cB, voffB); PG8_STAGE(PG8_SA(0, 0), cA, voffA); PG8_STAGE(PG8_SB(0, 1), cB + hstep, voffB); PG8_STAGE(PG8_SA(0, 1), cA + hstep, voffA);
        if (wr == 1) PG8_BAR;
        PG8_WAIT_V(4); PG8_BAR;
        PG8_STAGE(PG8_SB(1, 0), cB + kstep, voffB); PG8_STAGE(PG8_SA(1, 0), cA + kstep, voffA); PG8_STAGE(PG8_SB(1, 1), cB + hstep + kstep, voffB);
        PG8_WAIT_V(6); PG8_BAR;
    }
    for (;;) {
        const bool has_next = S.next(ui + 1, nxt); PG8_UNI(nxt);
        const char* nA = has_next ? (const char*)g.A + (size_t)nxt.pm * tstep + (size_t)nxt.ks * K * 2 : cA; const char* nB = has_next ? (const char*)g.Bt + (size_t)nxt.pn * tstep + (size_t)nxt.ks * K * 2 : cB;
        for (int t = 0; t < nt; t += 2) {
            const bool last = (t == nt - 2);
            const char* a1 = cA + (size_t)(t + 1) * kstep;
            const char* a2 = last ? nA : cA + (size_t)(t + 2) * kstep; const char* b2 = last ? nB : cB + (size_t)(t + 2) * kstep;
            const char* a3 = a2 + kstep; const char* b3 = b2 + kstep;
            if (last && has_next) S.a_ready(nxt);
            if constexpr (SP2) {
            PG8_LDB(B0, 0, 0); PG8_LDB(B1, 0, 1); PG8_SCHED; PG8_LDA(At, 0, 0); PG8_STAGE(PG8_SA(1, 1), a1 + hstep, voffA);
            PG8_WAIT_V(8); PG8_WAIT_L(0); PG8_BAR; PG8_MMA(0, 0, At, B0); PG8_MMA(0, 1, At, B1); PG8_BAR; PG8_SCHED;
            PG8_LDA(At, 0, 1); PG8_STAGE(PG8_SB(0, 0), b2, voffB); PG8_STAGE(PG8_SB(0, 1), b2 + hstep, voffB); PG8_STAGE(PG8_SA(0, 0), a2, voffA);
            PG8_WAIT_V(8); PG8_WAIT_L(0); PG8_BAR; PG8_MMA(1, 0, At, B0); PG8_MMA(1, 1, At, B1); PG8_BAR; PG8_SCHED;
            PG8_LDB(B0, 1, 0); PG8_LDB(B1, 1, 1); PG8_SCHED; PG8_LDA(At, 1, 0); PG8_STAGE(PG8_SA(0, 1), a2 + hstep, voffA);
            PG8_WAIT_V(8); PG8_WAIT_L(0); PG8_BAR; PG8_MMA(0, 0, At, B0); PG8_MMA(0, 1, At, B1); PG8_BAR; PG8_SCHED;
            PG8_LDA(At, 1, 1); PG8_STAGE(PG8_SB(1, 0), b3, voffB); PG8_STAGE(PG8_SB(1, 1), b3 + hstep, voffB); PG8_STAGE(PG8_SA(1, 0), a3, voffA);
            PG8_WAIT_V(8); PG8_WAIT_L(0); PG8_BAR; PG8_MMA(1, 0, At, B0); PG8_MMA(1, 1, At, B1); PG8_BAR; PG8_SCHED;
            } else {
            PG8_LDB(B0, 0, 0); PG8_SCHED; PG8_LDA(At, 0, 0); PG8_STAGE(PG8_SA(1, 1), a1 + hstep, voffA);
            PG8_WAIT_L(8); PG8_BAR; PG8_WAIT_L(0); PG8_MMA(0, 0, At, B0); PG8_BAR; PG8_SCHED;
            PG8_LDB(B1, 0, 1); PG8_STAGE(PG8_SB(0, 0), b2, voffB);
            PG8_BAR; PG8_WAIT_L(0); PG8_MMA(0, 1, At, B1); PG8_BAR;
            PG8_LDA(At, 0, 1); PG8_STAGE(PG8_SA(0, 0), a2, voffA);
            PG8_BAR; PG8_WAIT_L(0); PG8_MMA(1, 0, At, B0); PG8_BAR; PG8_SCHED;
            PG8_STAGE(PG8_SB(0, 1), b2 + hstep, voffB);
            PG8_WAIT_V(6); PG8_BAR; PG8_MMA(1, 1, At, B1); PG8_BAR;
            PG8_LDB(B0, 1, 0); PG8_SCHED; PG8_LDA(At, 1, 0); PG8_STAGE(PG8_SA(0, 1), a2 + hstep, voffA);
            PG8_WAIT_L(8); PG8_BAR; PG8_WAIT_L(0); PG8_MMA(0, 0, At, B0); PG8_BAR; PG8_SCHED;
            PG8_LDB(B1, 1, 1); PG8_STAGE(PG8_SB(1, 0), b3, voffB);
            PG8_BAR; PG8_WAIT_L(0); PG8_MMA(0, 1, At, B1); PG8_BAR;
            PG8_LDA(At, 1, 1); PG8_STAGE(PG8_SA(1, 0), a3, voffA);
            PG8_BAR; PG8_WAIT_L(0); PG8_MMA(1, 0, At, B0); PG8_BAR; PG8_SCHED;
            PG8_STAGE(PG8_SB(1, 1), b3 + hstep, voffB);
            PG8_WAIT_V(6); PG8_BAR; PG8_MMA(1, 1, At, B1); PG8_BAR;
            }
        }
        if constexpr (ALIGN_EPI) { if (wr == 0) PG8_BAR; }
        if constexpr (!Epi::AFTER_DRAIN) { unsigned ln_e; asm volatile("v_mbcnt_lo_u32_b32 %0, -1, 0\n\tv_mbcnt_hi_u32_b32 %0, -1, %0" : "=v"(ln_e)); const int fr_e = (int)(ln_e & 15u), fq_e = (int)(ln_e >> 4);
            E(acc, cur, wr, wc, fr_e, fq_e);
#ifdef PG8_EPI_TWICE
            if constexpr (Epi::TWICE_OK) { asm volatile("" ::: "memory"); E(acc, cur, wr, wc, fr, fq); }
#endif
            S.done(cur); }
        if (!has_next) break;
        if constexpr (Epi::CARRY) {
            unsigned ln_c; asm volatile("v_mbcnt_lo_u32_b32 %0, -1, 0\n\tv_mbcnt_hi_u32_b32 %0, -1, %0" : "=v"(ln_c)); E.carry(acc, cur, wr, wc, (int)(ln_c & 15u), (int)(ln_c >> 4));
        } else {
#pragma unroll
        for (int a = 0; a < 2; ++a)
#pragma unroll
            for (int b = 0; b < 2; ++b)
#pragma unroll
                for (int m = 0; m < 4; ++m)
#pragma unroll
                    for (int n = 0; n < 2; ++n) acc[a][b][m][n] = (f32x4){0.f, 0.f, 0.f, 0.f};
        }
        cur = nxt; cA = nA; cB = nB; ++ui;
        if constexpr (ALIGN_EPI) { if (wr == 1) PG8_BAR; }
    }
    PG8_WAIT_V(0);
    if constexpr (!ALIGN_EPI) { if (wr == 0) PG8_BAR; }
    PG8_BAR;
    if constexpr (Epi::AFTER_DRAIN) { E.fused(acc, cur, wr, wc, fr, fq, lds, wid, lane); S.done(cur); }
#undef PG8_SA
#undef PG8_SB
#undef PG8_STAGE
#undef PG8_LDA
#undef PG8_LDB
#undef PG8_MMA
#undef PG8_WAIT_V
#undef PG8_WAIT_L
#undef PG8_BAR
#undef PG8_SCHED
}
}


constexpr int NWAVES = 8;
constexpr int DM = 1024, BATCH = 16, SEQ = 2048, MTOK = BATCH * SEQ, HB = 8, MH = HB * SEQ, DFF = 2816, NGU = 2 * DFF, NIN = 6144, DEPTH = 2, KUP = 1152  ;
constexpr int NFOX = 6, NSB = 5, NDSA = 5;
constexpr int C_QA = 0, C_KA = 384, C_VA = 768, C_QB = 1152, C_KB = 1472, C_VB = 1792, C_QC = 2112, C_CKV = 2432, C_QI = 2560, C_GATE = 3072;
constexpr int F_KI = 0, F_FA = 64, F_WI = 70;
constexpr float EPS = 1e-6f;

constexpr size_t MiB = 1u << 20;
constexpr size_t WS_CTL = 0, CTL_ZERO_BYTES = 1 * MiB;
constexpr size_t WS_WGU1 = 2 * MiB, WS_WD1 = 13 * MiB, WS_WIN = 19 * MiB, WS_WUP = 31 * MiB, WS_WOUT = 34 * MiB, WS_WGU2 = 36 * MiB, WS_WD2 = 47 * MiB;
constexpr size_t WS_XB = 54 * MiB;
constexpr size_t WS_SSQ = 118 * MiB;
constexpr int PLD = 3072;
constexpr size_t WS_GI = 216 * MiB;
constexpr size_t WS_P = 120 * MiB;
constexpr size_t WS_HFF = 120 * MiB;
constexpr size_t WS_PF = 312 * MiB;
constexpr size_t WS_Y = 328 * MiB;
constexpr size_t WS_KAI = 364 * MiB, WS_KBI = 376 * MiB;
constexpr size_t WS_MGB = 428 * MiB;
constexpr size_t WS_KC = 460 * MiB, WS_VC = 462 * MiB, WS_KI = 464 * MiB;
constexpr size_t WS_CF = 466 * MiB;
constexpr size_t WS_VTA = 468 * MiB, WS_VTB = 481 * MiB, WS_VTC = 492 * MiB;
constexpr size_t WS_END = 494 * MiB;
constexpr size_t WS_SINK = 960 * 1024;
constexpr int CW_BAR = 4096;
constexpr int MAX_LAUNCHES = 60;

constexpr int RING_OFF = 0, RING_BYTES = 131072;
constexpr int LDSCTL_OFF = RING_BYTES, MISC_OFF = LDSCTL_OFF + 320;
constexpr int VCT_OFF = 132096;
constexpr int RST_OFF = 132096;
constexpr int LDS_BYTES = 147456;

#define GAS __attribute__((address_space(1)))
#define LAS __attribute__((address_space(3)))
typedef unsigned short bf16;
typedef unsigned v4u __attribute__((ext_vector_type(4)));
typedef float f32x4 __attribute__((ext_vector_type(4)));
typedef short bf16x8 __attribute__((ext_vector_type(8)));
typedef GAS unsigned gu32;
typedef GAS unsigned long long gu64;
#define RLX_AGENT __ATOMIC_RELAXED, __HIP_MEMORY_SCOPE_AGENT
#define LDS_WAIT() asm volatile("s_waitcnt lgkmcnt(0)" ::: "memory")
#define VM_WAIT() asm volatile("s_waitcnt vmcnt(0)" ::: "memory")
__device__ __forceinline__ unsigned long long rt() { return __builtin_amdgcn_s_memrealtime(); }
__device__ __forceinline__ unsigned f2bf(float f) { unsigned u = __builtin_bit_cast(unsigned, f); return (u + 0x7fffu + ((u >> 16) & 1u)) >> 16; }
__device__ __forceinline__ unsigned pk2(float lo, float hi) { return f2bf(lo) | (f2bf(hi) << 16); }

#define XB_TMO      128
#define XB_XCNT(j)  (256  + 64 * (j))
#define XB_XSUB(j)  (1280 + 64 * (j))
#define XB_XGEN(j)  (2304 + 64 * (j))
#define XB_TOP      3328
#define XB_TOPGEN   3392
#define XCD_BAR_WORDS 3456
#define XB_SPIN_CAP (1u << 18)

__device__ __forceinline__ unsigned xb_ld(unsigned* p)              { return __hip_atomic_load(p, __ATOMIC_RELAXED, __HIP_MEMORY_SCOPE_AGENT); }
__device__ __forceinline__ unsigned xb_add(unsigned* p, unsigned v) { return __hip_atomic_fetch_add(p, v, __ATOMIC_RELAXED, __HIP_MEMORY_SCOPE_AGENT); }
__device__ __forceinline__ unsigned xb_xcc_id() { return (unsigned)__builtin_amdgcn_s_getreg((3 << 11) | 20) & 0xFu; }
#define XB_SPIN(cond, bar) do { unsigned _sp = 0; while (cond) { __builtin_amdgcn_s_sleep(1); \
    if ((++_sp & 255u) == 0u) { if (xb_ld(&(bar)[XB_TMO])) break; if (_sp > XB_SPIN_CAP) { atomicAdd(&(bar)[XB_TMO], 1u); break; } } } } while (0)

struct XcdBarrier {
    unsigned* bar; unsigned x;
    volatile LAS unsigned* st;
};

__device__ __forceinline__ XcdBarrier xcd_barrier_post(unsigned* bar, volatile LAS unsigned* st, bool leader_thread  ) {
    XcdBarrier b; b.bar = bar; b.x = xb_xcc_id(); b.st = st;
    if (leader_thread) (void)xb_add(&bar[XB_XCNT(b.x)], 1u);
    return b;
}
__device__ __forceinline__ void xcd_barrier_complete(unsigned* bar, unsigned x, unsigned& nloc, unsigned& nx) {
    const unsigned G = gridDim.x * gridDim.y * gridDim.z;
    unsigned sum, cnt, mine, sp = 0u;
    for (;;) {
        sum = 0u; cnt = 0u; mine = 0u;
#pragma unroll
        for (unsigned j = 0; j < 16; ++j) { const unsigned c = xb_ld(&bar[XB_XCNT(j)]); sum += c; cnt += (c > 0u) ? 1u : 0u; mine = (j == x) ? c : mine; }
        if (sum == G) break;
        __builtin_amdgcn_s_sleep(1);
        if ((++sp & 255u) == 0u) { if (xb_ld(&bar[XB_TMO])) break; if (sp > XB_SPIN_CAP) { atomicAdd(&bar[XB_TMO], 1u); break; } }
    }
    nloc = mine > 0u ? mine : 1u; nx = cnt > 0u ? cnt : 1u;
}

__device__ __forceinline__ void xcd_barrier(const XcdBarrier& b, bool leader_thread  ) {
    asm volatile("s_waitcnt vmcnt(0)" ::: "memory");
    __syncthreads();
    if (leader_thread) {
        unsigned* bar = b.bar; unsigned bx_ = b.x; asm volatile("" : "+s"(bar), "+s"(bx_));
        __builtin_amdgcn_s_waitcnt(0);
        unsigned nloc = b.st[0], nx = b.st[1];
        if (nloc == 0u) { xcd_barrier_complete(bar, bx_, nloc, nx); b.st[0] = nloc; b.st[1] = nx; }
        const unsigned old = xb_add(&bar[XB_XSUB(bx_)], 1u);
        const unsigned gen = old / nloc;
        if (old + 1u == (gen + 1u) * nloc) {
            __builtin_amdgcn_fence(__ATOMIC_RELEASE, "agent");
            asm volatile("s_waitcnt vmcnt(0)" ::: "memory");
            const unsigned og = xb_add(&bar[XB_TOP], 1u);
            const unsigned tg = og / nx;
            if (og + 1u == (tg + 1u) * nx) xb_add(&bar[XB_TOPGEN], 1u);
            else XB_SPIN(xb_ld(&bar[XB_TOPGEN]) == tg, bar);
            __builtin_amdgcn_fence(__ATOMIC_ACQUIRE, "agent");
            xb_add(&bar[XB_XGEN(bx_)], 1u);
            asm volatile("s_waitcnt vmcnt(0)" ::: "memory");
        } else {
            XB_SPIN(xb_ld(&bar[XB_XGEN(bx_)]) == gen, bar);
            __builtin_amdgcn_fence(__ATOMIC_ACQUIRE, "agent");
            asm volatile("s_waitcnt vmcnt(0)" ::: "memory");
        }
    }
    __syncthreads();
}


typedef unsigned u32x2 __attribute__((ext_vector_type(2)));
__device__ __forceinline__ float bflo(unsigned w) { return __uint_as_float(w << 16); }
__device__ __forceinline__ float bfhi(unsigned w) { return __uint_as_float(w & 0xffff0000u); }
__device__ __forceinline__ float bf2f(bf16 v) { return __uint_as_float((unsigned)v << 16); }
__device__ __forceinline__ float bperm_f(float v, int srclane) { return __int_as_float(__builtin_amdgcn_ds_bpermute(srclane << 2, __float_as_int(v))); }
__device__ __forceinline__ unsigned bperm_u(unsigned v, int srclane) { return (unsigned)__builtin_amdgcn_ds_bpermute(srclane << 2, (int)v); }
__device__ __forceinline__ float wave_sum(float v, int lane) {
#pragma unroll
    for (int o = 1; o < 64; o <<= 1) v += bperm_f(v, lane ^ o);
    return v;
}
__device__ __forceinline__ float xhalf_max(float v) { auto rr = __builtin_amdgcn_permlane32_swap(__float_as_uint(v), __float_as_uint(v), false, false); return fmaxf(__uint_as_float(rr[0]), __uint_as_float(rr[1])); }
__device__ __forceinline__ float xhalf_sum(float v) { auto rr = __builtin_amdgcn_permlane32_swap(__float_as_uint(v), __float_as_uint(v), false, false); return __uint_as_float(rr[0]) + __uint_as_float(rr[1]); }
__device__ __forceinline__ unsigned xhalf_sum_u(unsigned v) { auto rr = __builtin_amdgcn_permlane32_swap(v, v, false, false); return rr[0] + rr[1]; }
__device__ __forceinline__ float xhalf_other(float v, int hh) { auto rr = __builtin_amdgcn_permlane32_swap(__float_as_uint(v), __float_as_uint(v), false, false); return __uint_as_float(hh ? rr[0] : rr[1]); }
__device__ __forceinline__ void rope_cs(int pos, int i, float& c, float& s) {
    const float cf = i == 0 ? 0.15915494309189535f : i == 1 ? 0.03086376340470123f : i == 2 ? 0.005985185712713705f : i == 3 ? 0.001160663641240061f
                   : i == 4 ? 0.00022507907903927653f : i == 5 ? 4.364795279280289e-05f : i == 6 ? 8.464330808241401e-06f : 1.6414262627950345e-06f;
    const float hi = __uint_as_float(__float_as_uint(cf) & 0xfffff000u), lo = cf - hi;
    const float p = (float)pos; const float a = p * hi; float r = a - floorf(a); r += p * lo;
    s = __builtin_amdgcn_sinf(r); c = __builtin_amdgcn_cosf(r);
}

template <int MODE> __device__ __forceinline__ int colmap(int n) {
    if (MODE == 0) return n;
    if (MODE == 1) { const int t = n >> 8, r = n & 255; return r < 128 ? t * 128 + r : DFF + t * 128 + (r - 128); }
    if (n < 1152) return n;
    if (n < 2880) return n + 6;
    if (n < 2886) return n - 2880 + 1152;
    if (n < 2890) return n;
    if (n < 3072) return -1;
    return n - 182;
}
template <int MODE> __device__ __forceinline__ float colscale(int n) {
    if (MODE != 2) return 1.0f;
    if (n < 384 || (n >= 2112 && n < 2432)) return 0.125f * 1.4426950408889634f;
    if (n >= 1152 && n < 1472) return 0.125f;
    return 1.0f;
}
template <int MODE> __device__ __forceinline__ void conv_job(const float* W, int Nsrc, int Ksrc, const float* gain, bf16* WT, int Ndst, int Kdst, LAS float* scr, int gw, int ngw, int lane, int& coff, int ldd = 0) {
    if (ldd == 0) ldd = Kdst;
    const int nblk = Ndst / 32, nitems = (Kdst / 64) * nblk;
    int it0 = gw - coff; if (it0 < 0) it0 += ngw;
    coff = (coff + nitems) % ngw;
    for (int it = it0; it < nitems; it += ngw) {
        const int kb = it / nblk, nb = it % nblk, k0 = 64 * kb, n0 = 32 * nb;
        const int sc = colmap<MODE>(n0 + (lane & 31));
        float wv_[32];
#pragma unroll
        for (int i = 0; i < 32; ++i) { const int k = k0 + 2 * i + (lane >> 5); wv_[i] = (sc >= 0 && k < Ksrc) ? W[(size_t)k * Nsrc + sc] : 0.f; }
        if (gain) {
#pragma unroll
            for (int i = 0; i < 32; ++i) { const int k = k0 + 2 * i + (lane >> 5); wv_[i] *= k < Ksrc ? gain[k] : 0.f; } }
        if (MODE == 2) { const float cs = colscale<MODE>(n0 + (lane & 31));
#pragma unroll
            for (int i = 0; i < 32; ++i) wv_[i] *= cs; }
#pragma unroll
        for (int i = 0; i < 32; ++i) scr[(2 * i + (lane >> 5)) * 33 + (lane & 31)] = wv_[i];
        LDS_WAIT(); asm volatile("" ::: "memory");
        const int c = lane & 7;
#pragma unroll
        for (int j = 0; j < 4; ++j) { const int n = (lane >> 3) + 8 * j; const LAS float* s = scr + (8 * c) * 33 + n;
            v4u o; o.x = pk2(s[0 * 33], s[1 * 33]); o.y = pk2(s[2 * 33], s[3 * 33]); o.z = pk2(s[4 * 33], s[5 * 33]); o.w = pk2(s[6 * 33], s[7 * 33]);
            *(GAS v4u*)(WT + (size_t)(n0 + n) * ldd + k0 + 8 * c) = o; }
        LDS_WAIT(); asm volatile("" ::: "memory");
    }
}


typedef short bf16x8 __attribute__((ext_vector_type(8)));
typedef float f32x16 __attribute__((ext_vector_type(16)));
typedef float f32x2_t __attribute__((ext_vector_type(2))); typedef __bf16 bf16x2_t __attribute__((ext_vector_type(2)));
__device__ __forceinline__ unsigned cvtpk(float lo, float hi) { f32x2_t v = {lo, hi}; bf16x2_t b = __builtin_convertvector(v, bf16x2_t); return __builtin_bit_cast(unsigned, b); }
#define MFMA32(a, b, c) __builtin_amdgcn_mfma_f32_32x32x16_bf16((a), (b), (c), 0, 0, 0)
__device__ __forceinline__ int crow(int i, int hh) { return (i & 3) + 8 * (i >> 2) + 4 * hh; }
__device__ __forceinline__ bf16x8 ldg16(const bf16* p) { return *(const GAS bf16x8*)p; }
__device__ __forceinline__ bf16x8 pack8(const f32x16& x, int s) {
    v4u p; p.x = cvtpk(x[8 * s + 0], x[8 * s + 1]); p.y = cvtpk(x[8 * s + 2], x[8 * s + 3]); p.z = cvtpk(x[8 * s + 4], x[8 * s + 5]); p.w = cvtpk(x[8 * s + 6], x[8 * s + 7]);
    return __builtin_bit_cast(bf16x8, p);
}
__device__ __forceinline__ void store_ot(bf16* yrow, const f32x16 (&o)[2], float scale, int hh) {
#pragma unroll
    for (int dt = 0; dt < 2; ++dt)
#pragma unroll
        for (int gp = 0; gp < 2; ++gp) {
            unsigned a0 = cvtpk(o[dt][8 * gp + 0] * scale, o[dt][8 * gp + 1] * scale), a1 = cvtpk(o[dt][8 * gp + 2] * scale, o[dt][8 * gp + 3] * scale);
            unsigned b0 = cvtpk(o[dt][8 * gp + 4] * scale, o[dt][8 * gp + 5] * scale), b1 = cvtpk(o[dt][8 * gp + 6] * scale, o[dt][8 * gp + 7] * scale);
            auto r0 = __builtin_amdgcn_permlane32_swap(a0, b0, false, false); auto r1 = __builtin_amdgcn_permlane32_swap(a1, b1, false, false);
            v4u w; w.x = r0[0]; w.y = r1[0]; w.z = r0[1]; w.w = r1[1];
            *(GAS v4u*)(yrow + 32 * dt + 16 * gp + 8 * hh) = w; }
}
constexpr float LOG2E = 1.4426950408889634f, LN2 = 0.6931471805599453f;

#define FOX_LOAD(KF, VF, kt_) do { _Pragma("unroll") for (int s_ = 0; s_ < 4; ++s_) KF[s_] = ldg16(kb + (size_t)2048 * (kt_) + 512 * s_); \
    _Pragma("unroll") for (int d_ = 0; d_ < 2; ++d_) _Pragma("unroll") for (int s_ = 0; s_ < 2; ++s_) VF[d_][s_] = ldg16(vb + (size_t)2048 * (kt_) + 512 * (2 * d_ + s_)); } while (0)
#define FOX_REF 24.0f
#define FOX_STEP(KF, VF, NKF, NVF, kt_) do { \
    { const int kn_ = (kt_) + 2 <= qs ? (kt_) + 2 : qs; FOX_LOAD(NKF, NVF, kn_); } \
    f32x4 cf_[4]; _Pragma("unroll") for (int g_ = 0; g_ < 4; ++g_) cf_[g_] = *(const LAS f32x4*)(cfL + 32 * (kt_) + 8 * g_ + 4 * hh); \
    f32x16 sacc; _Pragma("unroll") for (int i = 0; i < 16; ++i) sacc[i] = cf_[i >> 2][i & 3] - rt;        \
    _Pragma("unroll") for (int s_ = 0; s_ < 4; ++s_) sacc = MFMA32(KF[s_], qf[s_], sacc); \
    if ((kt_) == qs) { _Pragma("unroll") for (int i = 0; i < 16; ++i) { float p = __builtin_amdgcn_exp2f(sacc[i]); if (crow(i, hh) > r) p = 0.f; sacc[i] = p; l += p; } } \
    else { _Pragma("unroll") for (int i = 0; i < 16; ++i) { const float p = __builtin_amdgcn_exp2f(sacc[i]); sacc[i] = p; l += p; } } \
    const bf16x8 p0 = pack8(sacc, 0), p1 = pack8(sacc, 1); \
    _Pragma("unroll") for (int d_ = 0; d_ < 2; ++d_) { o[d_] = MFMA32(VF[d_][0], p0, o[d_]); o[d_] = MFMA32(VF[d_][1], p1, o[d_]); } } while (0)
__device__ __forceinline__ void fox_strip(const bf16* P, const bf16* KAI, const LAS float* cfL, const bf16* VTA, bf16* YA, int b, int h, int qs, int lane) {
    const int r = lane & 31, hh = lane >> 5;
    const size_t rowq = (size_t)b * SEQ + qs * 32 + r;
    bf16x8 qf[4];
#pragma unroll
    for (int s = 0; s < 4; ++s) qf[s] = ldg16(P + rowq * PLD + C_QA + h * 64 + 16 * s + 8 * hh);
    const float rt = cfL[qs * 32 + r] + FOX_REF;
    const bf16* kb = KAI + (size_t)(b * NFOX + h) * 64 * SEQ + 8 * lane;
    const bf16* vb = VTA + (size_t)(b * NFOX + h) * 64 * SEQ + 8 * lane;
    f32x16 o[2]; o[0] = f32x16{}; o[1] = f32x16{};
    float l = 0.f;
    bf16x8 kA[4], vA[2][2], kB[4], vB[2][2], kC[4], vC[2][2];
    FOX_LOAD(kA, vA, 0); { const int k1 = qs >= 1 ? 1 : 0; FOX_LOAD(kB, vB, k1); }
    for (int kt = 0; kt <= qs; kt += 3) {
        FOX_STEP(kA, vA, kC, vC, kt);
        if (kt + 1 > qs) break;
        FOX_STEP(kB, vB, kA, vA, kt + 1);
        if (kt + 2 > qs) break;
        FOX_STEP(kC, vC, kB, vB, kt + 2);
    }
    l = xhalf_sum(l);
    store_ot(YA + rowq * KUP + h * 64, o, 1.0f / l, hh);
}

__device__ __forceinline__ void sb_strip(const bf16* P, const bf16* KBI, const bf16* VTB, bf16* YB, int b, int h, int qs, int lane) {
    const int r = lane & 31, hh = lane >> 5;
    const size_t rowq = (size_t)b * SEQ + qs * 32 + r;
    bf16x8 qf[4];
#pragma unroll
    for (int s = 0; s < 4; ++s) qf[s] = ldg16(P + rowq * PLD + C_QB + h * 64 + 16 * s + 8 * hh);
    const bf16* kb = KBI + (size_t)(b * NSB + h) * 64 * SEQ + 8 * lane;
    const bf16* vb = VTB + (size_t)(b * NSB + h) * 64 * SEQ + 8 * lane;
    f32x16 o[2]; o[0] = f32x16{}; o[1] = f32x16{};
    float R = 0.f;
    bf16x8 kf[4], vf[2][2];
#pragma unroll
    for (int s = 0; s < 4; ++s) kf[s] = ldg16(kb + (size_t)2048 * qs + 512 * s);
#pragma unroll
    for (int dt = 0; dt < 2; ++dt)
#pragma unroll
        for (int s = 0; s < 2; ++s) vf[dt][s] = ldg16(vb + (size_t)2048 * qs + 512 * (2 * dt + s));
    asm volatile("" ::: "memory");
    for (int kt = qs; kt >= 0; --kt) {
        bf16x8 nk[4], nv[2][2];
        const int kn = kt > 0 ? kt - 1 : 0;
#pragma unroll
        for (int s = 0; s < 4; ++s) nk[s] = ldg16(kb + (size_t)2048 * kn + 512 * s);
#pragma unroll
        for (int dt = 0; dt < 2; ++dt)
#pragma unroll
            for (int s = 0; s < 2; ++s) nv[dt][s] = ldg16(vb + (size_t)2048 * kn + 512 * (2 * dt + s));
        asm volatile("" ::: "memory");
        f32x16 z = f32x16{};
#pragma unroll
        for (int s = 0; s < 4; ++s) z = MFMA32(kf[s], qf[s], z);
        f32x16 sp;
#pragma unroll
        for (int i = 0; i < 16; ++i) { const float zz = z[i]; const float e = __builtin_amdgcn_exp2f(-fabsf(zz) * LOG2E); float s_ = fmaxf(zz, 0.f) + LN2 * __builtin_amdgcn_logf(1.0f + e);
            const bool valid = (kt < qs) || (crow(i, hh) < r); sp[i] = valid ? s_ : 0.f; z[i] = valid ? zz - s_ : -INFINITY; }
        float tg[4], tp[4];
#pragma unroll
        for (int g = 0; g < 4; ++g) { tg[g] = (sp[4 * g] + sp[4 * g + 1]) + (sp[4 * g + 2] + sp[4 * g + 3]); tp[g] = xhalf_other(tg[g], hh); }
        float above = R;
#pragma unroll
        for (int g = 3; g >= 0; --g) {
            const float ab = above + (hh == 0 ? tp[g] : 0.f);
            const float w3 = ab, w2 = w3 + sp[4 * g + 3], w1 = w2 + sp[4 * g + 2], w0 = w1 + sp[4 * g + 1];
            z[4 * g + 3] = __builtin_amdgcn_exp2f((z[4 * g + 3] - w3) * LOG2E); z[4 * g + 2] = __builtin_amdgcn_exp2f((z[4 * g + 2] - w2) * LOG2E);
            z[4 * g + 1] = __builtin_amdgcn_exp2f((z[4 * g + 1] - w1) * LOG2E); z[4 * g + 0] = __builtin_amdgcn_exp2f((z[4 * g + 0] - w0) * LOG2E);
            above += tg[g] + tp[g];
        }
        R = above;
        const bf16x8 p0 = pack8(z, 0), p1 = pack8(z, 1);
#pragma unroll
        for (int dt = 0; dt < 2; ++dt) { o[dt] = MFMA32(vf[dt][0], p0, o[dt]); o[dt] = MFMA32(vf[dt][1], p1, o[dt]); }
        if (__all(R > 104.0f)) break;
#pragma unroll
        for (int s = 0; s < 4; ++s) kf[s] = nk[s];
#pragma unroll
        for (int dt = 0; dt < 2; ++dt)
#pragma unroll
            for (int s = 0; s < 2; ++s) vf[dt][s] = nv[dt][s];
    }
    store_ot(YB + rowq * KUP + h * 64, o, 1.0f, hh);
}

template <int NH> __device__ __forceinline__ void dsa_attend(f32x16 (&o)[NH][2], float (&m)[NH], float (&l)[NH], const bf16* kcb, const bf16* vtb, const LAS unsigned char* qcl, int hbase,
                                                              const unsigned (&selm)[4], int ntiles, int wave) {
    const float SC = 0.125f * LOG2E;
#pragma unroll
    for (int h = 0; h < NH; ++h) { o[h][0] = f32x16{}; o[h][1] = f32x16{}; m[h] = 0.f; l[h] = 0.f; }
#define DSA_LOADKV(KF, VF, j_) do { _Pragma("unroll") for (int s_ = 0; s_ < 4; ++s_) KF[s_] = ldg16(kcb + (size_t)2048 * (j_) + 512 * s_); \
    _Pragma("unroll") for (int d_ = 0; d_ < 2; ++d_) _Pragma("unroll") for (int s_ = 0; s_ < 2; ++s_) VF[d_][s_] = ldg16(vtb + (size_t)2048 * (j_) + 512 * (2 * d_ + s_)); } while (0)
    bf16x8 kc[4], vt[2][2];
    if (wave < ntiles) DSA_LOADKV(kc, vt, wave);
    asm volatile("" ::: "memory");
    __builtin_amdgcn_s_waitcnt(0x0F70);
#pragma unroll 1
    for (int sl = 0; sl < 8; ++sl) {
        const int j = sl * 8 + wave;
        if (j < ntiles) {
            const int jn = j + 8 < ntiles ? j + 8 : j;
            const unsigned sw = sl < 2 ? selm[0] : sl < 4 ? selm[1] : sl < 6 ? selm[2] : selm[3];
            const unsigned bits = sw >> ((sl & 1) * 16);
            f32x16 minit;
#pragma unroll
            for (int i = 0; i < 16; ++i) minit[i] = ((bits >> i) & 1u) ? -FOX_REF : -INFINITY;
            f32x16 sa[NH];
#pragma unroll
            for (int h = 0; h < NH; ++h) { sa[h] = minit;
#pragma unroll
                for (int s = 0; s < 4; ++s) sa[h] = MFMA32(kc[s], *(const LAS bf16x8*)(qcl + ((hbase + h) * 64 + 16 * s) * 2), sa[h]); }
            asm volatile("" ::: "memory");
#pragma unroll
            for (int s_ = 0; s_ < 4; ++s_) kc[s_] = ldg16(kcb + (size_t)2048 * jn + 512 * s_);
            asm volatile("" ::: "memory");
#pragma unroll
            for (int i = 0; i < 16; ++i)
#pragma unroll
                for (int h = 0; h < NH; ++h) { const float p = __builtin_amdgcn_exp2f(sa[h][i]); sa[h][i] = p; l[h] += p; }
#pragma unroll
            for (int h = 0; h < NH; ++h) { const bf16x8 p0 = pack8(sa[h], 0), p1 = pack8(sa[h], 1);
#pragma unroll
                for (int dt = 0; dt < 2; ++dt) { o[h][dt] = MFMA32(vt[dt][0], p0, o[h][dt]); o[h][dt] = MFMA32(vt[dt][1], p1, o[h][dt]); } }
            asm volatile("" ::: "memory");
#pragma unroll
            for (int d_ = 0; d_ < 2; ++d_)
#pragma unroll
                for (int s_ = 0; s_ < 2; ++s_) vt[d_][s_] = ldg16(vtb + (size_t)2048 * jn + 512 * (2 * d_ + s_));
            asm volatile("" ::: "memory");
        }
    }
#undef DSA_LOADKV
#pragma unroll
    for (int h = 0; h < NH; ++h) l[h] = xhalf_sum(l[h]);
}
__device__ __forceinline__ void dsa_combine(const f32x16 (&o)[2], float m, float l, LAS float* Ml, LAS float* Ob, bf16* yq, int h5, int wave, int lane) {
    const int r = lane & 31, hh = lane >> 5;
    if (lane < 32) { Ml[(wave * 2 + 0) * 32 + r] = m; Ml[(wave * 2 + 1) * 32 + r] = l; }
#pragma unroll
    for (int dt = 0; dt < 2; ++dt)
#pragma unroll
        for (int i = 0; i < 16; ++i) Ob[(wave * 64 + 32 * dt + crow(i, hh)) * 32 + r] = o[dt][i];
    __syncthreads();
    {
        float ls = 0.f, acc4[4] = {0.f, 0.f, 0.f, 0.f};
#pragma unroll
        for (int w = 0; w < 8; ++w) { ls += Ml[(w * 2 + 1) * 32 + r];
#pragma unroll
            for (int e = 0; e < 4; ++e) acc4[e] += Ob[(w * 64 + 8 * wave + 4 * hh + e) * 32 + r]; }
        const float il = 1.0f / ls;
        u32x2 wv; wv.x = cvtpk(acc4[0] * il, acc4[1] * il); wv.y = cvtpk(acc4[2] * il, acc4[3] * il);
        *(GAS u32x2*)(yq + h5 * 64 + 8 * wave + 4 * hh) = wv;
    }
    __syncthreads();
}
__device__ __forceinline__ unsigned wg_sum32(unsigned c, LAS unsigned* cnt, int& seq, int wave, int r, int lane) {
    c = xhalf_sum_u(c);
    const int buf = seq & 1; ++seq;
    if (lane < 32) cnt[(buf * 8 + wave) * 32 + r] = c;
    __syncthreads();
    unsigned t = 0;
#pragma unroll
    for (int w = 0; w < 8; ++w) t += cnt[(buf * 8 + w) * 32 + r];
    return t;
}
__device__ __forceinline__ void dsa_unit(const bf16* P, const float* Pf, const bf16* KI, const bf16* KC, const bf16* VTC, bf16* YC, int b, int g, int wave, int lane, LAS unsigned char* lds) {
    asm volatile("" : "+v"(lane), "+s"(wave));
    const int r = lane & 31, hh = lane >> 5;
    const int N = 64 * (g / 2 + 1), ntiles = N / 32;
    const size_t rowq = (size_t)b * SEQ + 32 * g + r;
    LAS unsigned* cnt = (LAS unsigned*)lds; LAS float* Ml = (LAS float*)(lds + 2048); LAS float* Ob = (LAS float*)(lds + 4096);
    LAS unsigned char* QiL = lds + 69632;
    LAS unsigned char* QcL = lds + 86528;
    int seq = 0;
    {
        const int t = wave * 64 + lane;
        v4u qs_[5];
#pragma unroll
        for (int i = 0; i < 2; ++i) { const int c = t + 512 * i, row = c >> 5, ch = c & 31; qs_[i] = *(const GAS v4u*)(P + ((size_t)b * SEQ + 32 * g + row) * PLD + C_QI + 8 * ch); }
#pragma unroll
        for (int i = 0; i < 3; ++i) { const int c = t + 512 * i < 32 * 40 ? t + 512 * i : 0; const int row = c / 40, ch = c % 40; qs_[2 + i] = *(const GAS v4u*)(P + ((size_t)b * SEQ + 32 * g + row) * PLD + C_QC + 8 * ch); }
#pragma unroll
        for (int i = 0; i < 2; ++i) { const int c = t + 512 * i, row = c >> 5, ch = c & 31; *(LAS v4u*)(QiL + row * 528 + ch * 16) = qs_[i]; }
#pragma unroll
        for (int i = 0; i < 3; ++i) { const int c = t + 512 * i; if (c < 32 * 40) { const int row = c / 40, ch = c % 40; *(LAS v4u*)(QcL + row * 656 + ch * 16) = qs_[2 + i]; } }
    }
    const float w0 = Pf[rowq * 256 + F_WI + 0], w1 = Pf[rowq * 256 + F_WI + 1], w2 = Pf[rowq * 256 + F_WI + 2], w3 = Pf[rowq * 256 + F_WI + 3];
    __syncthreads();
    unsigned key[8][16];
    const bf16* kib = KI + (size_t)b * SEQ * 64 + 8 * lane;
    bf16x8 kf[4];
    if (wave < ntiles) {
#pragma unroll
        for (int s = 0; s < 4; ++s) kf[s] = ldg16(kib + (size_t)2048 * wave + 512 * s); }
    asm volatile("" ::: "memory");
    __builtin_amdgcn_s_waitcnt(0x0F70);
#pragma unroll
    for (int sl = 0; sl < 8; ++sl) {
        const int j = sl * 8 + wave;
        if (j < ntiles) {
            bf16x8 kn[4];
            { const int jn = j + 8 < ntiles ? j + 8 : j;
#pragma unroll
              for (int s = 0; s < 4; ++s) kn[s] = ldg16(kib + (size_t)2048 * jn + 512 * s); }
            asm volatile("" ::: "memory");
            float sc[16];
#pragma unroll
            for (int hp = 0; hp < 2; ++hp) {
                f32x16 accA = f32x16{}, accB = f32x16{};
#pragma unroll
                for (int s = 0; s < 4; ++s) { accA = MFMA32(kf[s], *(const LAS bf16x8*)(QiL + r * 528 + ((2 * hp) * 64 + 16 * s + 8 * hh) * 2), accA);
                                              accB = MFMA32(kf[s], *(const LAS bf16x8*)(QiL + r * 528 + ((2 * hp + 1) * 64 + 16 * s + 8 * hh) * 2), accB); }
                const float wA = hp == 0 ? w0 : w2, wB = hp == 0 ? w1 : w3;
#pragma unroll
                for (int i = 0; i < 16; ++i) { const float t = hp == 0 ? wA * fmaxf(accA[i], 0.f) : fmaf(wA, fmaxf(accA[i], 0.f), sc[i]); sc[i] = fmaf(wB, fmaxf(accB[i], 0.f), t); }
            }
#pragma unroll
            for (int i = 0; i < 16; ++i) { const unsigned ub = __float_as_uint(sc[i] + 0.0f); key[sl][i] = (ub & 0x80000000u) ? ~ub : (ub | 0x80000000u); }
#pragma unroll
            for (int s = 0; s < 4; ++s) kf[s] = kn[s];
        } else {
#pragma unroll
            for (int i = 0; i < 16; ++i) key[sl][i] = 0u;
        }
    }
#ifndef DSA_REP_ATT
#define DSA_REP_ATT 1
#endif
    unsigned T = 0u; bool tie = false;
    if (N > 256) {
        LAS unsigned* hist = (LAS unsigned*)(lds + 4096);
        LAS unsigned* res = (LAS unsigned*)lds;
        const int tw = wave * 64 + lane;
        if (tw < 32) res[32 + tw] = 256u;
        bool done = false; unsigned need = 256u, ceq = 0u;
#pragma unroll 1
        for (int sh = 24; sh >= 0; sh -= 8) {
            for (int i = tw; i < 32 * 257; i += 512) hist[i] = 0u;
            __syncthreads();
            if (!done) {
                LAS unsigned* hq = hist + r * 257;
#pragma unroll
                for (int sl = 0; sl < 8; ++sl) if (sl * 8 + wave < ntiles) {
#pragma unroll
                    for (int i = 0; i < 16; ++i) { const unsigned k = key[sl][i];
                        if (sh == 24 || (k >> ((sh + 8) & 31)) == (T >> ((sh + 8) & 31))) { __hip_atomic_fetch_add(hq + ((k >> sh) & 255u), 1u, __ATOMIC_RELAXED, __HIP_MEMORY_SCOPE_WORKGROUP);
#ifdef PROBE_AT2
                            __hip_atomic_fetch_add(hq + 9216 + ((k >> sh) & 255u), 1u, __ATOMIC_RELAXED, __HIP_MEMORY_SCOPE_WORKGROUP);
#endif
                        } } }
            }
            __syncthreads();
#pragma unroll
            for (int qi = 0; qi < 4; ++qi) {
                const int q = 4 * wave + qi; const LAS unsigned* hq = hist + q * 257 + 4 * lane;
                const unsigned h0 = hq[0], h1 = hq[1], h2 = hq[2], h3 = hq[3], sl_ = (h0 + h1) + (h2 + h3);
                unsigned v = sl_;
#pragma unroll
                for (int o = 1; o < 64; o <<= 1) { const unsigned n = bperm_u(v, lane + o); if (lane + o < 64) v += n; }
                const unsigned E = v - sl_, nd = res[32 + q];
                if (E < nd && nd <= E + sl_) {
                    unsigned cum = E, dg, hb;
                    if (cum + h3 >= nd) { dg = 3; hb = h3; } else { cum += h3; if (cum + h2 >= nd) { dg = 2; hb = h2; } else { cum += h2; if (cum + h1 >= nd) { dg = 1; hb = h1; } else { cum += h1; dg = 0; hb = h0; } } }
                    res[q] = (4u * lane + dg) | ((cum + hb == nd) ? 256u : 0u); res[32 + q] = nd - cum; res[64 + q] = hb;
                }
            }
            __syncthreads();
            if (!done) { const unsigned rr = res[r]; T |= (rr & 255u) << sh; need = res[32 + r]; ceq = res[64 + r]; done = (rr & 256u) != 0u; }
            if (!__any(!done)) break;
        }
        tie = !done && ceq > need;
    }
    unsigned selm[4], tm[4];
#pragma unroll
    for (int q = 0; q < 4; ++q) { selm[q] = 0u; tm[q] = 0u; }
#pragma unroll
    for (int sl = 0; sl < 8; ++sl)
#pragma unroll
        for (int i = 0; i < 16; ++i) { selm[sl >> 1] |= (key[sl][i] > T ? 1u : 0u) << ((sl & 1) * 16 + i); tm[sl >> 1] |= (key[sl][i] == T ? 1u : 0u) << ((sl & 1) * 16 + i); }
    int J = 4095;
    if (N > 256 && __any(tie)) {
        LAS unsigned* res = (LAS unsigned*)lds;
        LAS unsigned* cntL = (LAS unsigned*)(lds + 4096);
#pragma unroll
        for (int sl = 0; sl < 8; ++sl) { const unsigned c = xhalf_sum_u((unsigned)__builtin_popcount((tm[sl >> 1] >> ((sl & 1) * 16)) & 0xffffu)); if (hh == 0) cntL[r * 64 + sl * 8 + wave] = c; }
        __syncthreads();
#pragma unroll
        for (int qi = 0; qi < 4; ++qi) {
            const int q = 4 * wave + qi; const unsigned c = cntL[q * 64 + lane]; unsigned v = c;
#pragma unroll
            for (int o = 1; o < 64; o <<= 1) { const unsigned n = bperm_u(v, lane - o); if (lane >= o) v += n; }
            const unsigned nd = res[32 + q], ex = v - c;
            if (ex < nd && nd <= v) res[96 + q] = (unsigned)lane | ((nd - ex) << 8);
        }
        __syncthreads();
        const unsigned rj = res[96 + r]; const int Jt = (int)(rj & 255u), nn = (int)(rj >> 8);
        { const int st = Jt >> 3; const unsigned wsel = st < 2 ? tm[0] : st < 4 ? tm[1] : st < 6 ? tm[2] : tm[3]; const unsigned m16 = (wsel >> ((st & 1) * 16)) & 0xffffu;
          const unsigned mo = xhalf_sum_u(m16) - m16;
          const unsigned m0 = hh ? mo : m16, m1 = hh ? m16 : mo;
          unsigned rm = 0u;
#pragma unroll
          for (int g4 = 0; g4 < 4; ++g4) rm |= (((m0 >> (4 * g4)) & 15u) << (8 * g4)) | (((m1 >> (4 * g4)) & 15u) << (8 * g4 + 4));
          int p = 0;
#pragma unroll
          for (int bs = 16; bs >= 1; bs >>= 1) { if (__builtin_popcount(rm & ((1u << (p + bs)) - 1u)) < nn) p += bs; }
          if (tie && wave == (Jt & 7) && hh == 0) res[128 + r] = (unsigned)(32 * Jt + p); }
        __syncthreads();
        if (tie) J = (int)res[128 + r];
    }
    {
        const int Jt = J >> 5, Jr = J & 31; unsigned rm16 = 0u;
#pragma unroll
        for (int g4 = 0; g4 < 4; ++g4) { int n = Jr - 8 * g4 - 4 * hh + 1; n = n < 0 ? 0 : n > 4 ? 4 : n; rm16 |= ((1u << n) - 1u) << (4 * g4); }
#pragma unroll
        for (int sl = 0; sl < 8; ++sl) { const int j = sl * 8 + wave; const unsigned lm = j < Jt ? 0xffffu : j > Jt ? 0u : rm16; selm[sl >> 1] |= tm[sl >> 1] & (lm << ((sl & 1) * 16)); }
    }
    const bf16* kcb = KC + (size_t)b * SEQ * 64 + 8 * lane;
    const bf16* vtb = VTC + (size_t)b * 64 * SEQ + 8 * lane;
    const LAS unsigned char* qcl = QcL + r * 656 + 16 * hh;
    bf16* yq = YC + rowq * KUP;
    { f32x16 o[3][2]; float m[3], l[3]; dsa_attend<3>(o, m, l, kcb, vtb, qcl, 0, selm, ntiles, wave);
      dsa_combine(o[0], m[0], l[0], Ml, Ob, yq, 0, wave, lane); dsa_combine(o[1], m[1], l[1], Ml, Ob, yq, 1, wave, lane); dsa_combine(o[2], m[2], l[2], Ml, Ob, yq, 2, wave, lane); }
    { f32x16 o[2][2]; float m[2], l[2]; dsa_attend<2>(o, m, l, kcb, vtb, qcl, 3, selm, ntiles, wave);
      dsa_combine(o[0], m[0], l[0], Ml, Ob, yq, 3, wave, lane); dsa_combine(o[1], m[1], l[1], Ml, Ob, yq, 4, wave, lane); }
}


struct Args { const float* in[18]; float* out; unsigned char* ws; int ph_lo, ph_hi, li, pad; };

static_assert(pg8::EpiWin::KA0 == C_KA && pg8::EpiWin::KB0 == C_KB && pg8::EpiWin::NHA == NFOX && pg8::EpiWin::NHB == NSB && pg8::EpiWin::SEQL == SEQ && pg8::EpiWin::KAI_OFF == (long)(WS_KAI - WS_P) && pg8::EpiWin::KBI_OFF == (long)(WS_KBI - WS_P) && pg8::EpiWin::GI_OFF == (long)(WS_GI - WS_P), "EpiWin's copy of the layout constants");
__global__ void __launch_bounds__(NWAVES * 64, 2) mk_fwd(Args args) {
    extern __shared__ __attribute__((aligned(16))) unsigned char lds_raw[];
    LAS unsigned char* lds = (LAS unsigned char*)lds_raw;
    volatile LAS unsigned* MISC = (volatile LAS unsigned*)(lds + MISC_OFF);
    const int tid = threadIdx.x, lane0 = tid & 63, wave0 = __builtin_amdgcn_readfirstlane(tid >> 6);
    const int G0 = gridDim.x; const int bx0 = blockIdx.x; const int vcu = (G0 % 8 == 0) ? (bx0 % 8) * (G0 / 8) + bx0 / 8 : bx0;
    const int gw0 = vcu * NWAVES + wave0;
    unsigned char* ws0 = args.ws;
    gu32* ctl = (gu32*)(ws0 + WS_CTL);
    for (int u = tid; u < (LDS_BYTES - LDSCTL_OFF) / 4; u += NWAVES * 64) ((LAS unsigned*)(lds + LDSCTL_OFF))[u] = 0u;
    __syncthreads();
    XcdBarrier bar = xcd_barrier_post((unsigned*)(ctl + CW_BAR) + args.li * XCD_BAR_WORDS, MISC + 8, tid == 0);
    typedef const Args __attribute__((address_space(4)))* kargs_t;
    const kargs_t ka0 = (kargs_t)__builtin_amdgcn_kernarg_segment_ptr();
    const int lo = args.ph_lo, hi = args.ph_hi;
    int layer = 0, f = 0, hf = 0;
#define TX_NOW() ({ unsigned t_; asm volatile("v_mbcnt_lo_u32_b32 %0, -1, 0\n\tv_mbcnt_hi_u32_b32 %0, -1, %0" : "=v"(t_)); t_ | ((unsigned)wave0 << 6); })
    int ph = 0;
#define PH_BEGIN if (ph >= lo && ph < hi) { unsigned char* ws = ws0; kargs_t ka = ka0; unsigned tx_; asm volatile("v_mbcnt_lo_u32_b32 %0, -1, 0\n\tv_mbcnt_hi_u32_b32 %0, -1, %0" : "=v"(tx_)); tx_ |= (unsigned)wave0 << 6; int gw = gw0, G = G0, bx = bx0, Lr = layer; asm volatile("" : "+s"(ws), "+s"(ka), "+v"(tx_), "+s"(gw), "+s"(G), "+s"(bx), "+s"(Lr)); const int lane = (int)(tx_ & 63u), wave = __builtin_amdgcn_readfirstlane((int)(tx_ >> 6)); float* xf = ka->out; unsigned char* wbase = Lr ? (unsigned char*)xf : ws; const int NGW = G * NWAVES;
#define PH_END   if (ph + 1 < hi) xcd_barrier(bar, TX_NOW() == 0u); } ++ph;

#define WGU1 ((bf16*)(wbase + WS_WGU1))
#define WD1 ((bf16*)(wbase + WS_WD1))
#define WIN ((bf16*)(wbase + WS_WIN))
#define WUP ((bf16*)(wbase + WS_WUP))
#define WOUT ((bf16*)(wbase + WS_WOUT))
#define WGU2 ((bf16*)(wbase + WS_WGU2))
#define WD2 ((bf16*)(wbase + WS_WD2))
#define XB ((bf16*)(ws + WS_XB))
#define SSQ ((float*)(ws + WS_SSQ))
#define P ((bf16*)(ws + WS_P))
#define HFF ((bf16*)(ws + WS_HFF))
#define PF ((float*)(ws + WS_PF))
#define YA ((bf16*)(ws + WS_Y))
#define YB ((bf16*)(ws + WS_Y) + 384)
#define YC ((bf16*)(ws + WS_Y) + 768)
#define MGB ((bf16*)(ws + WS_MGB))
#define GI ((bf16*)(ws + WS_GI))
#define KAI ((bf16*)(ws + WS_KAI))
#define KBI ((bf16*)(ws + WS_KBI))
#define KC ((bf16*)(ws + WS_KC))
#define KI ((bf16*)(ws + WS_KI))
#define CF ((float*)(ws + WS_CF))
#define VTA ((bf16*)(ws + WS_VTA))
#define VTB ((bf16*)(ws + WS_VTB))
#define VTC ((bf16*)(ws + WS_VTC))
#define XF (xf)
#define scr ((LAS float*)(lds + RING_OFF + wave * 16384))
#define CONV_FFN(l, which) do { unsigned char* wbase = (l) ? (unsigned char*)xf : ws; const float* gg = ka->in[(which) ? 14 : 1] + (size_t)(l) * DM; const float* wgu = ka->in[(which) ? 15 : 2] + (size_t)(l) * DM * NGU; const float* wd = ka->in[(which) ? 16 : 3] + (size_t)(l) * DFF * DM; \
        conv_job<1>(wgu, NGU, DM, gg, (which) ? WGU2 : WGU1, NGU, DM, scr, gw, NGW, lane, coff); conv_job<0>(wd, DM, DFF, nullptr, (which) ? WD2 : WD1, DM, DFF, scr, gw, NGW, lane, coff); } while (0)
#define CONV_MIX(l) do { unsigned char* wbase = (l) ? (unsigned char*)xf : ws; conv_job<2>(ka->in[5] + (size_t)(l) * DM * 5962, 5962, DM, ka->in[4] + (size_t)(l) * DM, WIN, NIN, DM, scr, gw, NGW, lane, coff); \
        conv_job<0>(ka->in[10] + (size_t)(l) * 384 * DM, DM, 384, nullptr, WUP, DM, 384, scr, gw, NGW, lane, coff, KUP); \
        conv_job<0>(ka->in[11] + (size_t)(l) * 320 * DM, DM, 320, nullptr, WUP + 384, DM, 384, scr, gw, NGW, lane, coff, KUP); \
        conv_job<0>(ka->in[12] + (size_t)(l) * 320 * DM, DM, 320, nullptr, WUP + 768, DM, 384, scr, gw, NGW, lane, coff, KUP); \
        conv_job<0>(ka->in[13] + (size_t)(l) * DM * DM, DM, DM, nullptr, WOUT, DM, DM, scr, gw, NGW, lane, coff); } while (0)

    PH_BEGIN
        int coff = 0;
        CONV_FFN(0, 0); CONV_MIX(0); CONV_FFN(0, 1); CONV_FFN(1, 0); CONV_MIX(1); CONV_FFN(1, 1);
        const float* x = ka->in[0];
        for (int m0 = gw * 4; m0 < MTOK; m0 += NGW * 4) {
            f32x4 v[4][4]; float s[4];
#pragma unroll
            for (int q = 0; q < 4; ++q) { const GAS f32x4* xr = (const GAS f32x4*)(x + (size_t)(m0 + q) * DM) + lane;
#pragma unroll
                for (int j = 0; j < 4; ++j) v[q][j] = xr[64 * j]; }
#pragma unroll
            for (int q = 0; q < 4; ++q) { GAS u32x2* o8 = (GAS u32x2*)(XB + (size_t)(m0 + q) * DM) + lane; s[q] = 0.f;
#pragma unroll
                for (int j = 0; j < 4; ++j) { const f32x4 t = v[q][j]; s[q] += (t[0] * t[0] + t[1] * t[1]) + (t[2] * t[2] + t[3] * t[3]); u32x2 w; w.x = pk2(t[0], t[1]); w.y = pk2(t[2], t[3]); o8[64 * j] = w; } }
#pragma unroll
            for (int q = 0; q < 4; ++q) { const float sm = wave_sum(s[q], lane); if (lane < 16) SSQ[(size_t)(m0 + q) * 16 + lane] = lane == 0 ? sm : 0.f; }
        }
    PH_END

#pragma unroll 1
    for (layer = 0; layer < DEPTH; ++layer) {
#pragma unroll 1
        for (f = 0; f < 2; ++f) {
            PH_BEGIN
                pg8::Gemm g{XB, f ? WGU2 : WGU1, MTOK, NGU, DM, 0}; pg8::StaticOrder S; S.init(MTOK, NGU, G, bx);
                LAS float* rsT = (LAS float*)(lds + RST_OFF);
                pg8::EpiSwiglu E{rsT, HFF, DFF};
                { const float* ssq_ = SSQ; auto pre = [&]() { pg8::rs_table_fill(rsT, ssq_, S, (int)TX_NOW()); };
                  pg8::gemm_phase<pg8::EpiSwiglu, pg8::StaticOrder, true, true>(lds + RING_OFF, g, S, E, (int)TX_NOW(), pre); }
            PH_END
            PH_BEGIN
                pg8::Gemm g{HFF, f ? WD2 : WD1, MTOK, DM, DFF, 0}; pg8::StaticOrder S; S.init(MTOK, DM, G, bx);
                pg8::EpiResid E{XB, SSQ, 0.5f};
                pg8::gemm_phase<pg8::EpiResid, pg8::StaticOrder, true, true>(lds + RING_OFF, g, S, E, (int)TX_NOW());
            PH_END
            if (f == 1) break;
            { const size_t rb = 0;
                PH_BEGIN
                    pg8::Gemm g{XB + rb * DM, WIN, MH, NIN, DM, 0}; pg8::StaticOrder S; S.init(MH, NIN, G, bx);
                    LAS float* rsT = (LAS float*)(lds + RST_OFF);
                    pg8::EpiWin E{rsT, P, PF, PLD};
                    { const float* ssq_ = SSQ + rb * 16; auto pre = [&]() { pg8::rs_table_fill(rsT, ssq_, S, (int)TX_NOW()); };
                      pg8::gemm_phase<pg8::EpiWin, pg8::StaticOrder, true, true>(lds + RING_OFF, g, S, E, (int)TX_NOW(), pre); }
                PH_END
            }
#pragma unroll 1
            for (hf = 0; hf < 2; ++hf) {
                const size_t rb = (size_t)hf * MH;
                PH_BEGIN
                    const float* gkv = ka->in[7] + Lr * 128; const float* wkv = ka->in[8] + (size_t)Lr * 128 * 128; const float* gik = ka->in[9] + Lr * 64; const float* bfor = ka->in[6] + Lr * NFOX;
                    LAS bf16* Tt = (LAS bf16*)(lds + wave * 12288);
                    LAS bf16* VCt = (LAS bf16*)(lds + VCT_OFF);
                    LAS unsigned* Wl = (LAS unsigned*)(lds + 98304);
                    { f32x2_t wv_[16];
#pragma unroll
                      for (int i = 0; i < 16; ++i) wv_[i] = *(const GAS f32x2_t*)(wkv + 2 * ((int)tx_ + 512 * i));
#pragma unroll
                      for (int i = 0; i < 16; ++i) Wl[(int)tx_ + 512 * i] = pk2(wv_[i][0], wv_[i][1]); }
                    __syncthreads();
                    for (int blk = bx; blk < MH / 64; blk += G) {
                        const GAS bf16* prow = (const GAS bf16*)P + (size_t)(blk * 64 + (lane >> 3)) * PLD + 8 * (lane & 7);
                        v4u wa[8];
                        { const GAS bf16* pa = prow + (wave < 6 ? C_VA + wave * 64 : C_VB + (wave - 6) * 64);
#pragma unroll
                          for (int i = 0; i < 8; ++i) wa[i] = *(const GAS v4u*)(pa + (size_t)(8 * i) * PLD); }
                        float pc0[8], pc1[8], pki[8], qc1[8], qc2[8], qi1[8], qi2[8], pfa[8];
#pragma unroll
                        for (int j = 0; j < 8; ++j) { const int r = blk * 64 + wave * 8 + j; const int hq = lane >> 3, i8q = lane & 7;
                            pc0[j] = bf2f(P[(size_t)r * PLD + C_CKV + lane]); pc1[j] = bf2f(P[(size_t)r * PLD + C_CKV + 64 + lane]); pki[j] = PF[(size_t)r * 256 + F_KI + lane];
                            const bf16* pq = P + (size_t)r * PLD + C_QC + (hq < 5 ? hq : 0) * 64; qc1[j] = bf2f(pq[i8q]); qc2[j] = bf2f(pq[i8q + 8]);
                            const bf16* pi = P + (size_t)r * PLD + C_QI + (hq < 4 ? hq : 0) * 64; qi1[j] = bf2f(pi[i8q]); qi2[j] = bf2f(pi[i8q + 8]);
                            pfa[j] = PF[(size_t)r * 256 + F_FA + (lane < NFOX ? lane : 0)]; }
                        const float bfv = *(const GAS float*)(bfor + (lane < NFOX ? lane : 0));
                        LAS float* cn8 = (LAS float*)Tt;
                        { float ss[8];
#pragma unroll
                          for (int j = 0; j < 8; ++j) ss[j] = pc0[j] * pc0[j] + pc1[j] * pc1[j];
#pragma unroll
                          for (int o = 1; o < 64; o <<= 1)
#pragma unroll
                              for (int j = 0; j < 8; ++j) ss[j] += bperm_f(ss[j], lane ^ o);
                          const float g0 = gkv[lane], g1 = gkv[64 + lane];
#pragma unroll
                          for (int j = 0; j < 8; ++j) { const float rn = 1.0f / sqrtf(ss[j] * (1.0f / 128.0f) + EPS); cn8[j * 128 + lane] = pc0[j] * rn * g0; cn8[j * 128 + 64 + lane] = pc1[j] * rn * g1; } }
                        LDS_WAIT(); asm volatile("" ::: "memory");
                        float a0[8], a1[8];
#pragma unroll
                        for (int j = 0; j < 8; ++j) { a0[j] = 0.f; a1[j] = 0.f; }
#pragma unroll 2
                        for (int k = 0; k < 128; k += 4) {
                            unsigned w[4];
#pragma unroll
                            for (int e = 0; e < 4; ++e) w[e] = Wl[(k + e) * 64 + lane];
#pragma unroll
                            for (int j = 0; j < 8; ++j) { const f32x4 cn = *(const LAS f32x4*)(cn8 + j * 128 + k);
#pragma unroll
                                for (int e = 0; e < 4; ++e) { a0[j] = fmaf(cn[e], bflo(w[e]), a0[j]); a1[j] = fmaf(cn[e], bfhi(w[e]), a1[j]); } }
                        }
                        { float ss[8];
#pragma unroll
                          for (int j = 0; j < 8; ++j) ss[j] = pki[j] * pki[j];
#pragma unroll
                          for (int o = 1; o < 64; o <<= 1)
#pragma unroll
                              for (int j = 0; j < 8; ++j) ss[j] += bperm_f(ss[j], lane ^ o);
#pragma unroll
                          for (int j = 0; j < 8; ++j) pki[j] = pki[j] * (1.0f / sqrtf(ss[j] * (1.0f / 64.0f) + EPS)) * gik[lane]; }
#pragma unroll
                        for (int j = 0; j < 8; ++j) {
                            const int tl = wave * 8 + j, r = blk * 64 + tl; const int pos = r % SEQ; const int i8 = lane & 7;
                            float rc, rsn; rope_cs(pos, i8, rc, rsn);
                            float x0 = a0[j], x1v = a1[j];
                            {
                              const int j0 = (2 * lane) & 7, j1 = (2 * lane + 1) & 7;
                              const float c_0 = bperm_f(rc, j0), s_0 = bperm_f(rsn, j0), c_1 = bperm_f(rc, j1), s_1 = bperm_f(rsn, j1);
                              const float o0 = bperm_f(x0, lane ^ 4), o1 = bperm_f(x1v, lane ^ 4);
                              if (lane < 4) { x0 = x0 * c_0 - o0 * s_0; x1v = x1v * c_1 - o1 * s_1; } else if (lane < 8) { x0 = x0 * c_0 + o0 * s_0; x1v = x1v * c_1 + o1 * s_1; } }
                            const size_t kimg = (size_t)(r / SEQ) * SEQ * 64 + (size_t)((pos >> 5) * 4) * 512 + (pos & 31) * 8;
                            if (lane < 32) *(GAS unsigned*)(KC + kimg + (lane >> 3) * 512 + ((lane >> 2) & 1) * 256 + ((2 * lane) & 7)) = pk2(x0, x1v);
                            else *(LAS unsigned*)(VCt + tl * 64 + 2 * (lane - 32)) = pk2(x0, x1v);
                            { const int hh = lane >> 3;
                              if (hh < 5) { bf16* p = P + (size_t)r * PLD + C_QC + hh * 64; const float x1 = qc1[j], x2 = qc2[j]; p[i8] = (bf16)f2bf(x1 * rc - x2 * rsn); p[i8 + 8] = (bf16)f2bf(x2 * rc + x1 * rsn); }
                              if (hh < 4) { bf16* p = P + (size_t)r * PLD + C_QI + hh * 64; const float x1 = qi1[j], x2 = qi2[j]; p[i8] = (bf16)f2bf(x1 * rc - x2 * rsn); p[i8 + 8] = (bf16)f2bf(x2 * rc + x1 * rsn); } }
                            { float y = pki[j]; const float other = bperm_f(y, lane ^ 8); if (lane < 8) y = y * rc - other * rsn; else if (lane < 16) y = y * rc + other * rsn;
                              KI[kimg + (lane >> 4) * 512 + ((lane >> 3) & 1) * 256 + (lane & 7)] = (bf16)f2bf(y); }
                            if (lane < NFOX) { const float fv = pfa[j] + bfv;
                                CF[((size_t)(r / SEQ) * NFOX + lane) * SEQ + pos] = fminf(fv, 0.f) - __logf(1.0f + __expf(-fabsf(fv))); }
                            YB[(size_t)r * KUP + 320 + lane] = 0; YC[(size_t)r * KUP + 320 + lane] = 0;
                        }
                        LDS_WAIT(); asm volatile("" ::: "memory");
                        __syncthreads();
                        const int bl = (blk * 64) / SEQ, t0 = (blk * 64) % SEQ;
                        {
                            const int tok0 = lane >> 3, chl = lane & 7;
                            v4u wb[8];
#pragma unroll
                            for (int i = 0; i < 8; ++i) wb[i] = *(const LAS v4u*)(VCt + (tok0 + 8 * i) * 64 + 8 * chl);
                            if (wave < 3) { const GAS bf16* pb = prow + C_VB + (wave + 2) * 64;
#pragma unroll
                              for (int i = 0; i < 8; ++i) wb[i] = *(const GAS v4u*)(pb + (size_t)(8 * i) * PLD); }
#pragma unroll 1
                            for (int rnd = 0; rnd < 2; ++rnd) {
                                const int jt = rnd ? wave + 8 : wave;
                                if (jt < 12) {
#pragma unroll
                                for (int i = 0; i < 8; ++i) { const int tok = tok0 + 8 * i; const v4u w = wa[i];
                                    const int tp = (tok & ~12) | ((tok & 4) << 1) | ((tok & 8) >> 1);
                                    LAS bf16* d = Tt + (8 * chl) * 72 + ((((tp >> 3) ^ chl) << 3) | (tp & 7));
                                    d[0 * 72] = (bf16)(w.x & 0xffffu); d[1 * 72] = (bf16)(w.x >> 16); d[2 * 72] = (bf16)(w.y & 0xffffu); d[3 * 72] = (bf16)(w.y >> 16);
                                    d[4 * 72] = (bf16)(w.z & 0xffffu); d[5 * 72] = (bf16)(w.z >> 16); d[6 * 72] = (bf16)(w.w & 0xffffu); d[7 * 72] = (bf16)(w.w >> 16); }
                                LDS_WAIT(); asm volatile("" ::: "memory");
                                bf16* dst = jt < 6 ? VTA + ((size_t)(bl * NFOX + jt) * 64) * SEQ : jt < 11 ? VTB + ((size_t)(bl * NSB + (jt - 6)) * 64) * SEQ : VTC + ((size_t)bl * 64) * SEQ;
                                v4u o[8];
#pragma unroll
                                for (int i = 0; i < 8; ++i) o[i] = *(const LAS v4u*)(Tt + (tok0 + 8 * i) * 72 + 8 * (chl ^ i));
#pragma unroll
                                for (int i = 0; i < 8; ++i) { const int d = tok0 + 8 * i;
                                    *(GAS v4u*)(dst + ((size_t)(((t0 >> 5) + (chl >> 2)) * 2 + (d >> 5)) * 2 + ((chl & 3) >> 1)) * 512 + ((d & 31) + 32 * (chl & 1)) * 8) = o[i]; }
                                LDS_WAIT(); asm volatile("" ::: "memory");
                                }
#pragma unroll
                                for (int i = 0; i < 8; ++i) wa[i] = wb[i];
                            }
                        }
                        __syncthreads();
                    }
                PH_END
                PH_BEGIN
                    { const int vw = gw >> 3, w8 = gw & 7; const int nF = G < 192 ? G : 192, nS = G - nF;
                      for (int it = vw; it < HB * NFOX * 4; it += G) { const int q4 = it / (HB * NFOX), bh = it % (HB * NFOX);
                            LAS float* cfL = (LAS float*)(lds + RING_OFF);
                            __syncthreads();
                            {
                                const int ti = (int)tx_; f32x4 v = *(const GAS f32x4*)(CF + (size_t)bh * SEQ + 4 * ti);
                                v[1] += v[0]; v[2] += v[1]; v[3] += v[2];
                                float tot = v[3];
#pragma unroll
                                for (int o = 1; o < 64; o <<= 1) { const float n = bperm_f(tot, lane - o); if (lane >= o) tot += n; }
                                LAS float* wtot = cfL + SEQ;
                                if (lane == 63) wtot[wave] = tot;
                                __syncthreads();
                                float base = tot - v[3];
#pragma unroll
                                for (int w = 0; w < 8; ++w) base += w < wave ? wtot[w] : 0.f;
                                *(LAS f32x4*)(cfL + 4 * ti) = (v + base) * (-LOG2E);
                            }
                            __syncthreads();
#pragma unroll 1
                            for (int hl = 0; hl < 2; ++hl) fox_strip(P, KAI, cfL, VTA, YA, bh / NFOX, bh % NFOX, hl == 0 ? (7 - q4) * 8 + 7 - w8 : q4 * 8 + w8, lane); }
                      if (nS > 0) { if (vw >= nF) for (int E = vw - nF; E < HB * NSB * 8; E += nS) { const int Qg = 7 - E / (HB * NSB), bh = E % (HB * NSB); sb_strip(P, KBI, VTB, YB, bh / NSB, bh % NSB, Qg * 8 + 7 - w8, lane); } }
                      else for (int E = vw; E < HB * NSB * 8; E += G) { const int Qg = 7 - E / (HB * NSB), bh = E % (HB * NSB); sb_strip(P, KBI, VTB, YB, bh / NSB, bh % NSB, Qg * 8 + 7 - w8, lane); }
                    }
                    __syncthreads();
                    for (int rd = 0; rd * G < HB * 64; ++rd) { const int vw = gw >> 3; const int U = rd * G + ((rd & 1) ? G - 1 - vw : vw);
                        if (U < HB * 64) dsa_unit(P, PF, KI, KC, VTC, YC, U % HB, 63 - U / HB, wave, lane, lds + RING_OFF); }
                PH_END
                PH_BEGIN
                    pg8::SegOrder3 S; S.init(MH, DM, G, bx);
                    { pg8::Gemm g{YA, WUP, MH, DM, 384, KUP}; pg8::EpiGateR E{GI, MGB}; pg8::gemm_phase<pg8::EpiGateR, pg8::SegOrder3, true, true>(lds + RING_OFF, g, S, E, (int)TX_NOW()); }
                PH_END
                PH_BEGIN
                    pg8::Gemm g{MGB, WOUT, MH, DM, DM, 0}; pg8::StaticOrder S; S.init(MH, DM, G, bx);
                    pg8::EpiResid E{XB + rb * DM, SSQ + rb * 16, 1.0f};
                    pg8::gemm_phase<pg8::EpiResid, pg8::StaticOrder, true, true>(lds + RING_OFF, g, S, E, (int)TX_NOW());
                    if (hf == 0) { const size_t rb1 = (size_t)MH;

                    pg8::Gemm g{XB + rb1 * DM, WIN, MH, NIN, DM, 0}; pg8::StaticOrder S; S.init(MH, NIN, G, bx);
                    LAS float* rsT = (LAS float*)(lds + RST_OFF);
                    pg8::EpiWin E{rsT, P, PF, PLD};
                    { const float* ssq_ = SSQ + rb1 * 16; auto pre = [&]() { pg8::rs_table_fill(rsT, ssq_, S, (int)TX_NOW()); };
                      pg8::gemm_phase<pg8::EpiWin, pg8::StaticOrder, true, true>(lds + RING_OFF, g, S, E, (int)TX_NOW(), pre); }
                                    }
                PH_END
            }
        }
    }
    PH_BEGIN
        const float* gf = ka->in[17];
        const GAS f32x4* gr = (const GAS f32x4*)gf + lane; f32x4 gv[4];
#pragma unroll
        for (int j = 0; j < 4; ++j) gv[j] = gr[64 * j];
        for (int m0 = gw * 4; m0 < MTOK; m0 += NGW * 4) {
            u32x2 w[4][4];
#pragma unroll
            for (int q = 0; q < 4; ++q) { const GAS u32x2* xr = (const GAS u32x2*)(XB + (size_t)(m0 + q) * DM) + lane;
#pragma unroll
                for (int j = 0; j < 4; ++j) w[q][j] = xr[64 * j]; }
#pragma unroll
            for (int q = 0; q < 4; ++q) { f32x4 v[4]; float s = 0.f;
#pragma unroll
                for (int j = 0; j < 4; ++j) { v[j][0] = bflo(w[q][j].x); v[j][1] = bfhi(w[q][j].x); v[j][2] = bflo(w[q][j].y); v[j][3] = bfhi(w[q][j].y); s += (v[j][0] * v[j][0] + v[j][1] * v[j][1]) + (v[j][2] * v[j][2] + v[j][3] * v[j][3]); }
                const float rs = 1.0f / sqrtf(wave_sum(s, lane) * (1.0f / DM) + EPS);
                GAS f32x4* orow = (GAS f32x4*)(xf + (size_t)(m0 + q) * DM) + lane;
#pragma unroll
                for (int j = 0; j < 4; ++j) orow[64 * j] = v[j] * rs * gv[j]; }
        }
    PH_END
#undef PH_BEGIN
#undef PH_END
}

#ifndef MK_N_LAUNCHES
#define MK_N_LAUNCHES 1
#endif
constexpr int N_PHASES = 1 + DEPTH * (2 + 1 + 2 * 4 + 2) + 1;
extern "C" void kernel_launch(void* const* d_in, const int* in_sizes, int n_in, void* d_out, int out_size, void* d_ws, size_t ws_size, hipStream_t stream) {
    static int grid = 0;
    if (grid == 0) {
        if (n_in != 18 || in_sizes[0] != MTOK * DM || out_size != MTOK * DM || ws_size < WS_END) { fprintf(stderr, "kernel_launch: unexpected shapes (n_in %d, in0 %d, out %d, ws %zu); nothing launched\n", n_in, n_in > 0 ? in_sizes[0] : -1, out_size, ws_size); grid = -1; return; }
        int dev = 0, cus = 0, per_cu = 0;
        if (hipGetDevice(&dev) != hipSuccess || hipDeviceGetAttribute(&cus, hipDeviceAttributeMultiprocessorCount, dev) != hipSuccess) { grid = -1; return; }
        if (hipFuncSetAttribute((const void*)mk_fwd, hipFuncAttributeMaxDynamicSharedMemorySize, LDS_BYTES) != hipSuccess) { fprintf(stderr, "kernel_launch: hipFuncSetAttribute failed\n"); grid = -1; return; }
        if (hipOccupancyMaxActiveBlocksPerMultiprocessor(&per_cu, (const void*)mk_fwd, NWAVES * 64, LDS_BYTES) != hipSuccess || per_cu < 1) fprintf(stderr, "kernel_launch: occupancy query reports %d workgroups per CU\n", per_cu);
        (void)hipGetLastError();
        grid = cus;
        if (grid > 256) grid = 256;
    }
    if (grid < 0) return;
    if (hipMemsetAsync((char*)d_ws + WS_CTL, 0, CTL_ZERO_BYTES, stream) != hipSuccess) return;
    Args a{};
    for (int i = 0; i < 18; ++i) a.in[i] = (const float*)d_in[i];
    a.out = (float*)d_out; a.ws = (unsigned char*)d_ws; a.pad = 0;
    const int nl = MK_N_LAUNCHES;
    for (int li = 0; li < nl; ++li) {
        a.ph_lo = (int)((long)N_PHASES * li / nl); a.ph_hi = (int)((long)N_PHASES * (li + 1) / nl); a.li = li;
        hipLaunchKernelGGL(mk_fwd, dim3(grid), dim3(NWAVES * 64), LDS_BYTES, stream, a);
        const hipError_t le = hipPeekAtLastError();
        if (le != hipSuccess) { fprintf(stderr, "kernel_launch: launch %d failed: %s\n", li, hipGetErrorName(le)); break; }
    }
}
```

```cpp
#include <hip/hip_runtime.h>
#include <cstdio>
#include <cstdint>
#include <cmath>
namespace pg8 {
#define PG8_LAS __attribute__((address_space(3)))
typedef unsigned short bf16_t;
typedef short bf16x8 __attribute__((ext_vector_type(8)));
typedef float f32x4 __attribute__((ext_vector_type(4)));
typedef unsigned u32x4 __attribute__((ext_vector_type(4)));
constexpr int BM = 256, BK = 64, HALF = 128, HTB = HALF * BK * 2  , STAGE_BYTES = 8 * HTB, NXCD = 8, WGM = 8;

__host__ __device__ __forceinline__ int lds_byte(int r, int c) { const int st = (r >> 4) * 2 + (c >> 5), rr = r & 15, cc = c & 31, ob = rr * 64 + cc * 2; return st * 1024 + (ob ^ (((ob >> 9) & 1) << 5)); }
__host__ __device__ __forceinline__ void stage_rc(int b, int& R, int& C) { const int st = b / 1024, sb = b % 1024, swz = sb ^ (((sb >> 9) & 1) << 5); R = (st >> 1) * 16 + swz / 64; C = (st & 1) * 32 + (swz % 64) / 2; }
__host__ __device__ __forceinline__ int perm32(int rho) { const int n = rho >> 4, i = rho & 15; return 8 * (i >> 2) + 4 * n + (i & 3); }

struct Unit { int pm, pn, ks, ui; };
struct Gemm { const bf16_t* A; const bf16_t* Bt; int M, N, K, ld; };

struct StaticOrder {
    int nM, nN, nwg, G, c;
    __host__ __device__ void init(int M, int N, int G_, int c_) { nM = M / BM; nN = N / BM; nwg = nM * nN; G = G_; c = c_; }
    __host__ __device__ bool next(int i, Unit& u) const {
        const long L = (long)i * G + c; if (L >= nwg) return false;
        int wgid = (int)L; { const int q = nwg / NXCD, r = nwg % NXCD, xcd = wgid % NXCD, off = wgid / NXCD; wgid = (xcd < r ? xcd * (q + 1) : r * (q + 1) + (xcd - r) * q) + off; }
        const int nig = WGM * nN, gid = wgid / nig, fm = gid * WGM, gsz = (nM - fm) < WGM ? (nM - fm) : WGM;
        u.pm = fm + ((wgid % nig) % gsz); u.pn = (wgid % nig) / gsz; u.ks = 0; u.ui = i; return true;
    }
    __device__ __forceinline__ void a_ready(const Unit&) const {}
    __device__ __forceinline__ void done(const Unit&) const {}
};

__device__ __forceinline__ unsigned cvt_pk_bf16(float lo, float hi) { unsigned r; asm volatile("v_cvt_pk_bf16_f32 %0, %1, %2" : "=v"(r) : "v"(lo), "v"(hi)); return r; }
typedef float f32x2 __attribute__((ext_vector_type(2)));

#define PG8_GAS __attribute__((address_space(1)))
__device__ __forceinline__ float row_rs(const float* ssq, int row) {
    const f32x4* p = (const f32x4*)(ssq + (size_t)row * 16);
    const f32x4 a = p[0], b = p[1], c = p[2], d = p[3];
    const float s = (((a[0] + a[1]) + (a[2] + a[3])) + ((b[0] + b[1]) + (b[2] + b[3]))) + (((c[0] + c[1]) + (c[2] + c[3])) + ((d[0] + d[1]) + (d[2] + d[3])));
    return 1.0f / sqrtf(s * (1.0f / 1024.0f) + 1e-6f);
}
__device__ __forceinline__ float sigmoid_f(float v) { return __builtin_amdgcn_rcpf(1.0f + __expf(-v)); }
__device__ __forceinline__ float bf_lo(unsigned w) { return __uint_as_float(w << 16); }
__device__ __forceinline__ float bf_hi(unsigned w) { return __uint_as_float(w & 0xffff0000u); }

template <class Sched> __device__ __forceinline__ void rs_table_fill(PG8_LAS float* rsT, const float* ssq, const Sched& S, int tid) {
    Unit u; const int row = tid >> 1, hf = tid & 1;
    f32x4 a[12], b[12]; int n = 0;
#pragma unroll
    for (int i = 0; i < 12; ++i) { if (S.next(i, u)) { const PG8_GAS f32x4* p = (const PG8_GAS f32x4*)(ssq + (size_t)(u.pm * BM + row) * 16 + 8 * hf); a[i] = p[0]; b[i] = p[1]; n = i + 1; } else { a[i] = f32x4{}; b[i] = f32x4{}; } }
#pragma unroll
    for (int i = 0; i < 12; ++i) {
        float s = ((a[i][0] + a[i][1]) + (a[i][2] + a[i][3])) + ((b[i][0] + b[i][1]) + (b[i][2] + b[i][3]));
        s += __int_as_float(__builtin_amdgcn_ds_bpermute(((tid & 63) ^ 1) << 2, __float_as_int(s)));
        if (hf == 0 && i < n) rsT[i * BM + row] = 1.0f / sqrtf(s * (1.0f / 1024.0f) + 1e-6f);
    }
    __syncthreads();
}
#define PIN8(a) asm volatile("" : "+v"((a)[0]), "+v"((a)[1]), "+v"((a)[2]), "+v"((a)[3]), "+v"((a)[4]), "+v"((a)[5]), "+v"((a)[6]), "+v"((a)[7]))
#define PIN4X2(a) asm volatile("" : "+v"((a)[0]), "+v"((a)[1]), "+v"((a)[2]), "+v"((a)[3]))
struct EpiSwiglu {
    static constexpr bool PERM = true, AFTER_DRAIN = false, CARRY = false;
    const PG8_LAS float* rsT; bf16_t* H; int ldh;
    __device__ __forceinline__ void operator()(const f32x4 (&acc)[2][2][4][2], const Unit& u, int wr, int wc, int fr, int fq) const {
        const int row0 = u.pm * BM + wr * 64 + fr, col0 = u.pn * HALF + wc * 32 + 8 * fq;
#pragma unroll
        for (int ai = 0; ai < 2; ++ai)
#pragma unroll
            for (int m = 0; m < 4; ++m) {
                const int row = row0 + ai * HALF + m * 16; const float r = rsT[u.ui * BM + wr * 64 + fr + ai * HALF + m * 16];
                const float rn = r * -1.4426950408889634f, rq = r * r;
                f32x2 g[4], p[4], t[4];
#pragma unroll
                for (int n = 0; n < 2; ++n) { const f32x4 G4 = acc[ai][0][m][n], U4 = acc[ai][1][m][n];
                    g[2 * n] = f32x2{G4[0], G4[1]}; g[2 * n + 1] = f32x2{G4[2], G4[3]}; p[2 * n] = f32x2{U4[0], U4[1]}; p[2 * n + 1] = f32x2{U4[2], U4[3]}; }
#pragma unroll
                for (int i = 0; i < 4; ++i) { t[i] = g[i] * rn; p[i] = g[i] * p[i]; }
                PIN4X2(t);
#pragma unroll
                for (int i = 0; i < 4; ++i) { t[i][0] = __builtin_amdgcn_exp2f(t[i][0]); t[i][1] = __builtin_amdgcn_exp2f(t[i][1]); }
                PIN4X2(t);
#pragma unroll
                for (int i = 0; i < 4; ++i) { t[i] = t[i] + 1.0f; p[i] = p[i] * rq; }
                PIN4X2(t);
#pragma unroll
                for (int i = 0; i < 4; ++i) { t[i][0] = __builtin_amdgcn_rcpf(t[i][0]); t[i][1] = __builtin_amdgcn_rcpf(t[i][1]); }
                PIN4X2(t);
#pragma unroll
                for (int i = 0; i < 4; ++i) t[i] = t[i] * p[i];
                u32x4 w; w.x = cvt_pk_bf16(t[0][0], t[0][1]); w.y = cvt_pk_bf16(t[1][0], t[1][1]); w.z = cvt_pk_bf16(t[2][0], t[2][1]); w.w = cvt_pk_bf16(t[3][0], t[3][1]);
                *(PG8_GAS u32x4*)(H + (size_t)row * ldh + col0) = w;
            }
    }
};
struct EpiResid {
    static constexpr bool PERM = true, AFTER_DRAIN = false, CARRY = false;
    bf16_t* xb; float* ssq; float alpha;
    __device__ __forceinline__ void operator()(const f32x4 (&acc)[2][2][4][2], const Unit& u, int wr, int wc, int fr, int fq) const {
        const int row0 = u.pm * BM + wr * 64 + fr, col0 = u.pn * BM + wc * 32 + 8 * fq;
#pragma unroll
        for (int ai = 0; ai < 2; ++ai)
        {
            u32x4 xov[4][2];
#pragma unroll
            for (int m = 0; m < 4; ++m)
#pragma unroll
                for (int bj = 0; bj < 2; ++bj) xov[m][bj] = *(const PG8_GAS u32x4*)(xb + (size_t)(row0 + ai * HALF + m * 16) * 1024 + col0 + bj * HALF);
#pragma unroll
            for (int m = 0; m < 4; ++m) {
                const int row = row0 + ai * HALF + m * 16; float sq = 0.f;
#pragma unroll
                for (int bj = 0; bj < 2; ++bj) {
                    const u32x4 xo = xov[m][bj];
                    f32x4 x0, x1; x0[0] = bf_lo(xo.x); x0[1] = bf_hi(xo.x); x0[2] = bf_lo(xo.y); x0[3] = bf_hi(xo.y); x1[0] = bf_lo(xo.z); x1[1] = bf_hi(xo.z); x1[2] = bf_lo(xo.w); x1[3] = bf_hi(xo.w);
                    x0 += acc[ai][bj][m][0] * alpha; x1 += acc[ai][bj][m][1] * alpha;
                    u32x4 w; w.x = cvt_pk_bf16(x0[0], x0[1]); w.y = cvt_pk_bf16(x0[2], x0[3]); w.z = cvt_pk_bf16(x1[0], x1[1]); w.w = cvt_pk_bf16(x1[2], x1[3]);
                    *(PG8_GAS u32x4*)(xb + (size_t)row * 1024 + col0 + bj * HALF) = w;
                    sq += ((x0[0] * x0[0] + x0[1] * x0[1]) + (x0[2] * x0[2] + x0[3] * x0[3])) + ((x1[0] * x1[0] + x1[1] * x1[1]) + (x1[2] * x1[2] + x1[3] * x1[3]));
                }
                { const int ln_ = fq * 16 + fr;
                  sq += __int_as_float(__builtin_amdgcn_ds_bpermute((ln_ ^ 16) << 2, __float_as_int(sq))); sq += __int_as_float(__builtin_amdgcn_ds_bpermute((ln_ ^ 32) << 2, __float_as_int(sq))); }
                if (fq == 0) *(PG8_GAS float*)(ssq + (size_t)row * 16 + u.pn * 4 + wc) = sq;
            }
        }
    }
};
struct EpiWin {
    static constexpr bool PERM = true, AFTER_DRAIN = false, CARRY = false;
    static constexpr int KA0 = 384, NHA = 6, KB0 = 1472, NHB = 5, SEQL = 2048; static constexpr long KAI_OFF = (364L - 120L) << 20, KBI_OFF = (376L - 120L) << 20, GI_OFF = (216L - 120L) << 20;
    const PG8_LAS float* rsT; bf16_t* P; float* Pf; int ldp;
    __device__ __forceinline__ void operator()(const f32x4 (&acc)[2][2][4][2], const Unit& u, int wr, int wc, int fr, int fq) const {
        const int row0 = u.pm * BM + wr * 64 + fr, cin = wc * 32 + 8 * fq;
#pragma unroll
        for (int ai = 0; ai < 2; ++ai)
#pragma unroll
            for (int m = 0; m < 4; ++m) {
                const int row = row0 + ai * HALF + m * 16; const float r = rsT[u.ui * BM + wr * 64 + fr + ai * HALF + m * 16];
                if (u.pn == 11) {
#pragma unroll
                    for (int bj = 0; bj < 2; ++bj) { const f32x4 v0 = acc[ai][bj][m][0] * r, v1 = acc[ai][bj][m][1] * r;
                        PG8_GAS float* o = (PG8_GAS float*)(Pf + (size_t)row * 256 + cin + bj * HALF); *(PG8_GAS f32x4*)o = v0; *(PG8_GAS f32x4*)(o + 4) = v1; }
                } else if (u.pn >= 12) {
                    const float rn = r * -1.4426950408889634f;
                    f32x2 t[8];
#pragma unroll
                    for (int bj = 0; bj < 2; ++bj)
#pragma unroll
                        for (int n = 0; n < 2; ++n) { const f32x4 A4 = acc[ai][bj][m][n]; t[4 * bj + 2 * n] = f32x2{A4[0], A4[1]} * rn; t[4 * bj + 2 * n + 1] = f32x2{A4[2], A4[3]} * rn; }
                    PIN4X2(t); PIN4X2(t + 4);
#pragma unroll
                    for (int i = 0; i < 8; ++i) { t[i][0] = __builtin_amdgcn_exp2f(t[i][0]); t[i][1] = __builtin_amdgcn_exp2f(t[i][1]); }
                    PIN4X2(t); PIN4X2(t + 4);
#pragma unroll
                    for (int i = 0; i < 8; ++i) t[i] = t[i] + 1.0f;
                    PIN4X2(t); PIN4X2(t + 4);
#pragma unroll
                    for (int i = 0; i < 8; ++i) { t[i][0] = __builtin_amdgcn_rcpf(t[i][0]); t[i][1] = __builtin_amdgcn_rcpf(t[i][1]); }
#pragma unroll
                    for (int bj = 0; bj < 2; ++bj) { u32x4 w; w.x = cvt_pk_bf16(t[4 * bj][0], t[4 * bj][1]); w.y = cvt_pk_bf16(t[4 * bj + 1][0], t[4 * bj + 1][1]); w.z = cvt_pk_bf16(t[4 * bj + 2][0], t[4 * bj + 2][1]); w.w = cvt_pk_bf16(t[4 * bj + 3][0], t[4 * bj + 3][1]);
                        bf16_t* gi = (bf16_t*)((char*)P + GI_OFF) + ((size_t)(((u.pn - 12) >> 2) * 64 + u.pm) * 4 + ((u.pn - 12) & 3)) * 65536;
                        *(PG8_GAS u32x4*)(gi + (wr * 4 + wc) * 8192 + ((ai * 4 + m) * 2 + bj) * 512 + (fr + 16 * fq) * 8) = w; }
                } else {
#pragma unroll
                    for (int bj = 0; bj < 2; ++bj) { const f32x4 v0 = acc[ai][bj][m][0] * r, v1 = acc[ai][bj][m][1] * r;
                        u32x4 w; w.x = cvt_pk_bf16(v0[0], v0[1]); w.y = cvt_pk_bf16(v0[2], v0[3]); w.z = cvt_pk_bf16(v1[0], v1[1]); w.w = cvt_pk_bf16(v1[2], v1[3]);
                        const int gb = u.pn * BM + wc * 32 + bj * HALF;
                        const bool isKa = gb >= KA0 && gb < KA0 + 64 * NHA, isKb = gb >= KB0 && gb < KB0 + 64 * NHB;
                        if (isKa || isKb) {
                            const int rel = gb - (isKa ? KA0 : KB0), head = rel >> 6, c = ((rel & 63) >> 3) + fq, bt = row / SEQL, pos = row % SEQL;
                            bf16_t* img = (bf16_t*)((char*)P + (isKa ? KAI_OFF : KBI_OFF)) + (size_t)(bt * (isKa ? NHA : NHB) + head) * 64 * SEQL;
                            *(PG8_GAS u32x4*)(img + ((size_t)((pos >> 5) * 4 + (c >> 1)) * 64 + (pos & 31) + 32 * (c & 1)) * 8) = w;
                        } else *(PG8_GAS u32x4*)(P + (size_t)row * ldp + gb + 8 * fq) = w; }
                }
            }
    }
};
template <int MODE> struct EpiGate {
    static constexpr bool PERM = true, AFTER_DRAIN = false, CARRY = false;
    const bf16_t* G; int ldg; bf16_t* part; bf16_t* mgb;
    __device__ __forceinline__ void operator()(const f32x4 (&acc)[2][2][4][2], const Unit& u, int wr, int wc, int fr, int fq) const {
        const int row0 = u.pm * BM + wr * 64 + fr, col0 = u.pn * BM + wc * 32 + 8 * fq;
#pragma unroll
        for (int ai = 0; ai < 2; ++ai)
        {
            u32x4 gwv[4][2], pwv[4][2];
#pragma unroll
            for (int m = 0; m < 4; ++m)
#pragma unroll
                for (int bj = 0; bj < 2; ++bj) { const int row = row0 + ai * HALF + m * 16, col = col0 + bj * HALF;
                    gwv[m][bj] = *(const PG8_GAS u32x4*)(G + (size_t)row * ldg + col);
                    if (MODE >= 1) pwv[m][bj] = *(const PG8_GAS u32x4*)(part + (size_t)row * 1024 + col); }
#pragma unroll
            for (int m = 0; m < 4; ++m) {
                const int row = row0 + ai * HALF + m * 16;
#pragma unroll
                for (int bj = 0; bj < 2; ++bj) {
                    const int col = col0 + bj * HALF;
                    const u32x4 gw = gwv[m][bj];
                    f32x4 v0 = acc[ai][bj][m][0], v1 = acc[ai][bj][m][1];
                    v0[0] *= bf_lo(gw.x); v0[1] *= bf_hi(gw.x); v0[2] *= bf_lo(gw.y); v0[3] *= bf_hi(gw.y);
                    v1[0] *= bf_lo(gw.z); v1[1] *= bf_hi(gw.z); v1[2] *= bf_lo(gw.w); v1[3] *= bf_hi(gw.w);
                    if (MODE >= 1) { const u32x4 pw = pwv[m][bj];
                        v0[0] += bf_lo(pw.x); v0[1] += bf_hi(pw.x); v0[2] += bf_lo(pw.y); v0[3] += bf_hi(pw.y); v1[0] += bf_lo(pw.z); v1[1] += bf_hi(pw.z); v1[2] += bf_lo(pw.w); v1[3] += bf_hi(pw.w); }
                    u32x4 w; w.x = cvt_pk_bf16(v0[0], v0[1]); w.y = cvt_pk_bf16(v0[2], v0[3]); w.z = cvt_pk_bf16(v1[0], v1[1]); w.w = cvt_pk_bf16(v1[2], v1[3]);
                    *(PG8_GAS u32x4*)((MODE <= 1 ? part : mgb) + (size_t)row * 1024 + col) = w;
                }
            }
        }
    }
};

struct SegOrder3 : StaticOrder {
    __host__ __device__ bool next(int i, Unit& u) const { const bool ok = StaticOrder::next(i / 3, u); u.ks = i % 3; u.ui = i; return ok; }
};
struct EpiGateU {
    static constexpr bool PERM = true, AFTER_DRAIN = false, CARRY = false;
    const bf16_t* G; bf16_t* mgb; static constexpr int ldg = 6144;
    __device__ __forceinline__ void operator()(const f32x4 (&acc)[2][2][4][2], const Unit& u, int wr, int wc, int fr, int fq) const {
        const int row0 = u.pm * BM + wr * 64 + fr, col0 = u.pn * BM + wc * 32 + 8 * fq;
        const bf16_t* Gs = G + u.ks * 1024; const unsigned keep = u.ks ? 0xffffffffu : 0u;
#pragma unroll
        for (int ai = 0; ai < 2; ++ai)
        {
            u32x4 gwv[4][2], pwv[4][2];
#pragma unroll
            for (int m = 0; m < 4; ++m)
#pragma unroll
                for (int bj = 0; bj < 2; ++bj) { const int row = row0 + ai * HALF + m * 16, col = col0 + bj * HALF;
                    gwv[m][bj] = *(const PG8_GAS u32x4*)(Gs + (size_t)row * ldg + col);
                    pwv[m][bj] = *(const PG8_GAS u32x4*)(mgb + (size_t)row * 1024 + col); }
#pragma unroll
            for (int m = 0; m < 4; ++m) {
                const int row = row0 + ai * HALF + m * 16;
#pragma unroll
                for (int bj = 0; bj < 2; ++bj) {
                    const int col = col0 + bj * HALF;
                    const u32x4 gw = gwv[m][bj]; u32x4 pw = pwv[m][bj]; pw.x &= keep; pw.y &= keep; pw.z &= keep; pw.w &= keep;
                    f32x4 v0 = acc[ai][bj][m][0], v1 = acc[ai][bj][m][1];
                    v0[0] = fmaf(v0[0], bf_lo(gw.x), bf_lo(pw.x)); v0[1] = fmaf(v0[1], bf_hi(gw.x), bf_hi(pw.x)); v0[2] = fmaf(v0[2], bf_lo(gw.y), bf_lo(pw.y)); v0[3] = fmaf(v0[3], bf_hi(gw.y), bf_hi(pw.y));
                    v1[0] = fmaf(v1[0], bf_lo(gw.z), bf_lo(pw.z)); v1[1] = fmaf(v1[1], bf_hi(gw.z), bf_hi(pw.z)); v1[2] = fmaf(v1[2], bf_lo(gw.w), bf_lo(pw.w)); v1[3] = fmaf(v1[3], bf_hi(gw.w), bf_hi(pw.w));
                    u32x4 w; w.x = cvt_pk_bf16(v0[0], v0[1]); w.y = cvt_pk_bf16(v0[2], v0[3]); w.z = cvt_pk_bf16(v1[0], v1[1]); w.w = cvt_pk_bf16(v1[2], v1[3]);
                    *(PG8_GAS u32x4*)(mgb + (size_t)row * 1024 + col) = w;
                }
            }
        }
    }
};

struct EpiGateR {
    static constexpr bool PERM = true, AFTER_DRAIN = false, CARRY = true;
    const bf16_t* G; bf16_t* mgb; static constexpr int ldg = 6144;
    __device__ __forceinline__ void operator()(const f32x4 (&acc)[2][2][4][2], const Unit& u, int wr, int wc, int fr, int fq) const {
        if (u.ks != 2) return;
        const int row0 = u.pm * BM + wr * 64 + fr, col0 = u.pn * BM + wc * 32 + 8 * fq;
        const bf16_t* Gs = G + ((size_t)(2 * 64 + u.pm) * 4 + u.pn) * 65536 + (wr * 4 + wc) * 8192 + (fr + 16 * fq) * 8;
#pragma unroll
        for (int ai = 0; ai < 2; ++ai)
        {
            u32x4 gwv[4][2];
#pragma unroll
            for (int m = 0; m < 4; ++m)
#pragma unroll
                for (int bj = 0; bj < 2; ++bj) gwv[m][bj] = *(const PG8_GAS u32x4*)(Gs + ((ai * 4 + m) * 2 + bj) * 512);
#pragma unroll
            for (int m = 0; m < 4; ++m)
#pragma unroll
                for (int bj = 0; bj < 2; ++bj) {
                    const u32x4 gw = gwv[m][bj]; f32x4 v0 = acc[ai][bj][m][0], v1 = acc[ai][bj][m][1];
                    v0[0] *= bf_lo(gw.x); v0[1] *= bf_hi(gw.x); v0[2] *= bf_lo(gw.y); v0[3] *= bf_hi(gw.y); v1[0] *= bf_lo(gw.z); v1[1] *= bf_hi(gw.z); v1[2] *= bf_lo(gw.w); v1[3] *= bf_hi(gw.w);
                    u32x4 w; w.x = cvt_pk_bf16(v0[0], v0[1]); w.y = cvt_pk_bf16(v0[2], v0[3]); w.z = cvt_pk_bf16(v1[0], v1[1]); w.w = cvt_pk_bf16(v1[2], v1[3]);
                    *(PG8_GAS u32x4*)(mgb + (size_t)(row0 + ai * HALF + m * 16) * 1024 + col0 + bj * HALF) = w;
                }
        }
    }
    __device__ __forceinline__ void carry(f32x4 (&acc)[2][2][4][2], const Unit& u, int wr, int wc, int fr, int fq) const {
        const int row0 = u.pm * BM + wr * 64 + fr, col0 = u.pn * BM + wc * 32 + 8 * fq;
        const int kn = u.ks < 2 ? u.ks + 1 : 2; const float z = u.ks < 2 ? 1.0f : 0.0f;
        const size_t wofs = (size_t)(wr * 4 + wc) * 8192 + (fr + 16 * fq) * 8;
        const bf16_t* Ga = G + ((size_t)(u.ks * 64 + u.pm) * 4 + u.pn) * 65536 + wofs; const bf16_t* Gb = G + ((size_t)(kn * 64 + u.pm) * 4 + u.pn) * 65536 + wofs;
#pragma unroll
        for (int ai = 0; ai < 2; ++ai)
#pragma unroll
        for (int mh = 0; mh < 2; ++mh)
        {
            u32x4 ga[2][2], gb[2][2];
#pragma unroll
            for (int m2 = 0; m2 < 2; ++m2)
#pragma unroll
                for (int bj = 0; bj < 2; ++bj) { const int o_ = ((ai * 4 + 2 * mh + m2) * 2 + bj) * 512; ga[m2][bj] = *(const PG8_GAS u32x4*)(Ga + o_); gb[m2][bj] = *(const PG8_GAS u32x4*)(Gb + o_); }
#pragma unroll
            for (int m2 = 0; m2 < 2; ++m2)
#pragma unroll
                for (int bj = 0; bj < 2; ++bj) { const int m = 2 * mh + m2; const u32x4 a_ = ga[m2][bj], b_ = gb[m2][bj];
                    float fa[8] = {bf_lo(a_.x), bf_hi(a_.x), bf_lo(a_.y), bf_hi(a_.y), bf_lo(a_.z), bf_hi(a_.z), bf_lo(a_.w), bf_hi(a_.w)};
                    float fb[8] = {bf_lo(b_.x), bf_hi(b_.x), bf_lo(b_.y), bf_hi(b_.y), bf_lo(b_.z), bf_hi(b_.z), bf_lo(b_.w), bf_hi(b_.w)};
#pragma unroll
                    for (int e_ = 0; e_ < 8; ++e_) fb[e_] = __builtin_amdgcn_rcpf(fb[e_]);
#pragma unroll
                    for (int e_ = 0; e_ < 8; ++e_) fa[e_] = fa[e_] * fb[e_] * z;
#pragma unroll
                    for (int n_ = 0; n_ < 2; ++n_) { f32x4 v_ = acc[ai][bj][m][n_];
                        asm volatile("v_mul_f32 %0, %0, %4\n\tv_mul_f32 %1, %1, %5\n\tv_mul_f32 %2, %2, %6\n\tv_mul_f32 %3, %3, %7" : "+v"(v_[0]), "+v"(v_[1]), "+v"(v_[2]), "+v"(v_[3]) : "v"(fa[4 * n_ + 0]), "v"(fa[4 * n_ + 1]), "v"(fa[4 * n_ + 2]), "v"(fa[4 * n_ + 3]));
                        acc[ai][bj][m][n_] = v_; } }
            asm volatile("" ::: "memory");
        }
    }
};

struct NoPre { __device__ __forceinline__ void operator()() const {} };
template <class Epi, class Sched, bool ALIGN_EPI = false, bool SP2 = false, class Pre = NoPre>
__device__ __forceinline__ void gemm_phase(PG8_LAS unsigned char* lds, const Gemm g, const Sched& S, const Epi& E, int tid_in, const Pre& pre = Pre()) {
    int tid_ = tid_in; asm volatile("" : "+v"(tid_));
    const int tid = tid_, wid = __builtin_amdgcn_readfirstlane(tid >> 6), lane = tid & 63, wr = wid >> 2, wc = wid & 3, fr = lane & 15, fq = lane >> 4;
    const int K = g.K, nt = K / BK, ld = g.ld ? g.ld : g.K;
    unsigned voffA[2], voffB[2];
#pragma unroll
    for (int i = 0; i < 2; ++i) { int R, C; stage_rc(tid * 16 + i * 8192, R, C); const int Rb = Epi::PERM ? ((R & ~31) + perm32(R & 31)) : R;
        voffA[i] = (unsigned)(R * ld + C) * 2u; voffB[i] = (unsigned)(Rb * ld + C) * 2u; }
    const size_t kstep = (size_t)(BK * 2);
    const size_t hstep = (size_t)HALF * ld * 2;
    const size_t tstep = 2 * hstep;
    const unsigned ldsw = (unsigned)wid * 1024u;
    const int aoff = lds_byte(wr * 64 + fr, fq * 8), boff = lds_byte(wc * 32 + fr, fq * 8);
#define PG8_SA(b, h) (((b) * 2 + (h)) * HTB)
#define PG8_SB(b, h) ((4 + (b) * 2 + (h)) * HTB)
#define PG8_STAGE(bufoff, gbase, voff) do { _Pragma("unroll") for (int _i = 0; _i < 2; ++_i) \
        __builtin_amdgcn_global_load_lds((const unsigned*)((const char*)(gbase) + (voff)[_i]), (PG8_LAS unsigned*)(lds + (bufoff) + ldsw + _i * 8192), 16, 0, 0); } while (0)
#define PG8_LDA(dst, b, h) do { _Pragma("unroll") for (int m = 0; m < 4; ++m) _Pragma("unroll") for (int k = 0; k < 2; ++k) dst[m][k] = *(const PG8_LAS bf16x8*)(lds + PG8_SA(b, h) + aoff + m * 2048 + k * 1024); } while (0)
#define PG8_LDB(dst, b, h) do { _Pragma("unroll") for (int n = 0; n < 2; ++n) _Pragma("unroll") for (int k = 0; k < 2; ++k) dst[n][k] = *(const PG8_LAS bf16x8*)(lds + PG8_SB(b, h) + boff + n * 2048 + k * 1024); } while (0)
#define PG8_MMA(ai, bj, At, Bt) do { __builtin_amdgcn_s_setprio(1); _Pragma("unroll") for (int m = 0; m < 4; ++m) _Pragma("unroll") for (int n = 0; n < 2; ++n) _Pragma("unroll") for (int k = 0; k < 2; ++k) \
        acc[ai][bj][m][n] = __builtin_amdgcn_mfma_f32_16x16x32_bf16(Bt[n][k], At[m][k], acc[ai][bj][m][n], 0, 0, 0); __builtin_amdgcn_s_setprio(0); } while (0)
#define PG8_WAIT_V(n) asm volatile("s_waitcnt vmcnt(" #n ")" ::: "memory")
#define PG8_WAIT_L(n) asm volatile("s_waitcnt lgkmcnt(" #n ")" ::: "memory")
#define PG8_BAR __builtin_amdgcn_s_barrier()
#define PG8_SCHED __builtin_amdgcn_sched_barrier(0)
    Unit cur, nxt; int ui = 0;
    if (!S.next(0, cur)) return;
#define PG8_UNI(u_) do { (u_).pm = __builtin_amdgcn_readfirstlane((u_).pm); (u_).pn = __builtin_amdgcn_readfirstlane((u_).pn); (u_).ks = __builtin_amdgcn_readfirstlane((u_).ks); } while (0)
    PG8_UNI(cur);
    f32x4 acc[2][2][4][2];
#pragma unroll
    for (int a = 0; a < 2; ++a)
#pragma unroll
        for (int b = 0; b < 2; ++b)
#pragma unroll
            for (int m = 0; m < 4; ++m)
#pragma unroll
                for (int n = 0; n < 2; ++n) acc[a][b][m][n] = (f32x4){0.f, 0.f, 0.f, 0.f};
    bf16x8 At[4][2], B0[2][2], B1[2][2];
    const char* cA = (const char*)g.A + (size_t)cur.pm * tstep + (size_t)cur.ks * K * 2; const char* cB = (const char*)g.Bt + (size_t)cur.pn * tstep + (size_t)cur.ks * K * 2;
    S.a_ready(cur);
    if constexpr (SP2) {
        PG8_STAGE(PG8_SB(0, 0), cB, voffB); PG8_STAGE(PG8_SB(0, 1), cB + hstep, voffB); PG8_STAGE(PG8_SA(0, 0), cA, voffA); PG8_STAGE(PG8_SA(0, 1), cA + hstep, voffA);
        pre();
        if (wr == 1) PG8_BAR;
        PG8_WAIT_V(2); PG8_BAR;
        PG8_STAGE(PG8_SB(1, 0), cB + kstep, voffB); PG8_STAGE(PG8_SA(1, 0), cA + kstep, voffA); PG8_STAGE(PG8_SB(1, 1), cB + hstep + kstep, voffB);
        PG8_WAIT_V(6); PG8_BAR;
    } else {
        PG8_STAGE(PG8_SB(0, 0), cB, voffB); PG8_STAGE(PG8_SA(0, 0), cA, voffA); PG8_STAGE(PG8_SB(0, 1), cB + hstep, voffB); PG8_STAGE(PG8_SA(0, 1), cA + hstep, voffA);
        if (wr == 1) PG8_BAR;
        PG8_WAIT_V(4); PG8_BAR;
        PG8_STAGE(PG8_SB(1, 0), cB + kstep, voffB); PG8_STAGE(PG8_SA(1, 0), cA + kstep, voffA); PG8_STAGE(PG8_SB(1, 1), cB + hstep + kstep, voffB);
        PG8_WAIT_V(6); PG8_BAR;
    }
    for (;;) {
        const bool has_next = S.next(ui + 1, nxt); PG8_UNI(nxt);
        const char* nA = has_next ? (const char*)g.A + (size_t)nxt.pm * tstep + (size_t)nxt.ks * K * 2 : cA; const char* nB = has_next ? (const char*)g.Bt + (size_t)nxt.pn * tstep + (size_t)nxt.ks * K * 2 : cB;
        for (int t = 0; t < nt; t += 2) {
            const bool last = (t == nt - 2);
            const char* a1 = cA + (size_t)(t + 1) * kstep;
            const char* a2 = last ? nA : cA + (size_t)(t + 2) * kstep; const char* b2 = last ? nB : cB + (size_t)(t + 2) * kstep;
            const char* a3 = a2 + kstep; const char* b3 = b2 + kstep;
            if (last && has_next) S.a_ready(nxt);
            if constexpr (SP2) {
            PG8_LDB(B0, 0, 0); PG8_LDB(B1, 0, 1); PG8_SCHED; PG8_LDA(At, 0, 0); PG8_STAGE(PG8_SA(1, 1), a1 + hstep, voffA);
            PG8_WAIT_V(8); PG8_WAIT_L(0); PG8_BAR; PG8_MMA(0, 0, At, B0); PG8_MMA(0, 1, At, B1); PG8_BAR; PG8_SCHED;
            PG8_LDA(At, 0, 1); PG8_STAGE(PG8_SB(0, 0), b2, voffB); PG8_STAGE(PG8_SB(0, 1), b2 + hstep, voffB); PG8_STAGE(PG8_SA(0, 0), a2, voffA);
            PG8_WAIT_V(8); PG8_WAIT_L(0); PG8_BAR; PG8_MMA(1, 0, At, B0); PG8_MMA(1, 1, At, B1); PG8_BAR; PG8_SCHED;
            PG8_LDB(B0, 1, 0); PG8_LDB(B1, 1, 1); PG8_SCHED; PG8_LDA(At, 1, 0); PG8_STAGE(PG8_SA(0, 1), a2 + hstep, voffA);
            PG8_WAIT_V(8); PG8_WAIT_L(0); PG8_BAR; PG8_MMA(0, 0, At, B0); PG8_MMA(0, 1, At, B1); PG8_BAR; PG8_SCHED;
            PG8_LDA(At, 1, 1); PG8_STAGE(PG8_SB(1, 0), b3, voffB); PG8_STAGE(PG8_SB(1, 1), b3 + hstep, voffB); PG8_STAGE(PG8_SA(1, 0), a3, voffA);
            PG8_WAIT_V(8); PG8_WAIT_L(0); PG8_BAR; PG8_MMA(1, 0, At, B0); PG8_MMA(1, 1, At, B1); PG8_BAR; PG8_SCHED;
            } else {
            PG8_LDB(B0, 0, 0); PG8_SCHED; PG8_LDA(At, 0, 0); PG8_STAGE(PG8_SA(1, 1), a1 + hstep, voffA);
            PG8_WAIT_L(8); PG8_BAR; PG8_WAIT_L(0); PG8_MMA(0, 0, At, B0); PG8_BAR; PG8_SCHED;
            PG8_LDB(B1, 0, 1); PG8_STAGE(PG8_SB(0, 0), b2, voffB);
            PG8_BAR; PG8_WAIT_L(0); PG8_MMA(0, 1, At, B1); PG8_BAR;
            PG8_LDA(At, 0, 1); PG8_STAGE(PG8_SA(0, 0), a2, voffA);
            PG8_BAR; PG8_WAIT_L(0); PG8_MMA(1, 0, At, B0); PG8_BAR; PG8_SCHED;
            PG8_STAGE(PG8_SB(0, 1), b2 + hstep, voffB);
            PG8_WAIT_V(6); PG8_BAR; PG8_MMA(1, 1, At, B1); PG8_BAR;
            PG8_LDB(B0, 1, 0); PG8_SCHED; PG8_LDA(At, 1, 0); PG8_STAGE(PG8_SA(0, 1), a2 + hstep, voffA);
            PG8_WAIT_L(8); PG8_BAR; PG8_WAIT_L(0); PG8_MMA(0, 0, At, B0); PG8_BAR; PG8_SCHED;
            PG8_LDB(B1, 1, 1); PG8_STAGE(PG8_SB(1, 0), b3, voffB);
            PG8_BAR; PG8_WAIT_L(0); PG8_MMA(0, 1, At, B1); PG8_BAR;
            PG8_LDA(At, 1, 1); PG8_STAGE(PG8_SA(1, 0), a3, voffA);
            PG8_BAR; PG8_WAIT_L(0); PG8_MMA(1, 0, At, B0); PG8_BAR; PG8_SCHED;
            PG8_STAGE(PG8_SB(1, 1), b3 + hstep, voffB);
            PG8_WAIT_V(6); PG8_BAR; PG8_MMA(1, 1, At, B1); PG8_BAR;
            }
        }
        if constexpr (ALIGN_EPI) { if (wr == 0) PG8_BAR; }
        if constexpr (!Epi::AFTER_DRAIN) { unsigned ln_e; asm volatile("v_mbcnt_lo_u32_b32 %0, -1, 0\n\tv_mbcnt_hi_u32_b32 %0, -1, %0" : "=v"(ln_e)); const int fr_e = (int)(ln_e & 15u), fq_e = (int)(ln_e >> 4);
            E(acc, cur, wr, wc, fr_e, fq_e);
#ifdef PG8_EPI_TWICE
            if constexpr (Epi::TWICE_OK) { asm volatile("" ::: "memory"); E(acc, cur, wr, wc, fr, fq); }
#endif
            S.done(cur); }
        if (!has_next) break;
        if constexpr (Epi::CARRY) {
            unsigned ln_c; asm volatile("v_mbcnt_lo_u32_b32 %0, -1, 0\n\tv_mbcnt_hi_u32_b32 %0, -1, %0" : "=v"(ln_c)); E.carry(acc, cur, wr, wc, (int)(ln_c & 15u), (int)(ln_c >> 4));
        } else {
#pragma unroll
        for (int a = 0; a < 2; ++a)
#pragma unroll
            for (int b = 0; b < 2; ++b)
#pragma unroll
                for (int m = 0; m < 4; ++m)
#pragma unroll
                    for (int n = 0; n < 2; ++n) acc[a][b][m][n] = (f32x4){0.f, 0.f, 0.f, 0.f};
        }
        cur = nxt; cA = nA; cB = nB; ++ui;
        if constexpr (ALIGN_EPI) { if (wr == 1) PG8_BAR; }
    }
    PG8_WAIT_V(0);
    if constexpr (!ALIGN_EPI) { if (wr == 0) PG8_BAR; }
    PG8_BAR;
    if constexpr (Epi::AFTER_DRAIN) { E.fused(acc, cur, wr, wc, fr, fq, lds, wid, lane); S.done(cur); }
#undef PG8_SA
#undef PG8_SB
#undef PG8_STAGE
#undef PG8_LDA
#undef PG8_LDB
#undef PG8_MMA
#undef PG8_WAIT_V
#undef PG8_WAIT_L
#undef PG8_BAR
#undef PG8_SCHED
}
}


constexpr int NWAVES = 8;
constexpr int DM = 1024, BATCH = 16, SEQ = 2048, MTOK = BATCH * SEQ, HB = 8, MH = HB * SEQ, DFF = 2816, NGU = 2 * DFF, NIN = 6144, DEPTH = 2, KUP = 1152  ;
constexpr int NFOX = 6, NSB = 5, NDSA = 5;
constexpr int C_QA = 0, C_KA = 384, C_VA = 768, C_QB = 1152, C_KB = 1472, C_VB = 1792, C_QC = 2112, C_CKV = 2432, C_QI = 2560, C_GATE = 3072;
constexpr int F_KI = 0, F_FA = 64, F_WI = 70;
constexpr float EPS = 1e-6f;

constexpr size_t MiB = 1u << 20;
constexpr size_t WS_CTL = 0, CTL_ZERO_BYTES = 1 * MiB;
constexpr size_t WS_WGU1 = 2 * MiB, WS_WD1 = 13 * MiB, WS_WIN = 19 * MiB, WS_WUP = 31 * MiB, WS_WOUT = 34 * MiB, WS_WGU2 = 36 * MiB, WS_WD2 = 47 * MiB;
constexpr size_t WS_XB = 54 * MiB;
constexpr size_t WS_SSQ = 118 * MiB;
constexpr int PLD = 3072;
constexpr size_t WS_GI = 216 * MiB;
constexpr size_t WS_P = 120 * MiB;
constexpr size_t WS_HFF = 120 * MiB;
constexpr size_t WS_PF = 312 * MiB;
constexpr size_t WS_Y = 328 * MiB;
constexpr size_t WS_KAI = 364 * MiB, WS_KBI = 376 * MiB;
constexpr size_t WS_MGB = 428 * MiB;
constexpr size_t WS_KC = 460 * MiB, WS_VC = 462 * MiB, WS_KI = 464 * MiB;
constexpr size_t WS_CF = 466 * MiB;
constexpr size_t WS_VTA = 468 * MiB, WS_VTB = 481 * MiB, WS_VTC = 492 * MiB;
constexpr size_t WS_END = 494 * MiB;
constexpr size_t WS_SINK = 960 * 1024;
constexpr int CW_BAR = 4096;
constexpr int MAX_LAUNCHES = 60;

constexpr int RING_OFF = 0, RING_BYTES = 131072;
constexpr int LDSCTL_OFF = RING_BYTES, MISC_OFF = LDSCTL_OFF + 320;
constexpr int VCT_OFF = 132096;
constexpr int RST_OFF = 132096;
constexpr int LDS_BYTES = 147456;

#define GAS __attribute__((address_space(1)))
#define LAS __attribute__((address_space(3)))
typedef unsigned short bf16;
typedef unsigned v4u __attribute__((ext_vector_type(4)));
typedef float f32x4 __attribute__((ext_vector_type(4)));
typedef short bf16x8 __attribute__((ext_vector_type(8)));
typedef GAS unsigned gu32;
typedef GAS unsigned long long gu64;
#define RLX_AGENT __ATOMIC_RELAXED, __HIP_MEMORY_SCOPE_AGENT
#define LDS_WAIT() asm volatile("s_waitcnt lgkmcnt(0)" ::: "memory")
#define VM_WAIT() asm volatile("s_waitcnt vmcnt(0)" ::: "memory")
__device__ __forceinline__ unsigned long long rt() { return __builtin_amdgcn_s_memrealtime(); }
__device__ __forceinline__ unsigned f2bf(float f) { unsigned u = __builtin_bit_cast(unsigned, f); return (u + 0x7fffu + ((u >> 16) & 1u)) >> 16; }
__device__ __forceinline__ unsigned pk2(float lo, float hi) { return f2bf(lo) | (f2bf(hi) << 16); }

#define XB_TMO      128
#define XB_XCNT(j)  (256  + 64 * (j))
#define XB_XSUB(j)  (1280 + 64 * (j))
#define XB_XGEN(j)  (2304 + 64 * (j))
#define XB_TOP      3328
#define XB_TOPGEN   3392
#define XCD_BAR_WORDS 3456
#define XB_SPIN_CAP (1u << 18)

__device__ __forceinline__ unsigned xb_ld(unsigned* p)              { return __hip_atomic_load(p, __ATOMIC_RELAXED, __HIP_MEMORY_SCOPE_AGENT); }
__device__ __forceinline__ unsigned xb_add(unsigned* p, unsigned v) { return __hip_atomic_fetch_add(p, v, __ATOMIC_RELAXED, __HIP_MEMORY_SCOPE_AGENT); }
__device__ __forceinline__ unsigned xb_xcc_id() { return (unsigned)__builtin_amdgcn_s_getreg((3 << 11) | 20) & 0xFu; }
#define XB_SPIN(cond, bar) do { unsigned _sp = 0; while (cond) { __builtin_amdgcn_s_sleep(1); \
    if ((++_sp & 255u) == 0u) { if (xb_ld(&(bar)[XB_TMO])) break; if (_sp > XB_SPIN_CAP) { atomicAdd(&(bar)[XB_TMO], 1u); break; } } } } while (0)

struct XcdBarrier {
    unsigned* bar; unsigned x;
    volatile LAS unsigned* st;
};

__device__ __forceinline__ XcdBarrier xcd_barrier_post(unsigned* bar, volatile LAS unsigned* st, bool leader_thread  ) {
    XcdBarrier b; b.bar = bar; b.x = xb_xcc_id(); b.st = st;
    if (leader_thread) (void)xb_add(&bar[XB_XCNT(b.x)], 1u);
    return b;
}
__device__ __forceinline__ void xcd_barrier_complete(unsigned* bar, unsigned x, unsigned& nloc, unsigned& nx) {
    const unsigned G = gridDim.x * gridDim.y * gridDim.z;
    unsigned sum, cnt, mine, sp = 0u;
    for (;;) {
        sum = 0u; cnt = 0u; mine = 0u;
#pragma unroll
        for (unsigned j = 0; j < 16; ++j) { const unsigned c = xb_ld(&bar[XB_XCNT(j)]); sum += c; cnt += (c > 0u) ? 1u : 0u; mine = (j == x) ? c : mine; }
        if (sum == G) break;
        __builtin_amdgcn_s_sleep(1);
        if ((++sp & 255u) == 0u) { if (xb_ld(&bar[XB_TMO])) break; if (sp > XB_SPIN_CAP) { atomicAdd(&bar[XB_TMO], 1u); break; } }
    }
    nloc = mine > 0u ? mine : 1u; nx = cnt > 0u ? cnt : 1u;
}

__device__ __forceinline__ void xcd_barrier(const XcdBarrier& b, bool leader_thread  ) {
    asm volatile("s_waitcnt vmcnt(0)" ::: "memory");
    __syncthreads();
    if (leader_thread) {
        unsigned* bar = b.bar; unsigned bx_ = b.x; asm volatile("" : "+s"(bar), "+s"(bx_));
        __builtin_amdgcn_s_waitcnt(0);
        unsigned nloc = b.st[0], nx = b.st[1];
        if (nloc == 0u) { xcd_barrier_complete(bar, bx_, nloc, nx); b.st[0] = nloc; b.st[1] = nx; }
        const unsigned old = xb_add(&bar[XB_XSUB(bx_)], 1u);
        const unsigned gen = old / nloc;
        if (old + 1u == (gen + 1u) * nloc) {
            __builtin_amdgcn_fence(__ATOMIC_RELEASE, "agent");
            asm volatile("s_waitcnt vmcnt(0)" ::: "memory");
            const unsigned og = xb_add(&bar[XB_TOP], 1u);
            const unsigned tg = og / nx;
            if (og + 1u == (tg + 1u) * nx) xb_add(&bar[XB_TOPGEN], 1u);
            else XB_SPIN(xb_ld(&bar[XB_TOPGEN]) == tg, bar);
            __builtin_amdgcn_fence(__ATOMIC_ACQUIRE, "agent");
            xb_add(&bar[XB_XGEN(bx_)], 1u);
            asm volatile("s_waitcnt vmcnt(0)" ::: "memory");
        } else {
            XB_SPIN(xb_ld(&bar[XB_XGEN(bx_)]) == gen, bar);
            __builtin_amdgcn_fence(__ATOMIC_ACQUIRE, "agent");
            asm volatile("s_waitcnt vmcnt(0)" ::: "memory");
        }
    }
    __syncthreads();
}


typedef unsigned u32x2 __attribute__((ext_vector_type(2)));
__device__ __forceinline__ float bflo(unsigned w) { return __uint_as_float(w << 16); }
__device__ __forceinline__ float bfhi(unsigned w) { return __uint_as_float(w & 0xffff0000u); }
__device__ __forceinline__ float bf2f(bf16 v) { return __uint_as_float((unsigned)v << 16); }
__device__ __forceinline__ float bperm_f(float v, int srclane) { return __int_as_float(__builtin_amdgcn_ds_bpermute(srclane << 2, __float_as_int(v))); }
__device__ __forceinline__ unsigned bperm_u(unsigned v, int srclane) { return (unsigned)__builtin_amdgcn_ds_bpermute(srclane << 2, (int)v); }
__device__ __forceinline__ float wave_sum(float v, int lane) {
#pragma unroll
    for (int o = 1; o < 64; o <<= 1) v += bperm_f(v, lane ^ o);
    return v;
}
__device__ __forceinline__ float xhalf_max(float v) { auto rr = __builtin_amdgcn_permlane32_swap(__float_as_uint(v), __float_as_uint(v), false, false); return fmaxf(__uint_as_float(rr[0]), __uint_as_float(rr[1])); }
__device__ __forceinline__ float xhalf_sum(float v) { auto rr = __builtin_amdgcn_permlane32_swap(__float_as_uint(v), __float_as_uint(v), false, false); return __uint_as_float(rr[0]) + __uint_as_float(rr[1]); }
__device__ __forceinline__ unsigned xhalf_sum_u(unsigned v) { auto rr = __builtin_amdgcn_permlane32_swap(v, v, false, false); return rr[0] + rr[1]; }
__device__ __forceinline__ float xhalf_other(float v, int hh) { auto rr = __builtin_amdgcn_permlane32_swap(__float_as_uint(v), __float_as_uint(v), false, false); return __uint_as_float(hh ? rr[0] : rr[1]); }
__device__ __forceinline__ v4u pack8_dpp(float v) {
    const float vn = __int_as_float(__builtin_amdgcn_update_dpp(0, __float_as_int(v), 0x101, 0xf, 0xf, true));
    const unsigned u = pk2(v, vn), u2 = (unsigned)__builtin_amdgcn_update_dpp(0, (int)u, 0x102, 0xf, 0xf, true);
    v4u w; w.x = u; w.y = u2; w.z = (unsigned)__builtin_amdgcn_update_dpp(0, (int)u, 0x104, 0xf, 0xf, true); w.w = (unsigned)__builtin_amdgcn_update_dpp(0, (int)u2, 0x104, 0xf, 0xf, true);
    return w;
}
__device__ __forceinline__ float wave_sum_dpp(float v) {
    int x = __float_as_int(v);
    v += __int_as_float(__builtin_amdgcn_update_dpp(0, x, 0xB1, 0xf, 0xf, true)); x = __float_as_int(v);
    v += __int_as_float(__builtin_amdgcn_update_dpp(0, x, 0x4E, 0xf, 0xf, true)); x = __float_as_int(v);
    v += __int_as_float(__builtin_amdgcn_update_dpp(0, x, 0x141, 0xf, 0xf, true)); x = __float_as_int(v);
    v += __int_as_float(__builtin_amdgcn_update_dpp(0, x, 0x140, 0xf, 0xf, true)); x = __float_as_int(v);
    v += __int_as_float(__builtin_amdgcn_update_dpp(0, x, 0x142, 0xa, 0xf, false)); x = __float_as_int(v);
    v += __int_as_float(__builtin_amdgcn_update_dpp(0, x, 0x143, 0xc, 0xf, false));
    return __int_as_float(__builtin_amdgcn_readlane(__float_as_int(v), 63));
}
__device__ __forceinline__ void rope_cs(int pos, int i, float& c, float& s) {
    const float cf = i == 0 ? 0.15915494309189535f : i == 1 ? 0.03086376340470123f : i == 2 ? 0.005985185712713705f : i == 3 ? 0.001160663641240061f
                   : i == 4 ? 0.00022507907903927653f : i == 5 ? 4.364795279280289e-05f : i == 6 ? 8.464330808241401e-06f : 1.6414262627950345e-06f;
    const float hi = __uint_as_float(__float_as_uint(cf) & 0xfffff000u), lo = cf - hi;
    const float p = (float)pos; const float a = p * hi; float r = a - floorf(a); r += p * lo;
    s = __builtin_amdgcn_sinf(r); c = __builtin_amdgcn_cosf(r);
}

template <int MODE> __device__ __forceinline__ int colmap(int n) {
    if (MODE == 0) return n;
    if (MODE == 1) { const int t = n >> 8, r = n & 255; return r < 128 ? t * 128 + r : DFF + t * 128 + (r - 128); }
    if (n < 1152) return n;
    if (n < 2880) return n + 6;
    if (n < 2886) return n - 2880 + 1152;
    if (n < 2890) return n;
    if (n < 3072) return -1;
    return n - 182;
}
template <int MODE> __device__ __forceinline__ float colscale(int n) {
    if (MODE != 2) return 1.0f;
    if (n < 384 || (n >= 2112 && n < 2432)) return 0.125f * 1.4426950408889634f;
    if (n >= 1152 && n < 1472) return 0.125f;
    return 1.0f;
}
template <int MODE> __device__ __forceinline__ void conv_job(const float* W, int Nsrc, int Ksrc, const float* gain, bf16* WT, int Ndst, int Kdst, LAS float* scr, int gw, int ngw, int lane, int& coff, int ldd = 0) {
    if (ldd == 0) ldd = Kdst;
    const int nblk = Ndst / 32, nitems = (Kdst / 64) * nblk;
    int it0 = gw - coff; if (it0 < 0) it0 += ngw;
    coff = (coff + nitems) % ngw;
    for (int it = it0; it < nitems; it += ngw) {
        const int kb = it / nblk, nb = it % nblk, k0 = 64 * kb, n0 = 32 * nb;
        const int sc = colmap<MODE>(n0 + (lane & 31));
        float wv_[32];
#pragma unroll
        for (int i = 0; i < 32; ++i) { const int k = k0 + 2 * i + (lane >> 5); wv_[i] = (sc >= 0 && k < Ksrc) ? W[(size_t)k * Nsrc + sc] : 0.f; }
        if (gain) {
#pragma unroll
            for (int i = 0; i < 32; ++i) { const int k = k0 + 2 * i + (lane >> 5); wv_[i] *= k < Ksrc ? gain[k] : 0.f; } }
        if (MODE == 2) { const float cs = colscale<MODE>(n0 + (lane & 31));
#pragma unroll
            for (int i = 0; i < 32; ++i) wv_[i] *= cs; }
#pragma unroll
        for (int i = 0; i < 32; ++i) scr[(2 * i + (lane >> 5)) * 33 + (lane & 31)] = wv_[i];
        LDS_WAIT(); asm volatile("" ::: "memory");
        const int c = lane & 7;
#pragma unroll
        for (int j = 0; j < 4; ++j) { const int n = (lane >> 3) + 8 * j; const LAS float* s = scr + (8 * c) * 33 + n;
            v4u o; o.x = pk2(s[0 * 33], s[1 * 33]); o.y = pk2(s[2 * 33], s[3 * 33]); o.z = pk2(s[4 * 33], s[5 * 33]); o.w = pk2(s[6 * 33], s[7 * 33]);
            *(GAS v4u*)(WT + (size_t)(n0 + n) * ldd + k0 + 8 * c) = o; }
        LDS_WAIT(); asm volatile("" ::: "memory");
    }
}


typedef short bf16x8 __attribute__((ext_vector_type(8)));
typedef float f32x16 __attribute__((ext_vector_type(16)));
typedef float f32x2_t __attribute__((ext_vector_type(2))); typedef __bf16 bf16x2_t __attribute__((ext_vector_type(2)));
__device__ __forceinline__ unsigned cvtpk(float lo, float hi) { f32x2_t v = {lo, hi}; bf16x2_t b = __builtin_convertvector(v, bf16x2_t); return __builtin_bit_cast(unsigned, b); }
#define MFMA32(a, b, c) __builtin_amdgcn_mfma_f32_32x32x16_bf16((a), (b), (c), 0, 0, 0)
__device__ __forceinline__ int crow(int i, int hh) { return (i & 3) + 8 * (i >> 2) + 4 * hh; }
__device__ __forceinline__ bf16x8 ldg16(const bf16* p) { return *(const GAS bf16x8*)p; }
__device__ __forceinline__ bf16x8 pack8(const f32x16& x, int s) {
    v4u p; p.x = cvtpk(x[8 * s + 0], x[8 * s + 1]); p.y = cvtpk(x[8 * s + 2], x[8 * s + 3]); p.z = cvtpk(x[8 * s + 4], x[8 * s + 5]); p.w = cvtpk(x[8 * s + 6], x[8 * s + 7]);
    return __builtin_bit_cast(bf16x8, p);
}
__device__ __forceinline__ void store_ot(bf16* yrow, const f32x16 (&o)[2], float scale, int hh) {
#pragma unroll
    for (int dt = 0; dt < 2; ++dt)
#pragma unroll
        for (int gp = 0; gp < 2; ++gp) {
            unsigned a0 = cvtpk(o[dt][8 * gp + 0] * scale, o[dt][8 * gp + 1] * scale), a1 = cvtpk(o[dt][8 * gp + 2] * scale, o[dt][8 * gp + 3] * scale);
            unsigned b0 = cvtpk(o[dt][8 * gp + 4] * scale, o[dt][8 * gp + 5] * scale), b1 = cvtpk(o[dt][8 * gp + 6] * scale, o[dt][8 * gp + 7] * scale);
            auto r0 = __builtin_amdgcn_permlane32_swap(a0, b0, false, false); auto r1 = __builtin_amdgcn_permlane32_swap(a1, b1, false, false);
            v4u w; w.x = r0[0]; w.y = r1[0]; w.z = r0[1]; w.w = r1[1];
            *(GAS v4u*)(yrow + 32 * dt + 16 * gp + 8 * hh) = w; }
}
constexpr float LOG2E = 1.4426950408889634f, LN2 = 0.6931471805599453f;

#define FOX_LOAD(KF, VF, kt_) do { _Pragma("unroll") for (int s_ = 0; s_ < 4; ++s_) KF[s_] = ldg16(kb + (size_t)2048 * (kt_) + 512 * s_); \
    _Pragma("unroll") for (int d_ = 0; d_ < 2; ++d_) _Pragma("unroll") for (int s_ = 0; s_ < 2; ++s_) VF[d_][s_] = ldg16(vb + (size_t)2048 * (kt_) + 512 * (2 * d_ + s_)); } while (0)
#define FOX_REF 24.0f
#define FOX_STEP(KF, VF, NKF, NVF, kt_) do { \
    { const int kn_ = (kt_) + 2 <= qs ? (kt_) + 2 : qs; FOX_LOAD(NKF, NVF, kn_); } \
    f32x4 cf_[4]; _Pragma("unroll") for (int g_ = 0; g_ < 4; ++g_) cf_[g_] = *(const LAS f32x4*)(cfL + 32 * (kt_) + 8 * g_ + 4 * hh); \
    f32x16 sacc; _Pragma("unroll") for (int i = 0; i < 16; ++i) sacc[i] = cf_[i >> 2][i & 3] - rt;        \
    _Pragma("unroll") for (int s_ = 0; s_ < 4; ++s_) sacc = MFMA32(KF[s_], qf[s_], sacc); \
    if ((kt_) == qs) { _Pragma("unroll") for (int i = 0; i < 16; ++i) { float p = __builtin_amdgcn_exp2f(sacc[i]); if (crow(i, hh) > r) p = 0.f; sacc[i] = p; l += p; } } \
    else { _Pragma("unroll") for (int i = 0; i < 16; ++i) { const float p = __builtin_amdgcn_exp2f(sacc[i]); sacc[i] = p; l += p; } } \
    const bf16x8 p0 = pack8(sacc, 0), p1 = pack8(sacc, 1); \
    _Pragma("unroll") for (int d_ = 0; d_ < 2; ++d_) { o[d_] = MFMA32(VF[d_][0], p0, o[d_]); o[d_] = MFMA32(VF[d_][1], p1, o[d_]); } } while (0)
__device__ __forceinline__ void fox_strip(const bf16* P, const bf16* KAI, const LAS float* cfL, const bf16* VTA, bf16* YA, int b, int h, int qs, int lane) {
    const int r = lane & 31, hh = lane >> 5;
    const size_t rowq = (size_t)b * SEQ + qs * 32 + r;
    bf16x8 qf[4];
#pragma unroll
    for (int s = 0; s < 4; ++s) qf[s] = ldg16(P + rowq * PLD + C_QA + h * 64 + 16 * s + 8 * hh);
    const float rt = cfL[qs * 32 + r] + FOX_REF;
    const bf16* kb = KAI + (size_t)(b * NFOX + h) * 64 * SEQ + 8 * lane;
    const bf16* vb = VTA + (size_t)(b * NFOX + h) * 64 * SEQ + 8 * lane;
    f32x16 o[2]; o[0] = f32x16{}; o[1] = f32x16{};
    float l = 0.f;
    bf16x8 kA[4], vA[2][2], kB[4], vB[2][2], kC[4], vC[2][2];
    FOX_LOAD(kA, vA, 0); { const int k1 = qs >= 1 ? 1 : 0; FOX_LOAD(kB, vB, k1); }
    for (int kt = 0; kt <= qs; kt += 3) {
        FOX_STEP(kA, vA, kC, vC, kt);
        if (kt + 1 > qs) break;
        FOX_STEP(kB, vB, kA, vA, kt + 1);
        if (kt + 2 > qs) break;
        FOX_STEP(kC, vC, kB, vB, kt + 2);
    }
    l = xhalf_sum(l);
    store_ot(YA + rowq * KUP + h * 64, o, 1.0f / l, hh);
}

__device__ __forceinline__ void sb_strip(const bf16* P, const bf16* KBI, const bf16* VTB, bf16* YB, int b, int h, int qs, int lane) {
    const int r = lane & 31, hh = lane >> 5;
    const size_t rowq = (size_t)b * SEQ + qs * 32 + r;
    bf16x8 qf[4];
#pragma unroll
    for (int s = 0; s < 4; ++s) qf[s] = ldg16(P + rowq * PLD + C_QB + h * 64 + 16 * s + 8 * hh);
    const bf16* kb = KBI + (size_t)(b * NSB + h) * 64 * SEQ + 8 * lane;
    const bf16* vb = VTB + (size_t)(b * NSB + h) * 64 * SEQ + 8 * lane;
    f32x16 o[2]; o[0] = f32x16{}; o[1] = f32x16{};
    float R = 0.f;
    bf16x8 kf[4], vf[2][2];
#pragma unroll
    for (int s = 0; s < 4; ++s) kf[s] = ldg16(kb + (size_t)2048 * qs + 512 * s);
#pragma unroll
    for (int dt = 0; dt < 2; ++dt)
#pragma unroll
        for (int s = 0; s < 2; ++s) vf[dt][s] = ldg16(vb + (size_t)2048 * qs + 512 * (2 * dt + s));
    asm volatile("" ::: "memory");
    for (int kt = qs; kt >= 0; --kt) {
        bf16x8 nk[4], nv[2][2];
        const int kn = kt > 0 ? kt - 1 : 0;
#pragma unroll
        for (int s = 0; s < 4; ++s) nk[s] = ldg16(kb + (size_t)2048 * kn + 512 * s);
#pragma unroll
        for (int dt = 0; dt < 2; ++dt)
#pragma unroll
            for (int s = 0; s < 2; ++s) nv[dt][s] = ldg16(vb + (size_t)2048 * kn + 512 * (2 * dt + s));
        asm volatile("" ::: "memory");
        f32x16 z = f32x16{};
#pragma unroll
        for (int s = 0; s < 4; ++s) z = MFMA32(kf[s], qf[s], z);
        f32x16 sp;
#pragma unroll
        for (int i = 0; i < 16; ++i) { const float zz = z[i]; const float e = __builtin_amdgcn_exp2f(-fabsf(zz) * LOG2E); float s_ = fmaxf(zz, 0.f) + LN2 * __builtin_amdgcn_logf(1.0f + e);
            const bool valid = (kt < qs) || (crow(i, hh) < r); sp[i] = valid ? s_ : 0.f; z[i] = valid ? zz - s_ : -INFINITY; }
        float tg[4], tp[4];
#pragma unroll
        for (int g = 0; g < 4; ++g) { tg[g] = (sp[4 * g] + sp[4 * g + 1]) + (sp[4 * g + 2] + sp[4 * g + 3]); tp[g] = xhalf_other(tg[g], hh); }
        float above = R;
#pragma unroll
        for (int g = 3; g >= 0; --g) {
            const float ab = above + (hh == 0 ? tp[g] : 0.f);
            const float w3 = ab, w2 = w3 + sp[4 * g + 3], w1 = w2 + sp[4 * g + 2], w0 = w1 + sp[4 * g + 1];
            z[4 * g + 3] = __builtin_amdgcn_exp2f((z[4 * g + 3] - w3) * LOG2E); z[4 * g + 2] = __builtin_amdgcn_exp2f((z[4 * g + 2] - w2) * LOG2E);
            z[4 * g + 1] = __builtin_amdgcn_exp2f((z[4 * g + 1] - w1) * LOG2E); z[4 * g + 0] = __builtin_amdgcn_exp2f((z[4 * g + 0] - w0) * LOG2E);
            above += tg[g] + tp[g];
        }
        R = above;
        const bf16x8 p0 = pack8(z, 0), p1 = pack8(z, 1);
#pragma unroll
        for (int dt = 0; dt < 2; ++dt) { o[dt] = MFMA32(vf[dt][0], p0, o[dt]); o[dt] = MFMA32(vf[dt][1], p1, o[dt]); }
        if (__all(R > 104.0f)) break;
#pragma unroll
        for (int s = 0; s < 4; ++s) kf[s] = nk[s];
#pragma unroll
        for (int dt = 0; dt < 2; ++dt)
#pragma unroll
            for (int s = 0; s < 2; ++s) vf[dt][s] = nv[dt][s];
    }
    store_ot(YB + rowq * KUP + h * 64, o, 1.0f, hh);
}

template <int NH> __device__ __forceinline__ void dsa_attend(f32x16 (&o)[NH][2], float (&m)[NH], float (&l)[NH], const bf16* kcb, const bf16* vtb, const LAS unsigned char* qcl, int hbase,
                                                              const unsigned (&selm)[4], int ntiles, int wave) {
    const float SC = 0.125f * LOG2E;
#pragma unroll
    for (int h = 0; h < NH; ++h) { o[h][0] = f32x16{}; o[h][1] = f32x16{}; m[h] = 0.f; l[h] = 0.f; }
#define DSA_LOADKV(KF, VF, j_) do { _Pragma("unroll") for (int s_ = 0; s_ < 4; ++s_) KF[s_] = ldg16(kcb + (size_t)2048 * (j_) + 512 * s_); \
    _Pragma("unroll") for (int d_ = 0; d_ < 2; ++d_) _Pragma("unroll") for (int s_ = 0; s_ < 2; ++s_) VF[d_][s_] = ldg16(vtb + (size_t)2048 * (j_) + 512 * (2 * d_ + s_)); } while (0)
    bf16x8 kc[4], vt[2][2];
    if (wave < ntiles) DSA_LOADKV(kc, vt, wave);
    asm volatile("" ::: "memory");
    __builtin_amdgcn_s_waitcnt(0x0F70);
#pragma unroll 1
    for (int sl = 0; sl < 8; ++sl) {
        const int j = sl * 8 + wave;
        if (j < ntiles) {
            const int jn = j + 8 < ntiles ? j + 8 : j;
            const unsigned sw = sl < 2 ? selm[0] : sl < 4 ? selm[1] : sl < 6 ? selm[2] : selm[3];
            const unsigned bits = sw >> ((sl & 1) * 16);
            f32x16 minit;
#pragma unroll
            for (int i = 0; i < 16; ++i) minit[i] = ((bits >> i) & 1u) ? -FOX_REF : -INFINITY;
            f32x16 sa[NH];
#pragma unroll
            for (int h = 0; h < NH; ++h) { sa[h] = minit;
#pragma unroll
                for (int s = 0; s < 4; ++s) sa[h] = MFMA32(kc[s], *(const LAS bf16x8*)(qcl + ((hbase + h) * 64 + 16 * s) * 2), sa[h]); }
            asm volatile("" ::: "memory");
#pragma unroll
            for (int s_ = 0; s_ < 4; ++s_) kc[s_] = ldg16(kcb + (size_t)2048 * jn + 512 * s_);
            asm volatile("" ::: "memory");
#pragma unroll
            for (int i = 0; i < 16; ++i)
#pragma unroll
                for (int h = 0; h < NH; ++h) { const float p = __builtin_amdgcn_exp2f(sa[h][i]); sa[h][i] = p; l[h] += p; }
#pragma unroll
            for (int h = 0; h < NH; ++h) { const bf16x8 p0 = pack8(sa[h], 0), p1 = pack8(sa[h], 1);
#pragma unroll
                for (int dt = 0; dt < 2; ++dt) { o[h][dt] = MFMA32(vt[dt][0], p0, o[h][dt]); o[h][dt] = MFMA32(vt[dt][1], p1, o[h][dt]); } }
            asm volatile("" ::: "memory");
#pragma unroll
            for (int d_ = 0; d_ < 2; ++d_)
#pragma unroll
                for (int s_ = 0; s_ < 2; ++s_) vt[d_][s_] = ldg16(vtb + (size_t)2048 * jn + 512 * (2 * d_ + s_));
            asm volatile("" ::: "memory");
        }
    }
#undef DSA_LOADKV
#pragma unroll
    for (int h = 0; h < NH; ++h) l[h] = xhalf_sum(l[h]);
}
__device__ __forceinline__ void dsa_combine(const f32x16 (&o)[2], float m, float l, LAS float* Ml, LAS float* Ob, bf16* yq, int h5, int wave, int lane) {
    const int r = lane & 31, hh = lane >> 5;
    if (lane < 32) { Ml[(wave * 2 + 0) * 32 + r] = m; Ml[(wave * 2 + 1) * 32 + r] = l; }
#pragma unroll
    for (int dt = 0; dt < 2; ++dt)
#pragma unroll
        for (int i = 0; i < 16; ++i) Ob[(wave * 64 + 32 * dt + crow(i, hh)) * 32 + r] = o[dt][i];
    __syncthreads();
    {
        float ls = 0.f, acc4[4] = {0.f, 0.f, 0.f, 0.f};
#pragma unroll
        for (int w = 0; w < 8; ++w) { ls += Ml[(w * 2 + 1) * 32 + r];
#pragma unroll
            for (int e = 0; e < 4; ++e) acc4[e] += Ob[(w * 64 + 8 * wave + 4 * hh + e) * 32 + r]; }
        const float il = 1.0f / ls;
        u32x2 wv; wv.x = cvtpk(acc4[0] * il, acc4[1] * il); wv.y = cvtpk(acc4[2] * il, acc4[3] * il);
        *(GAS u32x2*)(yq + h5 * 64 + 8 * wave + 4 * hh) = wv;
    }
    __syncthreads();
}
__device__ __forceinline__ unsigned wg_sum32(unsigned c, LAS unsigned* cnt, int& seq, int wave, int r, int lane) {
    c = xhalf_sum_u(c);
    const int buf = seq & 1; ++seq;
    if (lane < 32) cnt[(buf * 8 + wave) * 32 + r] = c;
    __syncthreads();
    unsigned t = 0;
#pragma unroll
    for (int w = 0; w < 8; ++w) t += cnt[(buf * 8 + w) * 32 + r];
    return t;
}
__device__ __forceinline__ void dsa_unit(const bf16* P, const float* Pf, const bf16* KI, const bf16* KC, const bf16* VTC, bf16* YC, int b, int g, int wave, int lane, LAS unsigned char* lds) {
    asm volatile("" : "+v"(lane), "+s"(wave));
    const int r = lane & 31, hh = lane >> 5;
    const int N = 64 * (g / 2 + 1), ntiles = N / 32;
    const size_t rowq = (size_t)b * SEQ + 32 * g + r;
    LAS unsigned* cnt = (LAS unsigned*)lds; LAS float* Ml = (LAS float*)(lds + 2048); LAS float* Ob = (LAS float*)(lds + 4096);
    LAS unsigned char* QiL = lds + 69632;
    LAS unsigned char* QcL = lds + 86528;
    int seq = 0;
    {
        const int t = wave * 64 + lane;
        v4u qs_[5];
#pragma unroll
        for (int i = 0; i < 2; ++i) { const int c = t + 512 * i, row = c >> 5, ch = c & 31; qs_[i] = *(const GAS v4u*)(P + ((size_t)b * SEQ + 32 * g + row) * PLD + C_QI + 8 * ch); }
#pragma unroll
        for (int i = 0; i < 3; ++i) { const int c = t + 512 * i < 32 * 40 ? t + 512 * i : 0; const int row = c / 40, ch = c % 40; qs_[2 + i] = *(const GAS v4u*)(P + ((size_t)b * SEQ + 32 * g + row) * PLD + C_QC + 8 * ch); }
#pragma unroll
        for (int i = 0; i < 2; ++i) { const int c = t + 512 * i, row = c >> 5, ch = c & 31; *(LAS v4u*)(QiL + row * 528 + ch * 16) = qs_[i]; }
#pragma unroll
        for (int i = 0; i < 3; ++i) { const int c = t + 512 * i; if (c < 32 * 40) { const int row = c / 40, ch = c % 40; *(LAS v4u*)(QcL + row * 656 + ch * 16) = qs_[2 + i]; } }
    }
    const float w0 = Pf[rowq * 256 + F_WI + 0], w1 = Pf[rowq * 256 + F_WI + 1], w2 = Pf[rowq * 256 + F_WI + 2], w3 = Pf[rowq * 256 + F_WI + 3];
    __syncthreads();
    unsigned key[8][16];
    const bf16* kib = KI + (size_t)b * SEQ * 64 + 8 * lane;
    bf16x8 kf[4];
    if (wave < ntiles) {
#pragma unroll
        for (int s = 0; s < 4; ++s) kf[s] = ldg16(kib + (size_t)2048 * wave + 512 * s); }
    asm volatile("" ::: "memory");
    __builtin_amdgcn_s_waitcnt(0x0F70);
#pragma unroll
    for (int sl = 0; sl < 8; ++sl) {
        const int j = sl * 8 + wave;
        if (j < ntiles) {
            bf16x8 kn[4];
            { const int jn = j + 8 < ntiles ? j + 8 : j;
#pragma unroll
              for (int s = 0; s < 4; ++s) kn[s] = ldg16(kib + (size_t)2048 * jn + 512 * s); }
            asm volatile("" ::: "memory");
            float sc[16];
#pragma unroll
            for (int hp = 0; hp < 2; ++hp) {
                f32x16 accA = f32x16{}, accB = f32x16{};
#pragma unroll
                for (int s = 0; s < 4; ++s) { accA = MFMA32(kf[s], *(const LAS bf16x8*)(QiL + r * 528 + ((2 * hp) * 64 + 16 * s + 8 * hh) * 2), accA);
                                              accB = MFMA32(kf[s], *(const LAS bf16x8*)(QiL + r * 528 + ((2 * hp + 1) * 64 + 16 * s + 8 * hh) * 2), accB); }
                const float wA = hp == 0 ? w0 : w2, wB = hp == 0 ? w1 : w3;
#pragma unroll
                for (int i = 0; i < 16; ++i) { const float t = hp == 0 ? wA * fmaxf(accA[i], 0.f) : fmaf(wA, fmaxf(accA[i], 0.f), sc[i]); sc[i] = fmaf(wB, fmaxf(accB[i], 0.f), t); }
            }
#pragma unroll
            for (int i = 0; i < 16; ++i) { const unsigned ub = __float_as_uint(sc[i] + 0.0f); key[sl][i] = (ub & 0x80000000u) ? ~ub : (ub | 0x80000000u); }
#pragma unroll
            for (int s = 0; s < 4; ++s) kf[s] = kn[s];
        } else {
#pragma unroll
            for (int i = 0; i < 16; ++i) key[sl][i] = 0u;
        }
    }
#ifndef DSA_REP_ATT
#define DSA_REP_ATT 1
#endif
    unsigned T = 0u; bool tie = false;
    if (N > 256) {
        LAS unsigned* hist = (LAS unsigned*)(lds + 4096);
        LAS unsigned* res = (LAS unsigned*)lds;
        const int tw = wave * 64 + lane;
        if (tw < 32) res[32 + tw] = 256u;
        bool done = false; unsigned need = 256u, ceq = 0u;
#pragma unroll 1
        for (int sh = 24; sh >= 0; sh -= 8) {
            for (int i = tw; i < 32 * 257; i += 512) hist[i] = 0u;
            __syncthreads();
            if (!done) {
                LAS unsigned* hq = hist + r * 257;
#pragma unroll
                for (int sl = 0; sl < 8; ++sl) if (sl * 8 + wave < ntiles) {
#pragma unroll
                    for (int i = 0; i < 16; ++i) { const unsigned k = key[sl][i];
                        if (sh == 24 || (k >> ((sh + 8) & 31)) == (T >> ((sh + 8) & 31))) { __hip_atomic_fetch_add(hq + ((k >> sh) & 255u), 1u, __ATOMIC_RELAXED, __HIP_MEMORY_SCOPE_WORKGROUP);
#ifdef PROBE_AT2
                            __hip_atomic_fetch_add(hq + 9216 + ((k >> sh) & 255u), 1u, __ATOMIC_RELAXED, __HIP_MEMORY_SCOPE_WORKGROUP);
#endif
                        } } }
            }
            __syncthreads();
#pragma unroll
            for (int qi = 0; qi < 4; ++qi) {
                const int q = 4 * wave + qi; const LAS unsigned* hq = hist + q * 257 + 4 * lane;
                const unsigned h0 = hq[0], h1 = hq[1], h2 = hq[2], h3 = hq[3], sl_ = (h0 + h1) + (h2 + h3);
                unsigned v = sl_;
#pragma unroll
                for (int o = 1; o < 64; o <<= 1) { const unsigned n = bperm_u(v, lane + o); if (lane + o < 64) v += n; }
                const unsigned E = v - sl_, nd = res[32 + q];
                if (E < nd && nd <= E + sl_) {
                    unsigned cum = E, dg, hb;
                    if (cum + h3 >= nd) { dg = 3; hb = h3; } else { cum += h3; if (cum + h2 >= nd) { dg = 2; hb = h2; } else { cum += h2; if (cum + h1 >= nd) { dg = 1; hb = h1; } else { cum += h1; dg = 0; hb = h0; } } }
                    res[q] = (4u * lane + dg) | ((cum + hb == nd) ? 256u : 0u); res[32 + q] = nd - cum; res[64 + q] = hb;
                }
            }
            __syncthreads();
            if (!done) { const unsigned rr = res[r]; T |= (rr & 255u) << sh; need = res[32 + r]; ceq = res[64 + r]; done = (rr & 256u) != 0u; }
            if (!__any(!done)) break;
        }
        tie = !done && ceq > need;
    }
    unsigned selm[4], tm[4];
#pragma unroll
    for (int q = 0; q < 4; ++q) { selm[q] = 0u; tm[q] = 0u; }
#pragma unroll
    for (int sl = 0; sl < 8; ++sl)
#pragma unroll
        for (int i = 0; i < 16; ++i) { selm[sl >> 1] |= (key[sl][i] > T ? 1u : 0u) << ((sl & 1) * 16 + i); tm[sl >> 1] |= (key[sl][i] == T ? 1u : 0u) << ((sl & 1) * 16 + i); }
    int J = 4095;
    if (N > 256 && __any(tie)) {
        LAS unsigned* res = (LAS unsigned*)lds;
        LAS unsigned* cntL = (LAS unsigned*)(lds + 4096);
#pragma unroll
        for (int sl = 0; sl < 8; ++sl) { const unsigned c = xhalf_sum_u((unsigned)__builtin_popcount((tm[sl >> 1] >> ((sl & 1) * 16)) & 0xffffu)); if (hh == 0) cntL[r * 64 + sl * 8 + wave] = c; }
        __syncthreads();
#pragma unroll
        for (int qi = 0; qi < 4; ++qi) {
            const int q = 4 * wave + qi; const unsigned c = cntL[q * 64 + lane]; unsigned v = c;
#pragma unroll
            for (int o = 1; o < 64; o <<= 1) { const unsigned n = bperm_u(v, lane - o); if (lane >= o) v += n; }
            const unsigned nd = res[32 + q], ex = v - c;
            if (ex < nd && nd <= v) res[96 + q] = (unsigned)lane | ((nd - ex) << 8);
        }
        __syncthreads();
        const unsigned rj = res[96 + r]; const int Jt = (int)(rj & 255u), nn = (int)(rj >> 8);
        { const int st = Jt >> 3; const unsigned wsel = st < 2 ? tm[0] : st < 4 ? tm[1] : st < 6 ? tm[2] : tm[3]; const unsigned m16 = (wsel >> ((st & 1) * 16)) & 0xffffu;
          const unsigned mo = xhalf_sum_u(m16) - m16;
          const unsigned m0 = hh ? mo : m16, m1 = hh ? m16 : mo;
          unsigned rm = 0u;
#pragma unroll
          for (int g4 = 0; g4 < 4; ++g4) rm |= (((m0 >> (4 * g4)) & 15u) << (8 * g4)) | (((m1 >> (4 * g4)) & 15u) << (8 * g4 + 4));
          int p = 0;
#pragma unroll
          for (int bs = 16; bs >= 1; bs >>= 1) { if (__builtin_popcount(rm & ((1u << (p + bs)) - 1u)) < nn) p += bs; }
          if (tie && wave == (Jt & 7) && hh == 0) res[128 + r] = (unsigned)(32 * Jt + p); }
        __syncthreads();
        if (tie) J = (int)res[128 + r];
    }
    {
        const int Jt = J >> 5, Jr = J & 31; unsigned rm16 = 0u;
#pragma unroll
        for (int g4 = 0; g4 < 4; ++g4) { int n = Jr - 8 * g4 - 4 * hh + 1; n = n < 0 ? 0 : n > 4 ? 4 : n; rm16 |= ((1u << n) - 1u) << (4 * g4); }
#pragma unroll
        for (int sl = 0; sl < 8; ++sl) { const int j = sl * 8 + wave; const unsigned lm = j < Jt ? 0xffffu : j > Jt ? 0u : rm16; selm[sl >> 1] |= tm[sl >> 1] & (lm << ((sl & 1) * 16)); }
    }
    const bf16* kcb = KC + (size_t)b * SEQ * 64 + 8 * lane;
    const bf16* vtb = VTC + (size_t)b * 64 * SEQ + 8 * lane;
    const LAS unsigned char* qcl = QcL + r * 656 + 16 * hh;
    bf16* yq = YC + rowq * KUP;
    { f32x16 o[3][2]; float m[3], l[3]; dsa_attend<3>(o, m, l, kcb, vtb, qcl, 0, selm, ntiles, wave);
      dsa_combine(o[0], m[0], l[0], Ml, Ob, yq, 0, wave, lane); dsa_combine(o[1], m[1], l[1], Ml, Ob, yq, 1, wave, lane); dsa_combine(o[2], m[2], l[2], Ml, Ob, yq, 2, wave, lane); }
    { f32x16 o[2][2]; float m[2], l[2]; dsa_attend<2>(o, m, l, kcb, vtb, qcl, 3, selm, ntiles, wave);
      dsa_combine(o[0], m[0], l[0], Ml, Ob, yq, 3, wave, lane); dsa_combine(o[1], m[1], l[1], Ml, Ob, yq, 4, wave, lane); }
}


struct Args { const float* in[18]; float* out; unsigned char* ws; int ph_lo, ph_hi, li, pad; };

static_assert(pg8::EpiWin::KA0 == C_KA && pg8::EpiWin::KB0 == C_KB && pg8::EpiWin::NHA == NFOX && pg8::EpiWin::NHB == NSB && pg8::EpiWin::SEQL == SEQ && pg8::EpiWin::KAI_OFF == (long)(WS_KAI - WS_P) && pg8::EpiWin::KBI_OFF == (long)(WS_KBI - WS_P) && pg8::EpiWin::GI_OFF == (long)(WS_GI - WS_P), "EpiWin's copy of the layout constants");
__global__ void __launch_bounds__(NWAVES * 64, 2) mk_fwd(Args args) {
    extern __shared__ __attribute__((aligned(16))) unsigned char lds_raw[];
    LAS unsigned char* lds = (LAS unsigned char*)lds_raw;
    volatile LAS unsigned* MISC = (volatile LAS unsigned*)(lds + MISC_OFF);
    const int tid = threadIdx.x, lane0 = tid & 63, wave0 = __builtin_amdgcn_readfirstlane(tid >> 6);
    const int G0 = gridDim.x; const int bx0 = blockIdx.x; const int vcu = (G0 % 8 == 0) ? (bx0 % 8) * (G0 / 8) + bx0 / 8 : bx0;
    const int gw0 = vcu * NWAVES + wave0;
    unsigned char* ws0 = args.ws;
    gu32* ctl = (gu32*)(ws0 + WS_CTL);
    for (int u = tid; u < (LDS_BYTES - LDSCTL_OFF) / 4; u += NWAVES * 64) ((LAS unsigned*)(lds + LDSCTL_OFF))[u] = 0u;
    __syncthreads();
    XcdBarrier bar = xcd_barrier_post((unsigned*)(ctl + CW_BAR) + args.li * XCD_BAR_WORDS, MISC + 8, tid == 0);
    typedef const Args __attribute__((address_space(4)))* kargs_t;
    const kargs_t ka0 = (kargs_t)__builtin_amdgcn_kernarg_segment_ptr();
    const int lo = args.ph_lo, hi = args.ph_hi;
    int layer = 0, f = 0, hf = 0;
#define TX_NOW() ({ unsigned t_; asm volatile("v_mbcnt_lo_u32_b32 %0, -1, 0\n\tv_mbcnt_hi_u32_b32 %0, -1, %0" : "=v"(t_)); t_ | ((unsigned)wave0 << 6); })
    int ph = 0;
#define PH_BEGIN if (ph >= lo && ph < hi) { unsigned char* ws = ws0; kargs_t ka = ka0; unsigned tx_; asm volatile("v_mbcnt_lo_u32_b32 %0, -1, 0\n\tv_mbcnt_hi_u32_b32 %0, -1, %0" : "=v"(tx_)); tx_ |= (unsigned)wave0 << 6; int gw = gw0, G = G0, bx = bx0, Lr = layer; asm volatile("" : "+s"(ws), "+s"(ka), "+v"(tx_), "+s"(gw), "+s"(G), "+s"(bx), "+s"(Lr)); const int lane = (int)(tx_ & 63u), wave = __builtin_amdgcn_readfirstlane((int)(tx_ >> 6)); float* xf = ka->out; unsigned char* wbase = Lr ? (unsigned char*)xf : ws; const int NGW = G * NWAVES;
#define PH_END   if (ph + 1 < hi) xcd_barrier(bar, TX_NOW() == 0u); } ++ph;

#define WGU1 ((bf16*)(wbase + WS_WGU1))
#define WD1 ((bf16*)(wbase + WS_WD1))
#define WIN ((bf16*)(wbase + WS_WIN))
#define WUP ((bf16*)(wbase + WS_WUP))
#define WOUT ((bf16*)(wbase + WS_WOUT))
#define WGU2 ((bf16*)(wbase + WS_WGU2))
#define WD2 ((bf16*)(wbase + WS_WD2))
#define XB ((bf16*)(ws + WS_XB))
#define SSQ ((float*)(ws + WS_SSQ))
#define P ((bf16*)(ws + WS_P))
#define HFF ((bf16*)(ws + WS_HFF))
#define PF ((float*)(ws + WS_PF))
#define YA ((bf16*)(ws + WS_Y))
#define YB ((bf16*)(ws + WS_Y) + 384)
#define YC ((bf16*)(ws + WS_Y) + 768)
#define MGB ((bf16*)(ws + WS_MGB))
#define GI ((bf16*)(ws + WS_GI))
#define KAI ((bf16*)(ws + WS_KAI))
#define KBI ((bf16*)(ws + WS_KBI))
#define KC ((bf16*)(ws + WS_KC))
#define KI ((bf16*)(ws + WS_KI))
#define CF ((float*)(ws + WS_CF))
#define VTA ((bf16*)(ws + WS_VTA))
#define VTB ((bf16*)(ws + WS_VTB))
#define VTC ((bf16*)(ws + WS_VTC))
#define XF (xf)
#define scr ((LAS float*)(lds + RING_OFF + wave * 16384))
#define CONV_FFN(l, which) do { unsigned char* wbase = (l) ? (unsigned char*)xf : ws; const float* gg = ka->in[(which) ? 14 : 1] + (size_t)(l) * DM; const float* wgu = ka->in[(which) ? 15 : 2] + (size_t)(l) * DM * NGU; const float* wd = ka->in[(which) ? 16 : 3] + (size_t)(l) * DFF * DM; \
        conv_job<1>(wgu, NGU, DM, gg, (which) ? WGU2 : WGU1, NGU, DM, scr, gw, NGW, lane, coff); conv_job<0>(wd, DM, DFF, nullptr, (which) ? WD2 : WD1, DM, DFF, scr, gw, NGW, lane, coff); } while (0)
#define CONV_MIX(l) do { unsigned char* wbase = (l) ? (unsigned char*)xf : ws; conv_job<2>(ka->in[5] + (size_t)(l) * DM * 5962, 5962, DM, ka->in[4] + (size_t)(l) * DM, WIN, NIN, DM, scr, gw, NGW, lane, coff); \
        conv_job<0>(ka->in[10] + (size_t)(l) * 384 * DM, DM, 384, nullptr, WUP, DM, 384, scr, gw, NGW, lane, coff, KUP); \
        conv_job<0>(ka->in[11] + (size_t)(l) * 320 * DM, DM, 320, nullptr, WUP + 384, DM, 384, scr, gw, NGW, lane, coff, KUP); \
        conv_job<0>(ka->in[12] + (size_t)(l) * 320 * DM, DM, 320, nullptr, WUP + 768, DM, 384, scr, gw, NGW, lane, coff, KUP); \
        conv_job<0>(ka->in[13] + (size_t)(l) * DM * DM, DM, DM, nullptr, WOUT, DM, DM, scr, gw, NGW, lane, coff); } while (0)

    PH_BEGIN
        int coff = 0;
        CONV_FFN(0, 0); CONV_MIX(0); CONV_FFN(0, 1); CONV_FFN(1, 0); CONV_MIX(1); CONV_FFN(1, 1);
        const float* x = ka->in[0];
        for (int m0 = gw * 4; m0 < MTOK; m0 += NGW * 4) {
            f32x4 v[4][4]; float s[4];
#pragma unroll
            for (int q = 0; q < 4; ++q) { const GAS f32x4* xr = (const GAS f32x4*)(x + (size_t)(m0 + q) * DM) + lane;
#pragma unroll
                for (int j = 0; j < 4; ++j) v[q][j] = xr[64 * j]; }
#pragma unroll
            for (int q = 0; q < 4; ++q) { GAS u32x2* o8 = (GAS u32x2*)(XB + (size_t)(m0 + q) * DM) + lane; s[q] = 0.f;
#pragma unroll
                for (int j = 0; j < 4; ++j) { const f32x4 t = v[q][j]; s[q] += (t[0] * t[0] + t[1] * t[1]) + (t[2] * t[2] + t[3] * t[3]); u32x2 w; w.x = pk2(t[0], t[1]); w.y = pk2(t[2], t[3]); o8[64 * j] = w; } }
#pragma unroll
            for (int q = 0; q < 4; ++q) { const float sm = wave_sum(s[q], lane); if (lane < 16) SSQ[(size_t)(m0 + q) * 16 + lane] = lane == 0 ? sm : 0.f; }
        }
    PH_END

#pragma unroll 1
    for (layer = 0; layer < DEPTH; ++layer) {
#pragma unroll 1
        for (f = 0; f < 2; ++f) {
            PH_BEGIN
                pg8::Gemm g{XB, f ? WGU2 : WGU1, MTOK, NGU, DM, 0}; pg8::StaticOrder S; S.init(MTOK, NGU, G, bx);
                LAS float* rsT = (LAS float*)(lds + RST_OFF);
                pg8::EpiSwiglu E{rsT, HFF, DFF};
                { const float* ssq_ = SSQ; auto pre = [&]() { pg8::rs_table_fill(rsT, ssq_, S, (int)TX_NOW()); };
                  pg8::gemm_phase<pg8::EpiSwiglu, pg8::StaticOrder, true, true>(lds + RING_OFF, g, S, E, (int)TX_NOW(), pre); }
            PH_END
            PH_BEGIN
                pg8::Gemm g{HFF, f ? WD2 : WD1, MTOK, DM, DFF, 0}; pg8::StaticOrder S; S.init(MTOK, DM, G, bx);
                pg8::EpiResid E{XB, SSQ, 0.5f};
                pg8::gemm_phase<pg8::EpiResid, pg8::StaticOrder, true, true>(lds + RING_OFF, g, S, E, (int)TX_NOW());
            PH_END
            if (f == 1) break;
            { const size_t rb = 0;
                PH_BEGIN
                    pg8::Gemm g{XB + rb * DM, WIN, MH, NIN, DM, 0}; pg8::StaticOrder S; S.init(MH, NIN, G, bx);
                    LAS float* rsT = (LAS float*)(lds + RST_OFF);
                    pg8::EpiWin E{rsT, P, PF, PLD};
                    { const float* ssq_ = SSQ + rb * 16; auto pre = [&]() { pg8::rs_table_fill(rsT, ssq_, S, (int)TX_NOW()); };
                      pg8::gemm_phase<pg8::EpiWin, pg8::StaticOrder, true, true>(lds + RING_OFF, g, S, E, (int)TX_NOW(), pre); }
                PH_END
            }
#pragma unroll 1
            for (hf = 0; hf < 2; ++hf) {
                const size_t rb = (size_t)hf * MH;
                PH_BEGIN
                    const float* gkv = ka->in[7] + Lr * 128; const float* wkv = ka->in[8] + (size_t)Lr * 128 * 128; const float* gik = ka->in[9] + Lr * 64; const float* bfor = ka->in[6] + Lr * NFOX;
                    LAS bf16* Tt = (LAS bf16*)(lds + wave * 12288);
                    LAS bf16* VCt = (LAS bf16*)(lds + VCT_OFF);
                    LAS unsigned* Wl = (LAS unsigned*)(lds + 98304);
                    { f32x2_t wv_[16];
#pragma unroll
                      for (int i = 0; i < 16; ++i) wv_[i] = *(const GAS f32x2_t*)(wkv + 2 * ((int)tx_ + 512 * i));
#pragma unroll
                      for (int i = 0; i < 16; ++i) Wl[(int)tx_ + 512 * i] = pk2(wv_[i][0], wv_[i][1]); }
                    __syncthreads();
                    for (int blk = bx; blk < MH / 64; blk += G) {
                        const GAS bf16* prow = (const GAS bf16*)P + (size_t)(blk * 64 + (lane >> 3)) * PLD + 8 * (lane & 7);
                        v4u wa[8];
                        { const GAS bf16* pa = prow + (wave < 6 ? C_VA + wave * 64 : C_VB + (wave - 6) * 64);
#pragma unroll
                          for (int i = 0; i < 8; ++i) wa[i] = *(const GAS v4u*)(pa + (size_t)(8 * i) * PLD); }
                        float pc0[8], pc1[8], pki[8], qc1[8], qc2[8], qi1[8], qi2[8], pfa[8];
                        {   bf16 r0[8], r1[8], r2[8], r3[8], r4[8], r5[8];
#pragma unroll
                            for (int j = 0; j < 8; ++j) { const int r = blk * 64 + wave * 8 + j; const int hq = lane >> 3, i8q = lane & 7;
                                const GAS bf16* pr = (const GAS bf16*)P + (size_t)r * PLD; const GAS float* pf = (const GAS float*)PF + (size_t)r * 256;
                                r0[j] = pr[C_CKV + lane]; r1[j] = pr[C_CKV + 64 + lane]; pki[j] = pf[F_KI + lane];
                                const GAS bf16* pq = pr + C_QC + (hq < 5 ? hq : 0) * 64; r2[j] = pq[i8q]; r3[j] = pq[i8q + 8];
                                const GAS bf16* pi = pr + C_QI + (hq < 4 ? hq : 0) * 64; r4[j] = pi[i8q]; r5[j] = pi[i8q + 8];
                                pfa[j] = pf[F_FA + (lane < NFOX ? lane : 0)]; }
                            asm volatile("" ::: "memory");
#pragma unroll
                            for (int j = 0; j < 8; ++j) { pc0[j] = bf2f(r0[j]); pc1[j] = bf2f(r1[j]); qc1[j] = bf2f(r2[j]); qc2[j] = bf2f(r3[j]); qi1[j] = bf2f(r4[j]); qi2[j] = bf2f(r5[j]); }
                        }
                        const float bfv = *(const GAS float*)(bfor + (lane < NFOX ? lane : 0));
                        LAS float* cn8 = (LAS float*)Tt;
                        { float ss[8];
#pragma unroll
                          for (int j = 0; j < 8; ++j) ss[j] = pc0[j] * pc0[j] + pc1[j] * pc1[j];
#pragma unroll
                          for (int j = 0; j < 8; ++j) ss[j] = wave_sum_dpp(ss[j]);
                          const float g0 = gkv[lane], g1 = gkv[64 + lane];
#pragma unroll
                          for (int j = 0; j < 8; ++j) { const float rn = 1.0f / sqrtf(ss[j] * (1.0f / 128.0f) + EPS); cn8[j * 128 + lane] = pc0[j] * rn * g0; cn8[j * 128 + 64 + lane] = pc1[j] * rn * g1; } }
                        LDS_WAIT(); asm volatile("" ::: "memory");
                        float a0[8], a1[8];
#pragma unroll
                        for (int j = 0; j < 8; ++j) { a0[j] = 0.f; a1[j] = 0.f; }
#pragma unroll 2
                        for (int k = 0; k < 128; k += 4) {
                            unsigned w[4];
#pragma unroll
                            for (int e = 0; e < 4; ++e) w[e] = Wl[(k + e) * 64 + lane];
#pragma unroll
                            for (int j = 0; j < 8; ++j) { const f32x4 cn = *(const LAS f32x4*)(cn8 + j * 128 + k);
#pragma unroll
                                for (int e = 0; e < 4; ++e) { a0[j] = fmaf(cn[e], bflo(w[e]), a0[j]); a1[j] = fmaf(cn[e], bfhi(w[e]), a1[j]); } }
                        }
                        { float ss[8];
#pragma unroll
                          for (int j = 0; j < 8; ++j) ss[j] = pki[j] * pki[j];
#pragma unroll
                          for (int o = 1; o < 64; o <<= 1)
#pragma unroll
                              for (int j = 0; j < 8; ++j) ss[j] += bperm_f(ss[j], lane ^ o);
#pragma unroll
                          for (int j = 0; j < 8; ++j) pki[j] = pki[j] * (1.0f / sqrtf(ss[j] * (1.0f / 64.0f) + EPS)) * gik[lane]; }
#pragma unroll
                        for (int j = 0; j < 8; ++j) {
                            const int tl = wave * 8 + j, r = blk * 64 + tl; const int pos = r % SEQ; const int i8 = lane & 7;
                            float rc, rsn; rope_cs(pos, i8, rc, rsn);
                            float x0 = a0[j], x1v = a1[j];
                            {
                              const int j0 = (2 * lane) & 7, j1 = (2 * lane + 1) & 7;
                              const float c_0 = bperm_f(rc, j0), s_0 = bperm_f(rsn, j0), c_1 = bperm_f(rc, j1), s_1 = bperm_f(rsn, j1);
                              const float o0 = bperm_f(x0, lane ^ 4), o1 = bperm_f(x1v, lane ^ 4);
                              if (lane < 4) { x0 = x0 * c_0 - o0 * s_0; x1v = x1v * c_1 - o1 * s_1; } else if (lane < 8) { x0 = x0 * c_0 + o0 * s_0; x1v = x1v * c_1 + o1 * s_1; } }
                            const size_t kimg = (size_t)(r / SEQ) * SEQ * 64 + (size_t)((pos >> 5) * 4) * 512 + (pos & 31) * 8;
                            if (lane < 32) *(GAS unsigned*)(KC + kimg + (lane >> 3) * 512 + ((lane >> 2) & 1) * 256 + ((2 * lane) & 7)) = pk2(x0, x1v);
                            else *(LAS unsigned*)(VCt + tl * 64 + 2 * (lane - 32)) = pk2(x0, x1v);
                            { const int hh = lane >> 3;
                              bf16* pc = P + (size_t)r * PLD + C_QC + hh * 64; bf16* pi = P + (size_t)r * PLD + C_QI + hh * 64; const bool sc_ = i8 == 0 && hh < 5, si_ = i8 == 0 && hh < 4;
                              { const v4u w_ = pack8_dpp(qc1[j] * rc - qc2[j] * rsn); if (sc_) *(GAS v4u*)pc = w_; }
                              { const v4u w_ = pack8_dpp(qc2[j] * rc + qc1[j] * rsn); if (sc_) *(GAS v4u*)(pc + 8) = w_; }
                              { const v4u w_ = pack8_dpp(qi1[j] * rc - qi2[j] * rsn); if (si_) *(GAS v4u*)pi = w_; }
                              { const v4u w_ = pack8_dpp(qi2[j] * rc + qi1[j] * rsn); if (si_) *(GAS v4u*)(pi + 8) = w_; } }
                            { float y = pki[j]; const float other = bperm_f(y, lane ^ 8); if (lane < 8) y = y * rc - other * rsn; else if (lane < 16) y = y * rc + other * rsn;
                              const v4u yw = pack8_dpp(y); if (i8 == 0) *(GAS v4u*)(KI + kimg + (lane >> 4) * 512 + ((lane >> 3) & 1) * 256) = yw; }
                            if (lane < NFOX) { const float fv = pfa[j] + bfv;
                                CF[((size_t)(r / SEQ) * NFOX + lane) * SEQ + pos] = fminf(fv, 0.f) - __logf(1.0f + __expf(-fabsf(fv))); }
                            if (lane < 16) *(GAS v4u*)((lane < 8 ? YB : YC) + (size_t)r * KUP + 320 + 8 * (lane & 7)) = v4u{0u, 0u, 0u, 0u};
                        }
                        LDS_WAIT(); asm volatile("" ::: "memory");
                        __syncthreads();
                        const int bl = (blk * 64) / SEQ, t0 = (blk * 64) % SEQ;
                        {
                            const int tok0 = lane >> 3, chl = lane & 7;
                            v4u wb[8];
#pragma unroll
                            for (int i = 0; i < 8; ++i) wb[i] = *(const LAS v4u*)(VCt + (tok0 + 8 * i) * 64 + 8 * chl);
                            if (wave < 3) { const GAS bf16* pb = prow + C_VB + (wave + 2) * 64;
#pragma unroll
                              for (int i = 0; i < 8; ++i) wb[i] = *(const GAS v4u*)(pb + (size_t)(8 * i) * PLD); }
#pragma unroll 1
                            for (int rnd = 0; rnd < 2; ++rnd) {
                                const int jt = rnd ? wave + 8 : wave;
                                if (jt < 12) {
#pragma unroll
                                for (int i = 0; i < 8; ++i) { const int tok = tok0 + 8 * i; const v4u w = wa[i];
                                    const int tp = (tok & ~12) | ((tok & 4) << 1) | ((tok & 8) >> 1);
                                    LAS bf16* d = Tt + (8 * chl) * 72 + ((((tp >> 3) ^ chl) << 3) | (tp & 7));
                                    d[0 * 72] = (bf16)(w.x & 0xffffu); d[1 * 72] = (bf16)(w.x >> 16); d[2 * 72] = (bf16)(w.y & 0xffffu); d[3 * 72] = (bf16)(w.y >> 16);
                                    d[4 * 72] = (bf16)(w.z & 0xffffu); d[5 * 72] = (bf16)(w.z >> 16); d[6 * 72] = (bf16)(w.w & 0xffffu); d[7 * 72] = (bf16)(w.w >> 16); }
                                LDS_WAIT(); asm volatile("" ::: "memory");
                                bf16* dst = jt < 6 ? VTA + ((size_t)(bl * NFOX + jt) * 64) * SEQ : jt < 11 ? VTB + ((size_t)(bl * NSB + (jt - 6)) * 64) * SEQ : VTC + ((size_t)bl * 64) * SEQ;
                                v4u o[8];
#pragma unroll
                                for (int i = 0; i < 8; ++i) o[i] = *(const LAS v4u*)(Tt + (tok0 + 8 * i) * 72 + 8 * (chl ^ i));
#pragma unroll
                                for (int i = 0; i < 8; ++i) { const int d = tok0 + 8 * i;
                                    *(GAS v4u*)(dst + ((size_t)(((t0 >> 5) + (chl >> 2)) * 2 + (d >> 5)) * 2 + ((chl & 3) >> 1)) * 512 + ((d & 31) + 32 * (chl & 1)) * 8) = o[i]; }
                                LDS_WAIT(); asm volatile("" ::: "memory");
                                }
#pragma unroll
                                for (int i = 0; i < 8; ++i) wa[i] = wb[i];
                            }
                        }
                        __syncthreads();
                    }
                PH_END
                PH_BEGIN
                    { const int vw = gw >> 3, w8 = gw & 7; const int nF = G < 192 ? G : 192, nS = G - nF;
                      for (int it = vw; it < HB * NFOX * 4; it += G) { const int q4 = it / (HB * NFOX), bh = it % (HB * NFOX);
                            LAS float* cfL = (LAS float*)(lds + RING_OFF);
                            __syncthreads();
                            {
                                const int ti = (int)tx_; f32x4 v = *(const GAS f32x4*)(CF + (size_t)bh * SEQ + 4 * ti);
                                v[1] += v[0]; v[2] += v[1]; v[3] += v[2];
                                float tot = v[3];
#pragma unroll
                                for (int o = 1; o < 64; o <<= 1) { const float n = bperm_f(tot, lane - o); if (lane >= o) tot += n; }
                                LAS float* wtot = cfL + SEQ;
                                if (lane == 63) wtot[wave] = tot;
                                __syncthreads();
                                float base = tot - v[3];
#pragma unroll
                                for (int w = 0; w < 8; ++w) base += w < wave ? wtot[w] : 0.f;
                                *(LAS f32x4*)(cfL + 4 * ti) = (v + base) * (-LOG2E);
                            }
                            __syncthreads();
#pragma unroll 1
                            for (int hl = 0; hl < 2; ++hl) fox_strip(P, KAI, cfL, VTA, YA, bh / NFOX, bh % NFOX, hl == 0 ? (7 - q4) * 8 + 7 - w8 : q4 * 8 + w8, lane); }
                      if (nS > 0) { if (vw >= nF) for (int E = vw - nF; E < HB * NSB * 8; E += nS) { const int Qg = 7 - E / (HB * NSB), bh = E % (HB * NSB); sb_strip(P, KBI, VTB, YB, bh / NSB, bh % NSB, Qg * 8 + 7 - w8, lane); } }
                      else for (int E = vw; E < HB * NSB * 8; E += G) { const int Qg = 7 - E / (HB * NSB), bh = E % (HB * NSB); sb_strip(P, KBI, VTB, YB, bh / NSB, bh % NSB, Qg * 8 + 7 - w8, lane); }
                    }
                    __syncthreads();
                    for (int rd = 0; rd * G < HB * 64; ++rd) { const int vw = gw >> 3; const int U = rd * G + ((rd & 1) ? G - 1 - vw : vw);
                        if (U < HB * 64) dsa_unit(P, PF, KI, KC, VTC, YC, U % HB, 63 - U / HB, wave, (int)(TX_NOW() & 63u), lds + RING_OFF); }
                PH_END
                PH_BEGIN
                    pg8::SegOrder3 S; S.init(MH, DM, G, bx);
                    { pg8::Gemm g{YA, WUP, MH, DM, 384, KUP}; pg8::EpiGateR E{GI, MGB}; pg8::gemm_phase<pg8::EpiGateR, pg8::SegOrder3, true, true>(lds + RING_OFF, g, S, E, (int)TX_NOW()); }
                PH_END
                PH_BEGIN
                    pg8::Gemm g{MGB, WOUT, MH, DM, DM, 0}; pg8::StaticOrder S; S.init(MH, DM, G, bx);
                    pg8::EpiResid E{XB + rb * DM, SSQ + rb * 16, 1.0f};
                    pg8::gemm_phase<pg8::EpiResid, pg8::StaticOrder, true, true>(lds + RING_OFF, g, S, E, (int)TX_NOW());
                    if (hf == 0) { const size_t rb1 = (size_t)MH;

                    pg8::Gemm g{XB + rb1 * DM, WIN, MH, NIN, DM, 0}; pg8::StaticOrder S; S.init(MH, NIN, G, bx);
                    LAS float* rsT = (LAS float*)(lds + RST_OFF);
                    pg8::EpiWin E{rsT, P, PF, PLD};
                    { const float* ssq_ = SSQ + rb1 * 16; auto pre = [&]() { pg8::rs_table_fill(rsT, ssq_, S, (int)TX_NOW()); };
                      pg8::gemm_phase<pg8::EpiWin, pg8::StaticOrder, true, true>(lds + RING_OFF, g, S, E, (int)TX_NOW(), pre); }
                                    }
                PH_END
            }
        }
    }
    PH_BEGIN
        const float* gf = ka->in[17];
        const GAS f32x4* gr = (const GAS f32x4*)gf + lane; f32x4 gv[4];
#pragma unroll
        for (int j = 0; j < 4; ++j) gv[j] = gr[64 * j];
        for (int m0 = gw * 4; m0 < MTOK; m0 += NGW * 4) {
            u32x2 w[4][4];
#pragma unroll
            for (int q = 0; q < 4; ++q) { const GAS u32x2* xr = (const GAS u32x2*)(XB + (size_t)(m0 + q) * DM) + lane;
#pragma unroll
                for (int j = 0; j < 4; ++j) w[q][j] = xr[64 * j]; }
#pragma unroll
            for (int q = 0; q < 4; ++q) { f32x4 v[4]; float s = 0.f;
#pragma unroll
                for (int j = 0; j < 4; ++j) { v[j][0] = bflo(w[q][j].x); v[j][1] = bfhi(w[q][j].x); v[j][2] = bflo(w[q][j].y); v[j][3] = bfhi(w[q][j].y); s += (v[j][0] * v[j][0] + v[j][1] * v[j][1]) + (v[j][2] * v[j][2] + v[j][3] * v[j][3]); }
                const float rs = 1.0f / sqrtf(wave_sum(s, lane) * (1.0f / DM) + EPS);
                GAS f32x4* orow = (GAS f32x4*)(xf + (size_t)(m0 + q) * DM) + lane;
#pragma unroll
                for (int j = 0; j < 4; ++j) orow[64 * j] = v[j] * rs * gv[j]; }
        }
    PH_END
#undef PH_BEGIN
#undef PH_END
}

#ifndef MK_N_LAUNCHES
#define MK_N_LAUNCHES 1
#endif
constexpr int N_PHASES = 1 + DEPTH * (2 + 1 + 2 * 4 + 2) + 1;
extern "C" void kernel_launch(void* const* d_in, const int* in_sizes, int n_in, void* d_out, int out_size, void* d_ws, size_t ws_size, hipStream_t stream) {
    static int grid = 0;
    if (grid == 0) {
        if (n_in != 18 || in_sizes[0] != MTOK * DM || out_size != MTOK * DM || ws_size < WS_END) { fprintf(stderr, "kernel_launch: unexpected shapes (n_in %d, in0 %d, out %d, ws %zu); nothing launched\n", n_in, n_in > 0 ? in_sizes[0] : -1, out_size, ws_size); grid = -1; return; }
        int dev = 0, cus = 0, per_cu = 0;
        if (hipGetDevice(&dev) != hipSuccess || hipDeviceGetAttribute(&cus, hipDeviceAttributeMultiprocessorCount, dev) != hipSuccess) { grid = -1; return; }
        if (hipFuncSetAttribute((const void*)mk_fwd, hipFuncAttributeMaxDynamicSharedMemorySize, LDS_BYTES) != hipSuccess) { fprintf(stderr, "kernel_launch: hipFuncSetAttribute failed\n"); grid = -1; return; }
        if (hipOccupancyMaxActiveBlocksPerMultiprocessor(&per_cu, (const void*)mk_fwd, NWAVES * 64, LDS_BYTES) != hipSuccess || per_cu < 1) fprintf(stderr, "kernel_launch: occupancy query reports %d workgroups per CU\n", per_cu);
        (void)hipGetLastError();
        grid = cus;
        if (grid > 256) grid = 256;
    }
    if (grid < 0) return;
    if (hipMemsetAsync((char*)d_ws + WS_CTL, 0, CTL_ZERO_BYTES, stream) != hipSuccess) return;
    Args a{};
    for (int i = 0; i < 18; ++i) a.in[i] = (const float*)d_in[i];
    a.out = (float*)d_out; a.ws = (unsigned char*)d_ws; a.pad = 0;
    const int nl = MK_N_LAUNCHES;
    for (int li = 0; li < nl; ++li) {
        a.ph_lo = (int)((long)N_PHASES * li / nl); a.ph_hi = (int)((long)N_PHASES * (li + 1) / nl); a.li = li;
        hipLaunchKernelGGL(mk_fwd, dim3(grid), dim3(NWAVES * 64), LDS_BYTES, stream, a);
        const hipError_t le = hipPeekAtLastError();
        if (le != hipSuccess) { fprintf(stderr, "kernel_launch: launch %d failed: %s\n", li, hipGetErrorName(le)); break; }
    }
}
```
